# Optimizing an MI355X kernel written in HIP

```python
import jax, jax.numpy as jnp
from jax import lax
import numpy as np

D_MODEL = 1024
BATCH = 8
SEQ = 2048
DEPTH = 4

N_HEADS = 8
N_KV_HEADS = 2
HEAD_DIM = 128
Q_GROUP = N_HEADS // N_KV_HEADS
WINDOW = 128
BLOCK = 128
ROPE_THETA = 500000.0
ROPE_DIM = HEAD_DIM // 4
D_RNN = D_MODEL
N_RNN_BLOCKS = 4
RNN_BLOCK_W = D_RNN // N_RNN_BLOCKS
RNN_CONV_W = 4
RG_C = 8.0
D_FF = 3 * D_MODEL
FFN_CONV_W = 3
D_PLE = 256
LN_EPS = 1e-5
DN_ALPHA = (2 * DEPTH) ** 0.25
DN_BETA = (8 * DEPTH) ** -0.25

Q_WIDTH = N_HEADS * HEAD_DIM
KV_WIDTH = N_KV_HEADS * HEAD_DIM
IN_SIZES = (Q_WIDTH, KV_WIDTH, KV_WIDTH, D_RNN, D_RNN, D_MODEL, D_MODEL)
D_IN = sum(IN_SIZES)

kernel_name = "hybrid_swa_rglru_bidir_encoder"


def layer_norm(x, g, b):
    xf = x.astype(jnp.float32)
    mu = jnp.mean(xf, axis=-1, keepdims=True)
    var = jnp.mean(jnp.square(xf - mu), axis=-1, keepdims=True)
    y = (xf - mu) * lax.rsqrt(var + LN_EPS) * g.astype(jnp.float32) + b.astype(jnp.float32)
    return y.astype(x.dtype)


def rope_tables(seq_len, dtype):
    pos = jnp.arange(seq_len, dtype=jnp.float32)
    inv = ROPE_THETA ** (-jnp.arange(0, ROPE_DIM, 2, dtype=jnp.float32) / ROPE_DIM)
    ang = pos[:, None] * inv[None, :]
    return jnp.cos(ang).astype(dtype), jnp.sin(ang).astype(dtype)


def partial_rope(x, cos, sin):
    half = ROPE_DIM // 2
    x1, x2, rest = x[..., :half], x[..., half:ROPE_DIM], x[..., ROPE_DIM:]
    c = cos[None, :, None, :]
    s = sin[None, :, None, :]
    return jnp.concatenate([x1 * c - x2 * s, x2 * c + x1 * s, rest], axis=-1)


def band_blocks(t):
    bsz, s = t.shape[:2]
    nb = s // BLOCK
    tp = jnp.pad(t, ((0, 0), (BLOCK, BLOCK), (0, 0), (0, 0)))
    tb = tp.reshape(bsz, nb + 2, BLOCK, *t.shape[2:])
    return jnp.concatenate([tb[:, :-2], tb[:, 1:-1], tb[:, 2:]], axis=2)


def local_attention(q, k, v, sink):
    bsz, s = q.shape[:2]
    nb = s // BLOCK
    qb = q.reshape(bsz, nb, BLOCK, N_KV_HEADS, Q_GROUP, HEAD_DIM)
    kb = band_blocks(k)
    vb = band_blocks(v)
    logits = jnp.einsum('bnqhgd,bnkhd->bnhgqk', qb, kb,
                        preferred_element_type=jnp.float32) * (HEAD_DIM ** -0.5)
    qi = jnp.arange(BLOCK)[:, None]
    kj = jnp.arange(3 * BLOCK)[None, :]
    band = jnp.abs(kj - BLOCK - qi) <= WINDOW
    kpos = jnp.arange(nb)[:, None] * BLOCK - BLOCK + jnp.arange(3 * BLOCK)[None, :]
    in_range = (kpos >= 0) & (kpos < s)
    valid = band[None] & in_range[:, None, :]
    logits = jnp.where(valid[None, :, None, None], logits, -1e30)
    sink_col = jnp.broadcast_to(
        sink.astype(jnp.float32).reshape(1, 1, N_KV_HEADS, Q_GROUP, 1, 1),
        logits.shape[:-1] + (1,))
    probs = jax.nn.softmax(jnp.concatenate([logits, sink_col], axis=-1), axis=-1)[..., :-1]
    out = jnp.einsum('bnhgqk,bnkhd->bnqhgd', probs.astype(v.dtype), vb)
    return out.reshape(bsz, s, Q_WIDTH)


def directional_conv(x, w, b, reverse):
    kw = w.shape[0]
    s = x.shape[1]
    if reverse:
        xp = jnp.pad(x, ((0, 0), (0, kw - 1), (0, 0)))
        y = sum(w[k] * xp[:, k:k + s] for k in range(kw))
    else:
        xp = jnp.pad(x, ((0, 0), (kw - 1, 0), (0, 0)))
        y = sum(w[k] * xp[:, kw - 1 - k:kw - 1 - k + s] for k in range(kw))
    return y + b


def centred_conv(x, w, b):
    kw = w.shape[0]
    s = x.shape[1]
    pad = (kw - 1) // 2
    xp = jnp.pad(x, ((0, 0), (pad, pad), (0, 0)))
    return sum(w[k] * xp[:, k:k + s] for k in range(kw)) + b


def rg_lru(x, w_a, b_a, w_x, b_x, lam, reverse):
    bsz, s, c = x.shape
    xb = x.reshape(bsz, s, N_RNN_BLOCKS, RNN_BLOCK_W)
    gate_a = jax.nn.sigmoid(jnp.einsum('bsnc,ncd->bsnd', xb, w_a).reshape(bsz, s, c) + b_a)
    gate_x = jax.nn.sigmoid(jnp.einsum('bsnc,ncd->bsnd', xb, w_x).reshape(bsz, s, c) + b_x)
    log_a = -RG_C * gate_a.astype(jnp.float32) * jax.nn.softplus(-lam.astype(jnp.float32))
    a = jnp.exp(log_a)
    mult = jnp.sqrt(-jnp.expm1(2.0 * log_a))
    start = jnp.arange(s) == (s - 1 if reverse else 0)
    mult = jnp.where(start[None, :, None], 1.0, mult)
    u = x.astype(jnp.float32) * gate_x.astype(jnp.float32) * mult

    def combine(left, right):
        a_l, b_l = left
        a_r, b_r = right
        return a_l * a_r, a_r * b_l + b_r

    _, h = lax.associative_scan(combine, (a, u), reverse=reverse, axis=1)
    return h.astype(x.dtype)


def setup_inputs(seed: int = 0) -> dict:
    key = jax.random.key(seed)
    ks = jax.random.split(key, 32)
    f32 = jnp.float32
    L = DEPTH

    def nrm(k, shape, scale):
        return jax.random.normal(k, shape, f32) * scale

    rad = jax.random.uniform(ks[10], (L, 2, D_RNN), f32, 0.9, 0.999)
    return {
        "x": jax.random.normal(ks[0], (BATCH, SEQ, D_MODEL), f32),
        "p": jax.random.normal(ks[1], (DEPTH, BATCH, SEQ, D_PLE), f32),
        "ln_in_g": 1.0 + nrm(ks[2], (D_MODEL,), 0.02),
        "ln_in_b": nrm(ks[3], (D_MODEL,), 0.02),
        "w_in": nrm(ks[4], (L, D_MODEL, D_IN), D_MODEL ** -0.5),
        "attn_sink": nrm(ks[5], (L, N_HEADS), 0.5),
        "rnn_conv_w": nrm(ks[6], (L, 2, RNN_CONV_W, D_RNN), RNN_CONV_W ** -0.5),
        "rnn_conv_b": nrm(ks[7], (L, 2, D_RNN), 0.02),
        "rg_w_a": nrm(ks[8], (L, 2, N_RNN_BLOCKS, RNN_BLOCK_W, RNN_BLOCK_W), RNN_BLOCK_W ** -0.5),
        "rg_b_a": nrm(ks[9], (L, 2, D_RNN), 0.02),
        "rg_w_x": nrm(ks[11], (L, 2, N_RNN_BLOCKS, RNN_BLOCK_W, RNN_BLOCK_W), RNN_BLOCK_W ** -0.5),
        "rg_b_x": nrm(ks[12], (L, 2, D_RNN), 0.02),
        "rg_lambda": jnp.log(rad) - jnp.log1p(-rad),
        "w_proj_attn": nrm(ks[13], (L, Q_WIDTH, D_MODEL), Q_WIDTH ** -0.5),
        "w_proj_rnn": nrm(ks[14], (L, D_RNN, D_MODEL), D_RNN ** -0.5),
        "w_out": nrm(ks[15], (L, D_MODEL, D_MODEL), DN_BETA * D_MODEL ** -0.5),
        "ln1_g": 1.0 + nrm(ks[16], (L, D_MODEL), 0.02),
        "ln1_b": nrm(ks[17], (L, D_MODEL), 0.02),
        "w_up": nrm(ks[18], (L, D_MODEL, 2 * D_FF), D_MODEL ** -0.5),
        "ffn_conv_w": nrm(ks[19], (L, FFN_CONV_W, D_FF), FFN_CONV_W ** -0.5),
        "ffn_conv_b": nrm(ks[20], (L, D_FF), 0.02),
        "w_down": nrm(ks[21], (L, D_FF, D_MODEL), DN_BETA * D_FF ** -0.5),
        "w_ple": nrm(ks[22], (L, D_PLE, D_MODEL), DN_BETA * D_PLE ** -0.5),
        "w_ple_gate": nrm(ks[23], (L, D_MODEL, D_MODEL), D_MODEL ** -0.5),
        "ln2_g": 1.0 + nrm(ks[24], (L, D_MODEL), 0.02),
        "ln2_b": nrm(ks[25], (L, D_MODEL), 0.02),
    }


def reference(x, p, ln_in_g, ln_in_b, w_in, attn_sink, rnn_conv_w, rnn_conv_b,
              rg_w_a, rg_b_a, rg_w_x, rg_b_x, rg_lambda, w_proj_attn, w_proj_rnn,
              w_out, ln1_g, ln1_b, w_up, ffn_conv_w, ffn_conv_b, w_down,
              w_ple, w_ple_gate, ln2_g, ln2_b):
    bsz, s, _ = x.shape
    cos, sin = rope_tables(s, x.dtype)
    split_points = np.cumsum(IN_SIZES)[:-1].tolist()
    h = layer_norm(x, ln_in_g, ln_in_b)
    for i in range(DEPTH):
        z = h @ w_in[i]
        q, k, v, xr, yr, ga, gr = jnp.split(z, split_points, axis=-1)
        q = partial_rope(q.reshape(bsz, s, N_HEADS, HEAD_DIM), cos, sin)
        k = partial_rope(k.reshape(bsz, s, N_KV_HEADS, HEAD_DIM), cos, sin)
        v = v.reshape(bsz, s, N_KV_HEADS, HEAD_DIM)
        attn = local_attention(q, k, v, attn_sink[i])

        xf = directional_conv(xr, rnn_conv_w[i, 0], rnn_conv_b[i, 0], False)
        xb = directional_conv(xr, rnn_conv_w[i, 1], rnn_conv_b[i, 1], True)
        hr = (rg_lru(xf, rg_w_a[i, 0], rg_b_a[i, 0], rg_w_x[i, 0], rg_b_x[i, 0], rg_lambda[i, 0], False)
              + rg_lru(xb, rg_w_a[i, 1], rg_b_a[i, 1], rg_w_x[i, 1], rg_b_x[i, 1], rg_lambda[i, 1], True))
        rnn = hr * jax.nn.gelu(yr)

        merged = (jax.nn.sigmoid(ga) * (attn @ w_proj_attn[i])
                  + jax.nn.sigmoid(gr) * (rnn @ w_proj_rnn[i]))
        h = layer_norm(DN_ALPHA * h + merged @ w_out[i], ln1_g[i], ln1_b[i])

        gate, val = jnp.split(h @ w_up[i], 2, axis=-1)
        gate = centred_conv(gate, ffn_conv_w[i], ffn_conv_b[i])
        ffn = (jax.nn.gelu(gate) * val) @ w_down[i]
        ple = jax.nn.sigmoid(h @ w_ple_gate[i]) * (p[i] @ w_ple[i])
        h = layer_norm(DN_ALPHA * h + ffn + ple, ln2_g[i], ln2_b[i])
    return h
```

```cpp
#include <hip/hip_runtime.h>
#include <hip/hip_cooperative_groups.h>
#include <cstdio>
#include <cstdint>
namespace cg = cooperative_groups;

#define LAS __attribute__((address_space(3)))
#define DI __device__ __forceinline__
typedef unsigned short bf16;
typedef short bf16x8 __attribute__((ext_vector_type(8)));
typedef float f32x4 __attribute__((ext_vector_type(4)));
typedef float f32x16 __attribute__((ext_vector_type(16)));
typedef unsigned u32x4 __attribute__((ext_vector_type(4)));
typedef unsigned u32x2 __attribute__((ext_vector_type(2)));
typedef __bf16 bf16x2_t __attribute__((ext_vector_type(2)));
typedef float f32x2_t __attribute__((ext_vector_type(2)));

constexpr int BATCH = 8, SEQ = 2048, D = 1024, DEPTH = 4, M = BATCH * SEQ;
constexpr int NH = 8, NKV = 2, HD = 128, DIN = 5632, DFF = 3072, DPLE = 256;
constexpr float LN_EPS = 1e-5f;
constexpr float DN_ALPHA = 1.6817928305074290f;
constexpr float LOG2E = 1.4426950408889634f;
constexpr float QSCALE = 0.08838834764831845f * LOG2E;

constexpr size_t MiB = 1u << 20;
constexpr size_t WS_ROPE = 0;
constexpr size_t WS_W = 1 * MiB;
constexpr size_t W_IN = 0, W_G = W_IN + (size_t)DIN * D, W_PA = W_G + 8 * 512 * 256, W_PR = W_PA + (size_t)D * D, W_O = W_PR + (size_t)D * 2 * D,
                 W_UP = W_O + (size_t)D * D, W_DN = W_UP + (size_t)2 * DFF * D, W_PLE = W_DN + (size_t)D * DFF, W_PG = W_PLE + (size_t)D * DPLE, W_END = W_PG + (size_t)D * D;
static_assert(W_END * 2 <= 42 * MiB, "weights");
constexpr size_t WS_PB = WS_W + 42 * MiB;
constexpr size_t WS_HB = WS_PB + 8 * MiB;
constexpr size_t WS_Z = WS_HB + 32 * MiB;
constexpr size_t WS_ATT = WS_Z + 176 * MiB;
constexpr size_t WS_XFB = WS_ATT + 32 * MiB;
constexpr size_t WS_EXTRA = WS_XFB + 64 * MiB;
constexpr size_t WS_END = WS_EXTRA + 64 * MiB;
static_assert(WS_END <= 440 * MiB, "ws");
constexpr size_t Z_Q = 0, Z_K = (size_t)M * 1024, Z_V = (size_t)M * 1280, Z_XR = (size_t)M * 1536, Z_GY = (size_t)M * 2560, Z_SA = (size_t)M * 3584, Z_SR = (size_t)M * 4608;

constexpr int LDS_BYTES = 135168;

DI unsigned pk2(float lo, float hi) { f32x2_t v = {lo, hi}; bf16x2_t b = __builtin_convertvector(v, bf16x2_t); return __builtin_bit_cast(unsigned, b); }
DI float bflo(unsigned u) { return __uint_as_float(u << 16); }
DI float bfhi(unsigned u) { return __uint_as_float(u & 0xffff0000u); }
DI float sigm(float x) { return __builtin_amdgcn_rcpf(1.f + __builtin_amdgcn_exp2f(-LOG2E * x)); }
DI float gelu_t(float x) { const float u = 0.7978845608028654f * (x + 0.044715f * x * x * x); return x * sigm(2.f * u); }
DI void unpack8(const u32x4 w, float (&v)[8]) { v[0] = bflo(w.x); v[1] = bfhi(w.x); v[2] = bflo(w.y); v[3] = bfhi(w.y); v[4] = bflo(w.z); v[5] = bfhi(w.z); v[6] = bflo(w.w); v[7] = bfhi(w.w); }
DI u32x4 pack8(const float (&v)[8]) { u32x4 w; w.x = pk2(v[0], v[1]); w.y = pk2(v[2], v[3]); w.z = pk2(v[4], v[5]); w.w = pk2(v[6], v[7]); return w; }
DI float shx(float v, int mask, int lane) { return __int_as_float(__builtin_amdgcn_ds_bpermute((lane ^ mask) << 2, __float_as_int(v))); }
DI float wave_sum(float v, int lane) {
#pragma unroll
    for (int o = 1; o < 64; o <<= 1) v += shx(v, o, lane);
    return v;
}
DI int get_tid(int wid_s) { int l; asm volatile("v_mbcnt_lo_u32_b32 %0, -1, 0\n\tv_mbcnt_hi_u32_b32 %0, -1, %0" : "=v"(l)); return wid_s * 64 + l; }
#define LDS_WAIT() asm volatile("s_waitcnt lgkmcnt(0)" ::: "memory")

namespace pg8 {
constexpr int BM = 256, BK = 64, HALF = 128, HTB = HALF * BK * 2, NXCD = 8, WGM = 8;
DI int lds_byte(int r, int c) { const int st = (r >> 4) * 2 + (c >> 5), rr = r & 15, cc = c & 31, ob = rr * 64 + cc * 2; return st * 1024 + (ob ^ (((ob >> 9) & 1) << 5)); }
DI void stage_rc(int b, int& R, int& C) { const int st = b / 1024, sb = b % 1024, swz = sb ^ (((sb >> 9) & 1) << 5); R = (st >> 1) * 16 + swz / 64; C = (st & 1) * 32 + (swz % 64) / 2; }
DI int perm32(int rho) { const int n = rho >> 4, i = rho & 15; return 8 * (i >> 2) + 4 * n + (i & 3); }
struct Unit { int pm, pn, g; };

struct TileOrder {
    int nM, nN, nwg, G, c; const char* Ab; const char* Bb; size_t atile, btile;
    DI void init(int Mr, int N, int G_, int c_, const void* A, int lda, const void* Bt, int K) { nM = Mr / BM; nN = N / BM; nwg = nM * nN; G = G_; c = c_; Ab = (const char*)A; Bb = (const char*)Bt; atile = (size_t)BM * lda * 2; btile = (size_t)BM * K * 2; }
    DI bool next(int i, Unit& u) const {
        const int L = i * G + c; if (L >= nwg) return false;
        int wgid = L; { const int q = nwg / NXCD, r = nwg % NXCD, xcd = wgid % NXCD, off = wgid / NXCD; wgid = (xcd < r ? xcd * (q + 1) : r * (q + 1) + (xcd - r) * q) + off; }
        const int nig = WGM * nN, gid = wgid / nig, fm = gid * WGM, gsz = (nM - fm) < WGM ? (nM - fm) : WGM;
        u.pm = fm + ((wgid % nig) % gsz); u.pn = (wgid % nig) / gsz; u.g = 0; return true;
    }
    DI const char* A(const Unit& u) const { return Ab + (size_t)u.pm * atile; }
    DI const char* B(const Unit& u) const { return Bb + (size_t)u.pn * btile; }
};
struct GateOrder {
    int G, c; const char* Ab; const char* Bb;
    DI bool next(int i, Unit& u) const {
        const int L = i * G + c; if (L >= 1024) return false;
        const int id = (L & 7) * 128 + (L >> 3); u.g = id >> 7; u.pm = (id & 127) >> 1; u.pn = id & 1; return true;
    }
    DI const char* A(const Unit& u) const { const int dir = u.g >> 2, blk = u.g & 3; return Ab + (((size_t)dir * M + (size_t)u.pm * 256) * 1024 + blk * 256) * 2; }
    DI const char* B(const Unit& u) const { return Bb + ((size_t)u.g * 512 + u.pn * 256) * 256 * 2; }
};

template <class Epi, class Sched>
DI void gemm_phase(LAS unsigned char* lds, const int wid_s, const int K, const int lda, const Sched& S, const Epi& E) {
    int tid_ = get_tid(wid_s);
    const int tid = tid_, wid = __builtin_amdgcn_readfirstlane(tid >> 6), lane = tid & 63, wr = wid >> 2, wc = wid & 3, fr = lane & 15, fq = lane >> 4;
    const int nt = K / BK;
    unsigned voffA[2], voffB[2];
#pragma unroll
    for (int i = 0; i < 2; ++i) { int R, C; stage_rc(tid * 16 + i * 8192, R, C); const int Rb = (R & ~31) + perm32(R & 31);
        voffA[i] = (unsigned)(R * lda + C) * 2u; voffB[i] = (unsigned)(Rb * K + C) * 2u; }
    const size_t kstep = (size_t)(BK * 2);
    const size_t hstepA = (size_t)HALF * lda * 2, hstepB = (size_t)HALF * K * 2;
    const unsigned ldsw = (unsigned)wid * 1024u;
    const int aoff = lds_byte(wr * 64 + fr, fq * 8), boff = lds_byte(wc * 32 + fr, fq * 8);
#define PG8_SA(b, h) (((b) * 2 + (h)) * HTB)
#define PG8_SB(b, h) ((4 + (b) * 2 + (h)) * HTB)
#define PG8_STAGE(bufoff, gbase, voff) do { _Pragma("unroll") for (int _i = 0; _i < 2; ++_i) \
        __builtin_amdgcn_global_load_lds((const unsigned*)((const char*)(gbase) + (voff)[_i]), (LAS unsigned*)(lds + (bufoff) + ldsw + _i * 8192), 16, 0, 0); } while (0)
#define PG8_LDA(dst, b, h) do { _Pragma("unroll") for (int m = 0; m < 4; ++m) _Pragma("unroll") for (int k = 0; k < 2; ++k) dst[m][k] = *(const LAS bf16x8*)(lds + PG8_SA(b, h) + aoff + m * 2048 + k * 1024); } while (0)
#define PG8_LDB(dst, b, h) do { _Pragma("unroll") for (int n = 0; n < 2; ++n) _Pragma("unroll") for (int k = 0; k < 2; ++k) dst[n][k] = *(const LAS bf16x8*)(lds + PG8_SB(b, h) + boff + n * 2048 + k * 1024); } while (0)
#define PG8_MMA(ai, bj, At, Bt) do { __builtin_amdgcn_s_setprio(1); _Pragma("unroll") for (int m = 0; m < 4; ++m) _Pragma("unroll") for (int n = 0; n < 2; ++n) _Pragma("unroll") for (int k = 0; k < 2; ++k) \
        acc[ai][bj][m][n] = __builtin_amdgcn_mfma_f32_16x16x32_bf16(Bt[n][k], At[m][k], acc[ai][bj][m][n], 0, 0, 0); __builtin_amdgcn_s_setprio(0); } while (0)
#define PG8_WAIT_V(n) asm volatile("s_waitcnt vmcnt(" #n ")" ::: "memory")
#define PG8_WAIT_L(n) asm volatile("s_waitcnt lgkmcnt(" #n ")" ::: "memory")
#define PG8_BAR __builtin_amdgcn_s_barrier()
#define PG8_SCHED __builtin_amdgcn_sched_barrier(0)
    PG8_SCHED;
    Unit cur, nxt; int ui = 0;
    if (!S.next(0, cur)) return;
    f32x4 acc[2][2][4][2];
#pragma unroll
    for (int a = 0; a < 2; ++a)
#pragma unroll
        for (int b = 0; b < 2; ++b)
#pragma unroll
            for (int m = 0; m < 4; ++m)
#pragma unroll
                for (int n = 0; n < 2; ++n) acc[a][b][m][n] = (f32x4){0.f, 0.f, 0.f, 0.f};
    bf16x8 At[4][2], B0[2][2], B1[2][2];
    const char* cA = S.A(cur); const char* cB = S.B(cur);
    PG8_STAGE(PG8_SB(0, 0), cB, voffB); PG8_STAGE(PG8_SB(0, 1), cB + hstepB, voffB); PG8_STAGE(PG8_SA(0, 0), cA, voffA); PG8_STAGE(PG8_SA(0, 1), cA + hstepA, voffA);
    if (wr == 1) PG8_BAR;
    PG8_WAIT_V(2); PG8_BAR;
    PG8_STAGE(PG8_SB(1, 0), cB + kstep, voffB); PG8_STAGE(PG8_SA(1, 0), cA + kstep, voffA); PG8_STAGE(PG8_SB(1, 1), cB + hstepB + kstep, voffB);
    PG8_WAIT_V(6); PG8_BAR;
    for (;;) {
        const bool has_next = S.next(ui + 1, nxt);
        const char* nA = has_next ? S.A(nxt) : cA; const char* nB = has_next ? S.B(nxt) : cB;
        for (int t = 0; t < nt; t += 2) {
            const bool last = (t == nt - 2);
            const char* a1 = cA + (size_t)(t + 1) * kstep;
            const char* a2 = last ? nA : cA + (size_t)(t + 2) * kstep; const char* b2 = last ? nB : cB + (size_t)(t + 2) * kstep;
            const char* a3 = a2 + kstep; const char* b3 = b2 + kstep;
            PG8_LDB(B0, 0, 0); PG8_LDB(B1, 0, 1); PG8_SCHED; PG8_LDA(At, 0, 0); PG8_STAGE(PG8_SA(1, 1), a1 + hstepA, voffA);
            PG8_WAIT_V(8); PG8_WAIT_L(0); PG8_BAR; PG8_MMA(0, 0, At, B0); PG8_MMA(0, 1, At, B1); PG8_BAR; PG8_SCHED;
            PG8_LDA(At, 0, 1); PG8_STAGE(PG8_SB(0, 0), b2, voffB); PG8_STAGE(PG8_SB(0, 1), b2 + hstepB, voffB); PG8_STAGE(PG8_SA(0, 0), a2, voffA);
            PG8_WAIT_V(8); PG8_WAIT_L(0); PG8_BAR; PG8_MMA(1, 0, At, B0); PG8_MMA(1, 1, At, B1); PG8_BAR; PG8_SCHED;
            PG8_LDB(B0, 1, 0); PG8_LDB(B1, 1, 1); PG8_SCHED; PG8_LDA(At, 1, 0); PG8_STAGE(PG8_SA(0, 1), a2 + hstepA, voffA);
            PG8_WAIT_V(8); PG8_WAIT_L(0); PG8_BAR; PG8_MMA(0, 0, At, B0); PG8_MMA(0, 1, At, B1); PG8_BAR; PG8_SCHED;
            PG8_LDA(At, 1, 1); PG8_STAGE(PG8_SB(1, 0), b3, voffB); PG8_STAGE(PG8_SB(1, 1), b3 + hstepB, voffB); PG8_STAGE(PG8_SA(1, 0), a3, voffA);
            PG8_WAIT_V(8); PG8_WAIT_L(0); PG8_BAR; PG8_MMA(1, 0, At, B0); PG8_MMA(1, 1, At, B1); PG8_BAR; PG8_SCHED;
        }
        if (wr == 0) PG8_BAR;
        E(acc, cur, wr, wc, fr, fq);
        if (!has_next) break;
#pragma unroll
        for (int a = 0; a < 2; ++a)
#pragma unroll
            for (int b = 0; b < 2; ++b)
#pragma unroll
                for (int m = 0; m < 4; ++m)
#pragma unroll
                    for (int n = 0; n < 2; ++n) acc[a][b][m][n] = (f32x4){0.f, 0.f, 0.f, 0.f};
        cur = nxt; cA = nA; cB = nB; ++ui;
        if (wr == 1) PG8_BAR;
    }
    PG8_WAIT_V(0);
    PG8_BAR;
    PG8_SCHED;
#undef PG8_SA
#undef PG8_SB
#undef PG8_STAGE
#undef PG8_LDA
#undef PG8_LDB
#undef PG8_MMA
#undef PG8_WAIT_V
#undef PG8_WAIT_L
#undef PG8_BAR
#undef PG8_SCHED
}
}
using pg8::Unit;
typedef f32x4 AccT[2][2][4][2];
#define EPI_ARGS const f32x4 (&acc)[2][2][4][2], const Unit& u, int wr, int wc, int fr, int fq
#define EPI_FOR_ROWS _Pragma("unroll") for (int ai = 0; ai < 2; ++ai) _Pragma("unroll") for (int m = 0; m < 4; ++m)
#define EPI_ROW (u.pm * 256 + ai * 128 + wr * 64 + m * 16 + fr)
#define EPI_V8(bj) { acc[ai][bj][m][0][0], acc[ai][bj][m][0][1], acc[ai][bj][m][0][2], acc[ai][bj][m][0][3], acc[ai][bj][m][1][0], acc[ai][bj][m][1][1], acc[ai][bj][m][1][2], acc[ai][bj][m][1][3] }

struct EpiIn {
    bf16* Z; const float* rope;
    DI void operator()(EPI_ARGS) const {
        const int pn = u.pn; size_t base; int ldc, colt, mode;
        if (pn < 4) { base = Z_Q; ldc = 1024; colt = pn * 256; mode = 0; }
        else if (pn == 4) { base = Z_K; ldc = 256; colt = 0; mode = 0; }
        else if (pn == 5) { base = Z_V; ldc = 256; colt = 0; mode = 1; }
        else { const int arr = (pn - 6) >> 2; base = (size_t)M * (1536 + 1024 * arr); ldc = 1024; colt = ((pn - 6) & 3) * 256; mode = arr == 0 ? 1 : (arr == 1 ? 2 : 3); }
        const float qs = pn < 4 ? QSCALE : 1.f;
        const bool rope_w = (mode == 0) && (wc == 0);
        EPI_FOR_ROWS {
            const int row = EPI_ROW;
            bf16* rowp = Z + base + (size_t)row * ldc + colt + wc * 32 + 8 * fq;
            f32x4 cs[4];
            if (rope_w) { const f32x4* rp = (const f32x4*)(rope + ((row & (SEQ - 1)) * 16 + 8 * (fq & 1)) * 2);
#pragma unroll
                for (int i = 0; i < 4; ++i) cs[i] = rp[i]; }
#pragma unroll
            for (int bj = 0; bj < 2; ++bj) {
                float v[8] = EPI_V8(bj);
                if (mode == 0) {
                    if (rope_w) {
#pragma unroll
                        for (int e = 0; e < 8; ++e) { const float pr = shx(v[e], 32, fq * 16 + fr); const float cc = cs[e >> 1][(e & 1) * 2], ss = cs[e >> 1][(e & 1) * 2 + 1];
                            v[e] = v[e] * cc + (fq < 2 ? -pr * ss : pr * ss); }
                    }
#pragma unroll
                    for (int e = 0; e < 8; ++e) v[e] *= qs;
                } else if (mode == 2) {
#pragma unroll
                    for (int e = 0; e < 8; ++e) v[e] = gelu_t(v[e]);
                } else if (mode == 3) {
#pragma unroll
                    for (int e = 0; e < 8; ++e) v[e] = sigm(v[e]);
                }
                *(u32x4*)(rowp + bj * 128) = pack8(v);
            }
        }
    }
};
struct EpiGate {
    const bf16* XFB; bf16* LA; bf16* U; const float* b_a; const float* b_x; const float* lam;
    DI void operator()(EPI_ARGS) const {
        const int dir = u.g >> 2, blk = u.g & 3;
        const int ch0 = blk * 256 + u.pn * 128 + wc * 32 + 8 * fq;
        float ba[8], bx[8], cl[8];
#pragma unroll
        for (int e = 0; e < 8; ++e) { ba[e] = b_a[dir * 1024 + ch0 + e]; bx[e] = b_x[dir * 1024 + ch0 + e];
            const float l = lam[dir * 1024 + ch0 + e]; cl[e] = -8.f * __builtin_amdgcn_logf(1.f + __builtin_amdgcn_exp2f(-LOG2E * l)); }
        EPI_FOR_ROWS {
            const int row = EPI_ROW; const int t = row & (SEQ - 1);
            const bool start = dir ? (t == SEQ - 1) : (t == 0);
            const size_t off = ((size_t)dir * M + row) * 1024 + ch0;
            float x[8]; unpack8(*(const u32x4*)(XFB + off), x);
            const float va[8] = EPI_V8(0); const float vx[8] = EPI_V8(1);
            float la[8], uu[8];
#pragma unroll
            for (int e = 0; e < 8; ++e) { const float ra = sigm(va[e] + ba[e]), gx = sigm(vx[e] + bx[e]); la[e] = ra * cl[e];
                const float mult = start ? 1.f : __builtin_amdgcn_sqrtf(fmaxf(1.f - __builtin_amdgcn_exp2f(2.f * la[e]), 0.f)); uu[e] = x[e] * gx * mult; }
            *(u32x4*)(LA + off) = pack8(la); *(u32x4*)(U + off) = pack8(uu);
            __builtin_amdgcn_sched_barrier(0);
        }
    }
};
enum { EP_PA = 0, EP_PR, EP_OUT, EP_PLE1, EP_PLE2, EP_DOWN, EP_UP };
template <int MODE> struct EpiX {
    float* F;
    float* TR;
    const bf16* S;
    bf16* O;
    DI void operator()(EPI_ARGS) const {
        EPI_FOR_ROWS {
            const int row = EPI_ROW;
#pragma unroll
            for (int bj = 0; bj < 2; ++bj) {
                const int col = u.pn * 256 + bj * 128 + wc * 32 + 8 * fq;
                float v[8] = EPI_V8(bj);
                if constexpr (MODE == EP_UP) { *(u32x4*)(O + (size_t)row * (2 * DFF) + col) = pack8(v); }
                else {
                    const size_t off = (size_t)row * 1024 + col;
                    if constexpr (MODE == EP_PA) { float s[8]; unpack8(*(const u32x4*)(S + off), s);
                        *(f32x4*)(F + off) = (f32x4){v[0] * s[0], v[1] * s[1], v[2] * s[2], v[3] * s[3]}; *(f32x4*)(F + off + 4) = (f32x4){v[4] * s[4], v[5] * s[5], v[6] * s[6], v[7] * s[7]}; }
                    if constexpr (MODE == EP_PR) { float s[8]; unpack8(*(const u32x4*)(S + off), s); const f32x4 t0 = *(const f32x4*)(F + off), t1 = *(const f32x4*)(F + off + 4);
                        float r[8] = {t0[0] + v[0] * s[0], t0[1] + v[1] * s[1], t0[2] + v[2] * s[2], t0[3] + v[3] * s[3], t1[0] + v[4] * s[4], t1[1] + v[5] * s[5], t1[2] + v[6] * s[6], t1[3] + v[7] * s[7]};
                        *(u32x4*)(O + off) = pack8(r); }
                    if constexpr (MODE == EP_OUT) { const f32x4 t0 = *(const f32x4*)(F + off), t1 = *(const f32x4*)(F + off + 4);
                        *(f32x4*)(F + off) = (f32x4){DN_ALPHA * t0[0] + v[0], DN_ALPHA * t0[1] + v[1], DN_ALPHA * t0[2] + v[2], DN_ALPHA * t0[3] + v[3]};
                        *(f32x4*)(F + off + 4) = (f32x4){DN_ALPHA * t1[0] + v[4], DN_ALPHA * t1[1] + v[5], DN_ALPHA * t1[2] + v[6], DN_ALPHA * t1[3] + v[7]}; }
                    if constexpr (MODE == EP_PLE1) { *(f32x4*)(F + off) = (f32x4){v[0], v[1], v[2], v[3]}; *(f32x4*)(F + off + 4) = (f32x4){v[4], v[5], v[6], v[7]}; }
                    if constexpr (MODE == EP_PLE2) { const f32x4 p0 = *(const f32x4*)(F + off), p1 = *(const f32x4*)(F + off + 4); const f32x4 t0 = *(const f32x4*)(TR + off), t1 = *(const f32x4*)(TR + off + 4);
                        *(f32x4*)(TR + off) = (f32x4){DN_ALPHA * t0[0] + sigm(v[0]) * p0[0], DN_ALPHA * t0[1] + sigm(v[1]) * p0[1], DN_ALPHA * t0[2] + sigm(v[2]) * p0[2], DN_ALPHA * t0[3] + sigm(v[3]) * p0[3]};
                        *(f32x4*)(TR + off + 4) = (f32x4){DN_ALPHA * t1[0] + sigm(v[4]) * p1[0], DN_ALPHA * t1[1] + sigm(v[5]) * p1[1], DN_ALPHA * t1[2] + sigm(v[6]) * p1[2], DN_ALPHA * t1[3] + sigm(v[7]) * p1[3]}; }
                    if constexpr (MODE == EP_DOWN) { const f32x4 t0 = *(const f32x4*)(F + off), t1 = *(const f32x4*)(F + off + 4);
                        *(f32x4*)(F + off) = (f32x4){t0[0] + v[0], t0[1] + v[1], t0[2] + v[2], t0[3] + v[3]}; *(f32x4*)(F + off + 4) = (f32x4){t1[0] + v[4], t1[1] + v[5], t1[2] + v[6], t1[3] + v[7]}; }
                }
            }
            if constexpr (MODE == EP_PLE2 || MODE == EP_PR) __builtin_amdgcn_sched_barrier(0);
            else if constexpr (MODE != EP_UP && MODE != EP_PLE1) { if (m & 1) __builtin_amdgcn_sched_barrier(0); }
        }
    }
};

DI void ln_rows(const float* src, float* dstf, bf16* dstb, const float* g, const float* bt, int gw, int NGW, int lane) {
    for (int mrow = gw; mrow < M; mrow += NGW) {
        const f32x4* xr = (const f32x4*)(src + (size_t)mrow * D) + lane;
        f32x4 v[4]; float s = 0.f;
#pragma unroll
        for (int j = 0; j < 4; ++j) { v[j] = xr[64 * j]; s += (v[j].x + v[j].y) + (v[j].z + v[j].w); }
        const float mean = wave_sum(s, lane) * (1.f / D); float s2 = 0.f;
#pragma unroll
        for (int j = 0; j < 4; ++j) { v[j] = v[j] - mean; s2 += (v[j].x * v[j].x + v[j].y * v[j].y) + (v[j].z * v[j].z + v[j].w * v[j].w); }
        const float rstd = __builtin_amdgcn_rsqf(wave_sum(s2, lane) * (1.f / D) + LN_EPS);
        f32x4* of = (f32x4*)(dstf + (size_t)mrow * D) + lane; u32x2* ob = (u32x2*)(dstb + (size_t)mrow * D) + lane;
#pragma unroll
        for (int j = 0; j < 4; ++j) { const f32x4 gg = ((const f32x4*)g)[lane + 64 * j], bb = ((const f32x4*)bt)[lane + 64 * j];
            const f32x4 y = v[j] * rstd * gg + bb; of[64 * j] = y; ob[64 * j] = (u32x2){pk2(y.x, y.y), pk2(y.z, y.w)}; }
    }
}
DI void tr_item(const float* W, int N, bf16* WT, int ldt, int rowmode, int dup, LAS float* scr, int kb, int nb, int lane) {
    const int k0 = 64 * kb, n0 = 32 * nb;
#pragma unroll 8
    for (int i = 0; i < 32; ++i) { const int kk = 2 * i + (lane >> 5); scr[kk * 33 + (lane & 31)] = W[(size_t)(k0 + kk) * N + n0 + (lane & 31)]; }
    LDS_WAIT(); asm volatile("" ::: "memory");
    const int c = lane & 7;
#pragma unroll
    for (int j = 0; j < 4; ++j) { const int n = (lane >> 3) + 8 * j; const LAS float* s = scr + (8 * c) * 33 + n;
        u32x4 o; o.x = pk2(s[0 * 33], s[1 * 33]); o.y = pk2(s[2 * 33], s[3 * 33]); o.z = pk2(s[4 * 33], s[5 * 33]); o.w = pk2(s[6 * 33], s[7 * 33]);
        const int nn = n0 + n; const int row = rowmode == 0 ? nn : ((nn >> 7) * 256 + (rowmode - 1) * 128 + (nn & 127));
        *(u32x4*)(WT + (size_t)row * ldt + k0 + 8 * c) = o; if (dup) *(u32x4*)(WT + (size_t)row * ldt + 1024 + k0 + 8 * c) = o; }
    LDS_WAIT(); asm volatile("" ::: "memory");
}
struct InPtrs { const float* in[26]; };
DI void convert_layer(const InPtrs& I, unsigned char* ws, int l, LAS unsigned char* lds, int gw, int NGW, int wave, int lane) {
    LAS float* scr = (LAS float*)(lds + wave * 8448);
    bf16* Wb = (bf16*)(ws + WS_W);
    constexpr int I_IN = 16 * 176, I_G = 32, I_SQ = 16 * 32, I_UP = 16 * 192, I_DN = 48 * 32, I_PLE = 4 * 32;
    constexpr int NIT = I_IN + 16 * I_G + 3 * I_SQ + I_UP + I_DN + I_PLE + I_SQ;
    for (int it = gw; it < NIT; it += NGW) {
        int r = it;
        if (r < I_IN) { tr_item(I.in[4] + (size_t)l * D * DIN, DIN, Wb + W_IN, D, 0, 0, scr, r / 176, r % 176, lane); continue; } r -= I_IN;
        if (r < 8 * I_G) { const int g = r / I_G, q = r % I_G; tr_item(I.in[8] + ((size_t)l * 8 + g) * 65536, 256, Wb + W_G + (size_t)g * 512 * 256, 256, 1, 0, scr, q / 8, q % 8, lane); continue; } r -= 8 * I_G;
        if (r < 8 * I_G) { const int g = r / I_G, q = r % I_G; tr_item(I.in[10] + ((size_t)l * 8 + g) * 65536, 256, Wb + W_G + (size_t)g * 512 * 256, 256, 2, 0, scr, q / 8, q % 8, lane); continue; } r -= 8 * I_G;
        if (r < I_SQ) { tr_item(I.in[13] + (size_t)l * D * D, D, Wb + W_PA, D, 0, 0, scr, r / 32, r % 32, lane); continue; } r -= I_SQ;
        if (r < I_SQ) { tr_item(I.in[14] + (size_t)l * D * D, D, Wb + W_PR, 2 * D, 0, 1, scr, r / 32, r % 32, lane); continue; } r -= I_SQ;
        if (r < I_SQ) { tr_item(I.in[15] + (size_t)l * D * D, D, Wb + W_O, D, 0, 0, scr, r / 32, r % 32, lane); continue; } r -= I_SQ;
        if (r < I_UP) { tr_item(I.in[18] + (size_t)l * D * 2 * DFF, 2 * DFF, Wb + W_UP, D, 0, 0, scr, r / 192, r % 192, lane); continue; } r -= I_UP;
        if (r < I_DN) { tr_item(I.in[21] + (size_t)l * DFF * D, D, Wb + W_DN, DFF, 0, 0, scr, r / 32, r % 32, lane); continue; } r -= I_DN;
        if (r < I_PLE) { tr_item(I.in[22] + (size_t)l * DPLE * D, D, Wb + W_PLE, DPLE, 0, 0, scr, r / 32, r % 32, lane); continue; } r -= I_PLE;
        tr_item(I.in[23] + (size_t)l * D * D, D, Wb + W_PG, D, 0, 0, scr, r / 32, r % 32, lane);
    }
    const float* P = I.in[1] + (size_t)l * M * DPLE; bf16* PB = (bf16*)(ws + WS_PB);
    for (size_t i = (size_t)gw * 64 + lane; i < (size_t)M * DPLE / 8; i += (size_t)NGW * 64) {
        const f32x4 a = ((const f32x4*)P)[2 * i], b = ((const f32x4*)P)[2 * i + 1];
        ((u32x4*)PB)[i] = (u32x4){pk2(a.x, a.y), pk2(a.z, a.w), pk2(b.x, b.y), pk2(b.z, b.w)};
    }
}
DI void rope_table(float* rope, int gtid, int nthr) {
    for (int i = gtid; i < SEQ * 16; i += nthr) {
        const int pos = i >> 4, j = i & 15;
        const float inv = exp2f(-(float)j * (18.931568569324174f / 16.0f));
        const float ang = (float)pos * inv;
        const double rev = (double)ang * 0.15915494309189535; const float fr = (float)(rev - floor(rev));
        rope[2 * i] = __builtin_amdgcn_cosf(fr); rope[2 * i + 1] = __builtin_amdgcn_sinf(fr);
    }
}
DI void conv_phase(const int wid_s, const bf16* xr, bf16* XFB, const float* cw, const float* cb, int c, int G) {
    const int tid = get_tid(wid_s); const int cg8 = (tid & 127) * 8, sub = tid >> 7;
    for (int it = c; it < M / 32; it += G) {
        const int r0 = it * 32 + sub * 8; const int t0 = r0 & (SEQ - 1);
        u32x4 xin[14];
#pragma unroll
        for (int i = 0; i < 14; ++i) { const int t = t0 - 3 + i; xin[i] = (t >= 0 && t < SEQ) ? *(const u32x4*)(xr + (size_t)(r0 - 3 + i) * 1024 + cg8) : (u32x4){0u, 0u, 0u, 0u}; }
#pragma unroll
        for (int dir = 0; dir < 2; ++dir) {
            float w[4][8], b8[8];
#pragma unroll
            for (int k = 0; k < 4; ++k) { const f32x4 w0 = *(const f32x4*)(cw + (dir * 4 + k) * 1024 + cg8), w1 = *(const f32x4*)(cw + (dir * 4 + k) * 1024 + cg8 + 4);
                w[k][0] = w0.x; w[k][1] = w0.y; w[k][2] = w0.z; w[k][3] = w0.w; w[k][4] = w1.x; w[k][5] = w1.y; w[k][6] = w1.z; w[k][7] = w1.w; }
            { const f32x4 w0 = *(const f32x4*)(cb + dir * 1024 + cg8), w1 = *(const f32x4*)(cb + dir * 1024 + cg8 + 4);
                b8[0] = w0.x; b8[1] = w0.y; b8[2] = w0.z; b8[3] = w0.w; b8[4] = w1.x; b8[5] = w1.y; b8[6] = w1.z; b8[7] = w1.w; }
#pragma unroll
            for (int j = 0; j < 8; ++j) {
                float o[8];
#pragma unroll
                for (int e = 0; e < 8; ++e) o[e] = b8[e];
#pragma unroll
                for (int k = 0; k < 4; ++k) { float xv[8]; unpack8(xin[dir ? (j + 3 + k) : (j + 3 - k)], xv);
#pragma unroll
                    for (int e = 0; e < 8; ++e) o[e] += w[k][e] * xv[e]; }
                *(u32x4*)(XFB + ((size_t)dir * M + r0 + j) * 1024 + cg8) = pack8(o);
            }
        }
    }
}
DI void attn_phase(const int wid_s, LAS unsigned char* lds, const bf16* zq, const bf16* zk, const bf16* zv, bf16* att, const float* sink, int c, int G) {
    const int tid = get_tid(wid_s); const int w = wid_s, lane = tid & 63, l32 = lane & 31, h = lane >> 5;
    LAS unsigned char* Ks = lds;
    LAS unsigned char* Vt = lds + 34816;
    for (int L = c; L < 512; L += G) {
        const int it = (L & 7) * 64 + (L >> 3);
        const int pair = it & 1, kvh = (it >> 1) & 1, n = (it >> 2) & 15, b = it >> 6;
        const int hq = kvh * 4 + pair * 2 + (w >> 2);
        const int qrl = (w & 3) * 32 + l32;
        const size_t qrow = (size_t)b * SEQ + n * 128 + qrl;
        bf16x8 qf[8];
#pragma unroll
        for (int c8 = 0; c8 < 8; ++c8) qf[c8] = *(const bf16x8*)(zq + qrow * 1024 + hq * 128 + c8 * 16 + h * 8);
        float mrun = sink[hq] * LOG2E, lrun = 1.f;
        f32x16 o[4];
#pragma unroll
        for (int dd = 0; dd < 4; ++dd)
#pragma unroll
            for (int i = 0; i < 16; ++i) o[dd][i] = 0.f;
        for (int kc = 0; kc < 3; ++kc) {
            const int kb = n - 1 + kc; if (kb < 0 || kb > 15) continue;
            __syncthreads();
            const size_t krow0 = (size_t)b * SEQ + kb * 128;
#pragma unroll
            for (int i = 0; i < 4; ++i) { const int piece = tid + i * 512; const int r = piece >> 4, cc = piece & 15;
                const u32x4 kv = *(const u32x4*)(zk + (krow0 + r) * 256 + kvh * 128 + cc * 8);
                *(LAS u32x4*)(Ks + r * 272 + cc * 16) = kv; }
#pragma unroll
            for (int i = 0; i < 4; ++i) { const int piece = tid + i * 512; const int r = piece & 127, cc = piece >> 7;
                const u32x4 vv = *(const u32x4*)(zv + (krow0 + r) * 256 + kvh * 128 + cc * 8);
#pragma unroll
                for (int e = 0; e < 8; ++e) { const unsigned wv = vv[e >> 1]; *(LAS unsigned short*)(Vt + (cc * 8 + e) * 264 + r * 2) = (unsigned short)((e & 1) ? (wv >> 16) : (wv & 0xffffu)); } }
            __syncthreads();
            f32x16 s[4];
#pragma unroll
            for (int j = 0; j < 4; ++j) {
#pragma unroll
                for (int i = 0; i < 16; ++i) s[j][i] = 0.f;
#pragma unroll
                for (int c8 = 0; c8 < 8; ++c8) { const bf16x8 kf = *(const LAS bf16x8*)(Ks + (j * 32 + l32) * 272 + c8 * 32 + h * 16);
                    s[j] = __builtin_amdgcn_mfma_f32_32x32x16_bf16(kf, qf[c8], s[j], 0, 0, 0); }
            }
            if (kc != 1) {
                int hb = (kc == 0) ? (4 * h - qrl) : (qrl - 4 * h); asm volatile("" : "+v"(hb));
#pragma unroll
                for (int j = 0; j < 4; ++j)
#pragma unroll
                    for (int i = 0; i < 16; ++i) { const int ko = j * 32 + (i & 3) + 8 * (i >> 2); const int dlt = (kc == 0) ? (hb + ko) : (hb - ko); const unsigned t = (unsigned)(dlt >> 31);
                        s[j][i] = __uint_as_float((__float_as_uint(s[j][i]) & ~t) | (0xF149F2CAu & t)); }
            }
            float mx = -3e38f;
#pragma unroll
            for (int j = 0; j < 4; ++j)
#pragma unroll
                for (int i = 0; i < 16; ++i) mx = fmaxf(mx, s[j][i]);
            mx = fmaxf(mx, shx(mx, 32, lane));
            const float mnew = fmaxf(mrun, mx); const float alpha = __builtin_amdgcn_exp2f(mrun - mnew); mrun = mnew;
            float psum = 0.f;
#pragma unroll
            for (int j = 0; j < 4; ++j)
#pragma unroll
                for (int i = 0; i < 16; ++i) { const float p = __builtin_amdgcn_exp2f(s[j][i] - mnew); s[j][i] = p; psum += p; }
            psum += shx(psum, 32, lane);
            lrun = lrun * alpha + psum;
#pragma unroll
            for (int dd = 0; dd < 4; ++dd)
#pragma unroll
                for (int i = 0; i < 16; ++i) o[dd][i] *= alpha;
#pragma unroll
            for (int j = 0; j < 4; ++j)
#pragma unroll
                for (int s2 = 0; s2 < 2; ++s2) {
                    u32x4 pw; pw.x = pk2(s[j][8 * s2 + 0], s[j][8 * s2 + 1]); pw.y = pk2(s[j][8 * s2 + 2], s[j][8 * s2 + 3]); pw.z = pk2(s[j][8 * s2 + 4], s[j][8 * s2 + 5]); pw.w = pk2(s[j][8 * s2 + 6], s[j][8 * s2 + 7]);
                    const bf16x8 pf = __builtin_bit_cast(bf16x8, pw);
#pragma unroll
                    for (int dd = 0; dd < 4; ++dd) { const LAS unsigned char* vp = Vt + (dd * 32 + l32) * 264 + (j * 32 + 16 * s2 + 4 * h) * 2;
                        const u32x2 lo = *(const LAS u32x2*)vp, hi = *(const LAS u32x2*)(vp + 16);
                        const u32x4 vw = {lo.x, lo.y, hi.x, hi.y};
                        o[dd] = __builtin_amdgcn_mfma_f32_32x32x16_bf16(__builtin_bit_cast(bf16x8, vw), pf, o[dd], 0, 0, 0); }
                }
        }
        const float inv = __builtin_amdgcn_rcpf(lrun);
        bf16* op = att + qrow * 1024 + hq * 128;
#pragma unroll
        for (int dd = 0; dd < 4; ++dd)
#pragma unroll
            for (int i4 = 0; i4 < 4; ++i4) { const int d0 = dd * 32 + 8 * i4 + 4 * h;
                *(u32x2*)(op + d0) = (u32x2){pk2(o[dd][4 * i4] * inv, o[dd][4 * i4 + 1] * inv), pk2(o[dd][4 * i4 + 2] * inv, o[dd][4 * i4 + 3] * inv)}; }
    }
}
DI void scan_phase(const int wid_s, LAS unsigned char* lds, const bf16* LA, const bf16* U, const bf16* gy, bf16* HG, int c, int G) {
    const int tid = get_tid(wid_s); const int w = wid_s, lane = tid & 63, cp = lane & 31, half = lane >> 5, sgi = 2 * w + half;
    LAS float* sP = (LAS float*)lds; LAS float* sH = sP + 16 * 64;
    for (int it = c; it < 256; it += G) {
        const int cgp = it & 15, dir = (it >> 4) & 1, b = it >> 5;
        const int ch = cgp * 64 + cp * 2;
        const size_t rb = (size_t)b * SEQ;
        const bf16* la = LA + ((size_t)dir * M + rb) * 1024 + ch; const bf16* uu = U + ((size_t)dir * M + rb) * 1024 + ch;
        const bf16* gp = gy + rb * 1024 + ch; bf16* hp = HG + rb * 2048 + dir * 1024 + ch;
        const int sbase = sgi * 128;
        float P0 = 1.f, P1 = 1.f, H0 = 0.f, H1 = 0.f;
        for (int j0 = 0; j0 < 128; j0 += 8) {
            unsigned lv[8], uv[8];
#pragma unroll
            for (int j = 0; j < 8; ++j) { const int sidx = sbase + j0 + j; const int t = dir ? (SEQ - 1 - sidx) : sidx; lv[j] = *(const unsigned*)(la + (size_t)t * 1024); uv[j] = *(const unsigned*)(uu + (size_t)t * 1024); }
#pragma unroll
            for (int j = 0; j < 8; ++j) { const float a0 = __builtin_amdgcn_exp2f(bflo(lv[j])), a1 = __builtin_amdgcn_exp2f(bfhi(lv[j]));
                H0 = a0 * H0 + bflo(uv[j]); H1 = a1 * H1 + bfhi(uv[j]); P0 *= a0; P1 *= a1; }
        }
        __syncthreads();
        sP[sgi * 64 + cp * 2] = P0; sP[sgi * 64 + cp * 2 + 1] = P1; sH[sgi * 64 + cp * 2] = H0; sH[sgi * 64 + cp * 2 + 1] = H1;
        __syncthreads();
        float c0 = 0.f, c1 = 0.f;
        for (int s = 0; s < sgi; ++s) { c0 = sP[s * 64 + cp * 2] * c0 + sH[s * 64 + cp * 2]; c1 = sP[s * 64 + cp * 2 + 1] * c1 + sH[s * 64 + cp * 2 + 1]; }
        H0 = c0; H1 = c1;
        for (int j0 = 0; j0 < 128; j0 += 8) {
            unsigned lv[8], uv[8], gv[8];
#pragma unroll
            for (int j = 0; j < 8; ++j) { const int sidx = sbase + j0 + j; const int t = dir ? (SEQ - 1 - sidx) : sidx; lv[j] = *(const unsigned*)(la + (size_t)t * 1024); uv[j] = *(const unsigned*)(uu + (size_t)t * 1024); gv[j] = *(const unsigned*)(gp + (size_t)t * 1024); }
#pragma unroll
            for (int j = 0; j < 8; ++j) { const int sidx = sbase + j0 + j; const int t = dir ? (SEQ - 1 - sidx) : sidx;
                const float a0 = __builtin_amdgcn_exp2f(bflo(lv[j])), a1 = __builtin_amdgcn_exp2f(bfhi(lv[j]));
                H0 = a0 * H0 + bflo(uv[j]); H1 = a1 * H1 + bfhi(uv[j]);
                *(unsigned*)(hp + (size_t)t * 2048) = pk2(H0 * bflo(gv[j]), H1 * bfhi(gv[j])); }
        }
    }
}
DI void geglu_phase(const int wid_s, const bf16* UP, bf16* ACT, const float* fw, const float* fb, int c, int G) {
    const int nthr = G * 512; const int tid = get_tid(wid_s);
    for (int i = c * 512 + tid; i < (M / 8) * 384; i += nthr) {
        const int cg8 = (i % 384) * 8, r0 = (i / 384) * 8, t0 = r0 & (SEQ - 1);
        float w[3][8], b8[8];
#pragma unroll
        for (int k = 0; k < 3; ++k) { const f32x4 w0 = *(const f32x4*)(fw + k * DFF + cg8), w1 = *(const f32x4*)(fw + k * DFF + cg8 + 4);
            w[k][0] = w0.x; w[k][1] = w0.y; w[k][2] = w0.z; w[k][3] = w0.w; w[k][4] = w1.x; w[k][5] = w1.y; w[k][6] = w1.z; w[k][7] = w1.w; }
        { const f32x4 w0 = *(const f32x4*)(fb + cg8), w1 = *(const f32x4*)(fb + cg8 + 4); b8[0] = w0.x; b8[1] = w0.y; b8[2] = w0.z; b8[3] = w0.w; b8[4] = w1.x; b8[5] = w1.y; b8[6] = w1.z; b8[7] = w1.w; }
        u32x4 gin[10];
#pragma unroll
        for (int q = 0; q < 10; ++q) { const int t = t0 - 1 + q; gin[q] = (t >= 0 && t < SEQ) ? *(const u32x4*)(UP + (size_t)(r0 - 1 + q) * (2 * DFF) + cg8) : (u32x4){0u, 0u, 0u, 0u}; }
#pragma unroll
        for (int j = 0; j < 8; ++j) {
            float o[8], vv[8]; unpack8(*(const u32x4*)(UP + (size_t)(r0 + j) * (2 * DFF) + DFF + cg8), vv);
#pragma unroll
            for (int e = 0; e < 8; ++e) o[e] = b8[e];
#pragma unroll
            for (int k = 0; k < 3; ++k) { float xv[8]; unpack8(gin[j + k], xv);
#pragma unroll
                for (int e = 0; e < 8; ++e) o[e] += w[k][e] * xv[e]; }
#pragma unroll
            for (int e = 0; e < 8; ++e) o[e] = gelu_t(o[e]) * vv[e];
            *(u32x4*)(ACT + (size_t)(r0 + j) * DFF + cg8) = pack8(o);
        }
    }
}

struct Args { InPtrs I; float* out; unsigned char* ws; int ph_lo, ph_hi; };
#ifndef ONLY
#define ONLY -1
#endif
#define CASE_ON(n) if constexpr (ONLY < 0 || ONLY == (n))
constexpr int PH_PER_LAYER = 11, N_PHASES = 1 + DEPTH * PH_PER_LAYER;

__global__ void __launch_bounds__(512, 2) fwd_kernel(Args args) {
    extern __shared__ __attribute__((aligned(16))) unsigned char lds_raw[];
    LAS unsigned char* lds = (LAS unsigned char*)lds_raw;
    cg::grid_group grid = cg::this_grid();
    typedef const __attribute__((address_space(4))) unsigned char* kptr_t;
    const int wid_s = __builtin_amdgcn_readfirstlane((int)threadIdx.x >> 6);
    for (int ph = args.ph_lo; ph < args.ph_hi; ++ph) {
        kptr_t kp = (kptr_t)__builtin_amdgcn_kernarg_segment_ptr(); asm volatile("" : "+s"(kp));
        InPtrs I;
#pragma unroll
        for (int i = 0; i < 26; ++i) I.in[i] = *(const float* const __attribute__((address_space(4)))*)(kp + 8 * i);
        float* trunk = *(float* const __attribute__((address_space(4)))*)(kp + 208);
        unsigned char* ws = *(unsigned char* const __attribute__((address_space(4)))*)(kp + 216);
        const int wave = wid_s;
        int G = gridDim.x, c = blockIdx.x; asm volatile("" : "+s"(G), "+s"(c));
        const int gw = c * 8 + wave, NGW = G * 8;
        float* rope = (float*)(ws + WS_ROPE);
        bf16* Wb = (bf16*)(ws + WS_W); bf16* PB = (bf16*)(ws + WS_PB); bf16* HB = (bf16*)(ws + WS_HB); bf16* Z = (bf16*)(ws + WS_Z);
        bf16* ATT = (bf16*)(ws + WS_ATT); bf16* XFB = (bf16*)(ws + WS_XFB); bf16* UB = (bf16*)(ws + WS_EXTRA); float* T = (float*)(ws + WS_EXTRA);
        bf16* LAb = Z; bf16* HG = XFB; bf16* UP = Z; bf16* ACT = XFB;
        if (ph > args.ph_lo) grid.sync();
        if (ph == 0) { CASE_ON(100) {
            const int tid = get_tid(wid_s), lane = tid & 63;
            convert_layer(I, ws, 0, lds, gw, NGW, wave, lane);
            ln_rows(I.in[0], trunk, HB, I.in[2], I.in[3], gw, NGW, lane);
            rope_table(rope, c * 512 + tid, G * 512); }
            continue;
        }
        const int l = (ph - 1) / PH_PER_LAYER, k = (ph - 1) % PH_PER_LAYER;
        switch (k) {
        case 0: CASE_ON(0) {
            pg8::TileOrder S; S.init(M, DIN, G, c, HB, D, Wb + W_IN, D);
            EpiIn E{Z, rope};
            pg8::gemm_phase(lds, wid_s, D, D, S, E);
        } break;
        case 1: CASE_ON(1) {
            attn_phase(wid_s, lds, Z + Z_Q, Z + Z_K, Z + Z_V, ATT, I.in[5] + l * NH, c, G);
            conv_phase(wid_s, Z + Z_XR, XFB, I.in[6] + (size_t)l * 2 * 4 * D, I.in[7] + (size_t)l * 2 * D, c, G);
        } break;
        case 2: CASE_ON(2) {
            pg8::GateOrder S{G, c, (const char*)XFB, (const char*)(Wb + W_G)};
            EpiGate E{XFB, LAb, UB, I.in[9] + (size_t)l * 2 * D, I.in[11] + (size_t)l * 2 * D, I.in[12] + (size_t)l * 2 * D};
            pg8::gemm_phase(lds, wid_s, 256, 1024, S, E);
        } break;
        case 3: CASE_ON(3) {
            scan_phase(wid_s, lds, LAb, UB, Z + Z_GY, HG, c, G);
        } break;
        case 4: CASE_ON(4) {
#if !defined(SUB) || SUB==0
            { pg8::TileOrder S; S.init(M, D, G, c, ATT, D, Wb + W_PA, D); EpiX<EP_PA> E{T, nullptr, Z + Z_SA, nullptr}; pg8::gemm_phase(lds, wid_s, D, D, S, E); }
#endif
#if !defined(SUB) || SUB==1
            { pg8::TileOrder S; S.init(M, D, G, c, HG, 2 * D, Wb + W_PR, 2 * D); EpiX<EP_PR> E{T, nullptr, Z + Z_SR, HB}; pg8::gemm_phase(lds, wid_s, 2 * D, 2 * D, S, E); }
#endif
        } break;
        case 5: CASE_ON(5) {
            pg8::TileOrder S; S.init(M, D, G, c, HB, D, Wb + W_O, D); EpiX<EP_OUT> E{trunk, nullptr, nullptr, nullptr}; pg8::gemm_phase(lds, wid_s, D, D, S, E);
        } break;
        case 6: CASE_ON(6) {
            const int lane = get_tid(wid_s) & 63;
            ln_rows(trunk, trunk, HB, I.in[16] + (size_t)l * D, I.in[17] + (size_t)l * D, gw, NGW, lane);
        } break;
        case 7: CASE_ON(7) {
#if !defined(SUB7) || SUB7==0
            { pg8::TileOrder S; S.init(M, D, G, c, PB, DPLE, Wb + W_PLE, DPLE); EpiX<EP_PLE1> E{T, nullptr, nullptr, nullptr}; pg8::gemm_phase(lds, wid_s, DPLE, DPLE, S, E); }
#endif
#if !defined(SUB7) || SUB7==1
            { pg8::TileOrder S; S.init(M, D, G, c, HB, D, Wb + W_PG, D); EpiX<EP_PLE2> E{T, trunk, nullptr, nullptr}; pg8::gemm_phase(lds, wid_s, D, D, S, E); }
#endif
#if !defined(SUB7) || SUB7==2
            { pg8::TileOrder S; S.init(M, 2 * DFF, G, c, HB, D, Wb + W_UP, D); EpiX<EP_UP> E{nullptr, nullptr, nullptr, UP}; pg8::gemm_phase(lds, wid_s, D, D, S, E); }
#endif
        } break;
        case 8: CASE_ON(8) {
            geglu_phase(wid_s, UP, ACT, I.in[19] + (size_t)l * 3 * DFF, I.in[20] + (size_t)l * DFF, c, G);
        } break;
        case 9: CASE_ON(9) {
            pg8::TileOrder S; S.init(M, D, G, c, ACT, DFF, Wb + W_DN, DFF); EpiX<EP_DOWN> E{trunk, nullptr, nullptr, nullptr}; pg8::gemm_phase(lds, wid_s, DFF, DFF, S, E);
        } break;
        case 10: CASE_ON(10) {
            const int lane = get_tid(wid_s) & 63;
            ln_rows(trunk, trunk, HB, I.in[24] + (size_t)l * D, I.in[25] + (size_t)l * D, gw, NGW, lane);
            if (l + 1 < DEPTH) convert_layer(I, ws, l + 1, lds, gw, NGW, wave, lane);
        } break;
        }
    }
}

extern "C" void kernel_launch(void* const* d_in, const int* in_sizes, int n_in, void* d_out, int out_size, void* d_ws, size_t ws_size, hipStream_t stream) {
    static int grid = 0;
    if (grid == 0) {
        if (n_in != 26 || out_size != M * D || ws_size < WS_END) { fprintf(stderr, "kernel_launch: unexpected sizes n_in %d out %d ws %zu\n", n_in, out_size, ws_size); grid = -1; return; }
        int dev = 0, cus = 0, per_cu = 0;
        hipGetDevice(&dev); hipDeviceGetAttribute(&cus, hipDeviceAttributeMultiprocessorCount, dev);
        if (hipFuncSetAttribute((const void*)fwd_kernel, hipFuncAttributeMaxDynamicSharedMemorySize, LDS_BYTES) != hipSuccess) { fprintf(stderr, "kernel_launch: hipFuncSetAttribute failed\n"); grid = -1; return; }
        hipOccupancyMaxActiveBlocksPerMultiprocessor(&per_cu, (const void*)fwd_kernel, 512, LDS_BYTES);
        (void)hipGetLastError();
        if (per_cu < 1) per_cu = 1;
        grid = cus * 1;
        if (grid > 256) grid = 256;
        fprintf(stderr, "kernel_launch: cus %d per_cu %d grid %d ws %zu\n", cus, per_cu, grid, ws_size);
    }
    if (grid < 0) return;
    Args a{};
    for (int i = 0; i < 26; ++i) a.I.in[i] = (const float*)d_in[i];
    a.out = (float*)d_out; a.ws = (unsigned char*)d_ws; a.ph_lo = 0; a.ph_hi = N_PHASES;
    void* kargs[] = {&a};
    hipError_t e = hipLaunchCooperativeKernel((const void*)fwd_kernel, dim3(grid), dim3(512), kargs, LDS_BYTES, stream);
    if (e != hipSuccess) fprintf(stderr, "kernel_launch: cooperative launch failed: %s\n", hipGetErrorString(e));
}
```

```cpp
#include <hip/hip_runtime.h>
#include <hip/hip_cooperative_groups.h>
#include <cstdio>
#include <cstdint>
namespace cg = cooperative_groups;

#define LAS __attribute__((address_space(3)))
#define DI __device__ __forceinline__
typedef unsigned short bf16;
typedef short bf16x8 __attribute__((ext_vector_type(8)));
typedef float f32x4 __attribute__((ext_vector_type(4)));
typedef float f32x16 __attribute__((ext_vector_type(16)));
typedef unsigned u32x4 __attribute__((ext_vector_type(4)));
typedef unsigned u32x2 __attribute__((ext_vector_type(2)));
typedef __bf16 bf16x2_t __attribute__((ext_vector_type(2)));
typedef float f32x2_t __attribute__((ext_vector_type(2)));

constexpr int BATCH = 8, SEQ = 2048, D = 1024, DEPTH = 4, M = BATCH * SEQ;
constexpr int NH = 8, NKV = 2, HD = 128, DIN = 5632, DFF = 3072, DPLE = 256;
constexpr float LN_EPS = 1e-5f;
constexpr float DN_ALPHA = 1.6817928305074290f;
constexpr float LOG2E = 1.4426950408889634f;
constexpr float QSCALE = 0.08838834764831845f * LOG2E;

constexpr size_t MiB = 1u << 20;
constexpr size_t WS_ROPE = 0;
constexpr size_t WS_BAR = 512 * 1024;
constexpr size_t WS_W = 1 * MiB;
constexpr size_t W_IN = 0, W_G = W_IN + (size_t)DIN * D, W_PA = W_G + 8 * 512 * 256, W_PR = W_PA + (size_t)D * D, W_O = W_PR + (size_t)D * 2 * D,
                 W_UP = W_O + (size_t)D * D, W_DN = W_UP + (size_t)2 * DFF * D, W_PLE = W_DN + (size_t)D * DFF, W_PG = W_PLE + (size_t)D * DPLE, W_END = W_PG + (size_t)D * D;
static_assert(W_END * 2 <= 42 * MiB, "weights");
constexpr size_t WS_PB = WS_W + 42 * MiB;
constexpr size_t WS_HB = WS_PB + 8 * MiB;
constexpr size_t WS_Z = WS_HB + 32 * MiB;
constexpr size_t WS_ATT = WS_Z + 176 * MiB;
constexpr size_t WS_XFB = WS_ATT + 32 * MiB;
constexpr size_t WS_EXTRA = WS_XFB + 64 * MiB;
constexpr size_t WS_END = WS_EXTRA + 64 * MiB;
static_assert(WS_END <= 440 * MiB, "ws");
constexpr size_t Z_Q = 0, Z_K = (size_t)M * 1024, Z_V = (size_t)M * 1280, Z_XR = (size_t)M * 1536, Z_GY = (size_t)M * 2560, Z_SA = (size_t)M * 3584, Z_SR = (size_t)M * 4608;

constexpr int LDS_BYTES = 135168;

DI unsigned pk2(float lo, float hi) { f32x2_t v = {lo, hi}; bf16x2_t b = __builtin_convertvector(v, bf16x2_t); return __builtin_bit_cast(unsigned, b); }
DI float bflo(unsigned u) { return __uint_as_float(u << 16); }
DI float bfhi(unsigned u) { return __uint_as_float(u & 0xffff0000u); }
DI float sigm(float x) { return __builtin_amdgcn_rcpf(1.f + __builtin_amdgcn_exp2f(-LOG2E * x)); }
DI float gelu_t(float x) { const float u = 0.7978845608028654f * (x + 0.044715f * x * x * x); return x * sigm(2.f * u); }
DI void unpack8(const u32x4 w, float (&v)[8]) { v[0] = bflo(w.x); v[1] = bfhi(w.x); v[2] = bflo(w.y); v[3] = bfhi(w.y); v[4] = bflo(w.z); v[5] = bfhi(w.z); v[6] = bflo(w.w); v[7] = bfhi(w.w); }
DI u32x4 pack8(const float (&v)[8]) { u32x4 w; w.x = pk2(v[0], v[1]); w.y = pk2(v[2], v[3]); w.z = pk2(v[4], v[5]); w.w = pk2(v[6], v[7]); return w; }
DI float shx(float v, int mask, int lane) { return __int_as_float(__builtin_amdgcn_ds_bpermute((lane ^ mask) << 2, __float_as_int(v))); }
DI float wave_sum(float v, int lane) {
#pragma unroll
    for (int o = 1; o < 64; o <<= 1) v += shx(v, o, lane);
    return v;
}
DI int get_tid(int wid_s) { int l; asm volatile("v_mbcnt_lo_u32_b32 %0, -1, 0\n\tv_mbcnt_hi_u32_b32 %0, -1, %0" : "=v"(l)); return wid_s * 64 + l; }
#define LDS_WAIT() asm volatile("s_waitcnt lgkmcnt(0)" ::: "memory")

namespace pg8 {
constexpr int BM = 256, BK = 64, HALF = 128, HTB = HALF * BK * 2, NXCD = 8, WGM = 8;
DI int lds_byte(int r, int c) { const int st = (r >> 4) * 2 + (c >> 5), rr = r & 15, cc = c & 31, ob = rr * 64 + cc * 2; return st * 1024 + (ob ^ (((ob >> 9) & 1) << 5)); }
DI void stage_rc(int b, int& R, int& C) { const int st = b / 1024, sb = b % 1024, swz = sb ^ (((sb >> 9) & 1) << 5); R = (st >> 1) * 16 + swz / 64; C = (st & 1) * 32 + (swz % 64) / 2; }
DI int perm32(int rho) { const int n = rho >> 4, i = rho & 15; return 8 * (i >> 2) + 4 * n + (i & 3); }
struct Unit { int pm, pn, g; };

struct TileOrder {
    int nM, nN, nwg, G, c; const char* Ab; const char* Bb; size_t atile, btile;
    DI void init(int Mr, int N, int G_, int c_, const void* A, int lda, const void* Bt, int K) { nM = Mr / BM; nN = N / BM; nwg = nM * nN; G = G_; c = c_; Ab = (const char*)A; Bb = (const char*)Bt; atile = (size_t)BM * lda * 2; btile = (size_t)BM * K * 2; }
    DI bool next(int i, Unit& u) const {
        const int L = i * G + c; if (L >= nwg) return false;
        int wgid = L; { const int q = nwg / NXCD, r = nwg % NXCD, xcd = wgid % NXCD, off = wgid / NXCD; wgid = (xcd < r ? xcd * (q + 1) : r * (q + 1) + (xcd - r) * q) + off; }
        const int nig = WGM * nN, gid = wgid / nig, fm = gid * WGM, gsz = (nM - fm) < WGM ? (nM - fm) : WGM;
        u.pm = fm + ((wgid % nig) % gsz); u.pn = (wgid % nig) / gsz; u.g = 0; return true;
    }
    DI const char* A(const Unit& u) const { return Ab + (size_t)u.pm * atile; }
    DI const char* B(const Unit& u) const { return Bb + (size_t)u.pn * btile; }
};
struct GateOrder {
    int G, c; const char* Ab; const char* Bb;
    DI bool next(int i, Unit& u) const {
        const int L = i * G + c; if (L >= 1024) return false;
        const int id = (L & 7) * 128 + (L >> 3); u.g = id >> 7; u.pm = (id & 127) >> 1; u.pn = id & 1; return true;
    }
    DI const char* A(const Unit& u) const { const int dir = u.g >> 2, blk = u.g & 3; return Ab + (((size_t)dir * M + (size_t)u.pm * 256) * 1024 + blk * 256) * 2; }
    DI const char* B(const Unit& u) const { return Bb + ((size_t)u.g * 512 + u.pn * 256) * 256 * 2; }
};

template <class Epi, class Sched>
DI void gemm_phase(LAS unsigned char* lds, const int wid_s, const int K, const int lda, const Sched& S, const Epi& E) {
    int tid_ = get_tid(wid_s);
    const int tid = tid_, wid = __builtin_amdgcn_readfirstlane(tid >> 6), lane = tid & 63, wr = wid >> 2, wc = wid & 3, fr = lane & 15, fq = lane >> 4;
    const int nt = K / BK;
    unsigned voffA[2], voffB[2];
#pragma unroll
    for (int i = 0; i < 2; ++i) { int R, C; stage_rc(tid * 16 + i * 8192, R, C); const int Rb = (R & ~31) + perm32(R & 31);
        voffA[i] = (unsigned)(R * lda + C) * 2u; voffB[i] = (unsigned)(Rb * K + C) * 2u; }
    const size_t kstep = (size_t)(BK * 2);
    const size_t hstepA = (size_t)HALF * lda * 2, hstepB = (size_t)HALF * K * 2;
    const unsigned ldsw = (unsigned)wid * 1024u;
    const int aoff = lds_byte(wr * 64 + fr, fq * 8), boff = lds_byte(wc * 32 + fr, fq * 8);
#define PG8_SA(b, h) (((b) * 2 + (h)) * HTB)
#define PG8_SB(b, h) ((4 + (b) * 2 + (h)) * HTB)
#define PG8_STAGE(bufoff, gbase, voff) do { _Pragma("unroll") for (int _i = 0; _i < 2; ++_i) \
        __builtin_amdgcn_global_load_lds((const unsigned*)((const char*)(gbase) + (voff)[_i]), (LAS unsigned*)(lds + (bufoff) + ldsw + _i * 8192), 16, 0, 0); } while (0)
#define PG8_LDA(dst, b, h) do { _Pragma("unroll") for (int m = 0; m < 4; ++m) _Pragma("unroll") for (int k = 0; k < 2; ++k) dst[m][k] = *(const LAS bf16x8*)(lds + PG8_SA(b, h) + aoff + m * 2048 + k * 1024); } while (0)
#define PG8_LDB(dst, b, h) do { _Pragma("unroll") for (int n = 0; n < 2; ++n) _Pragma("unroll") for (int k = 0; k < 2; ++k) dst[n][k] = *(const LAS bf16x8*)(lds + PG8_SB(b, h) + boff + n * 2048 + k * 1024); } while (0)
#define PG8_MMA(ai, bj, At, Bt) do { __builtin_amdgcn_s_setprio(1); _Pragma("unroll") for (int m = 0; m < 4; ++m) _Pragma("unroll") for (int n = 0; n < 2; ++n) _Pragma("unroll") for (int k = 0; k < 2; ++k) \
        acc[ai][bj][m][n] = __builtin_amdgcn_mfma_f32_16x16x32_bf16(Bt[n][k], At[m][k], acc[ai][bj][m][n], 0, 0, 0); __builtin_amdgcn_s_setprio(0); } while (0)
#define PG8_WAIT_V(n) asm volatile("s_waitcnt vmcnt(" #n ")" ::: "memory")
#define PG8_WAIT_L(n) asm volatile("s_waitcnt lgkmcnt(" #n ")" ::: "memory")
#define PG8_BAR __builtin_amdgcn_s_barrier()
#define PG8_SCHED __builtin_amdgcn_sched_barrier(0)
    PG8_SCHED;
    Unit cur, nxt; int ui = 0;
    if (!S.next(0, cur)) return;
    f32x4 acc[2][2][4][2];
#pragma unroll
    for (int a = 0; a < 2; ++a)
#pragma unroll
        for (int b = 0; b < 2; ++b)
#pragma unroll
            for (int m = 0; m < 4; ++m)
#pragma unroll
                for (int n = 0; n < 2; ++n) acc[a][b][m][n] = (f32x4){0.f, 0.f, 0.f, 0.f};
    bf16x8 At[4][2], B0[2][2], B1[2][2];
    const char* cA = S.A(cur); const char* cB = S.B(cur);
    PG8_STAGE(PG8_SB(0, 0), cB, voffB); PG8_STAGE(PG8_SB(0, 1), cB + hstepB, voffB); PG8_STAGE(PG8_SA(0, 0), cA, voffA); PG8_STAGE(PG8_SA(0, 1), cA + hstepA, voffA);
    if (wr == 1) PG8_BAR;
    PG8_WAIT_V(2); PG8_BAR;
    PG8_STAGE(PG8_SB(1, 0), cB + kstep, voffB); PG8_STAGE(PG8_SA(1, 0), cA + kstep, voffA); PG8_STAGE(PG8_SB(1, 1), cB + hstepB + kstep, voffB);
    PG8_WAIT_V(6); PG8_BAR;
    for (;;) {
        const bool has_next = S.next(ui + 1, nxt);
        const char* nA = has_next ? S.A(nxt) : cA; const char* nB = has_next ? S.B(nxt) : cB;
        for (int t = 0; t < nt; t += 2) {
            const bool last = (t == nt - 2);
            const char* a1 = cA + (size_t)(t + 1) * kstep;
            const char* a2 = last ? nA : cA + (size_t)(t + 2) * kstep; const char* b2 = last ? nB : cB + (size_t)(t + 2) * kstep;
            const char* a3 = a2 + kstep; const char* b3 = b2 + kstep;
            PG8_LDB(B0, 0, 0); PG8_LDB(B1, 0, 1); PG8_SCHED; PG8_LDA(At, 0, 0); PG8_STAGE(PG8_SA(1, 1), a1 + hstepA, voffA);
            PG8_WAIT_V(8); PG8_WAIT_L(0); PG8_BAR; PG8_MMA(0, 0, At, B0); PG8_MMA(0, 1, At, B1); PG8_BAR; PG8_SCHED;
            PG8_LDA(At, 0, 1); PG8_STAGE(PG8_SB(0, 0), b2, voffB); PG8_STAGE(PG8_SB(0, 1), b2 + hstepB, voffB); PG8_STAGE(PG8_SA(0, 0), a2, voffA);
            PG8_WAIT_V(8); PG8_WAIT_L(0); PG8_BAR; PG8_MMA(1, 0, At, B0); PG8_MMA(1, 1, At, B1); PG8_BAR; PG8_SCHED;
            PG8_LDB(B0, 1, 0); PG8_LDB(B1, 1, 1); PG8_SCHED; PG8_LDA(At, 1, 0); PG8_STAGE(PG8_SA(0, 1), a2 + hstepA, voffA);
            PG8_WAIT_V(8); PG8_WAIT_L(0); PG8_BAR; PG8_MMA(0, 0, At, B0); PG8_MMA(0, 1, At, B1); PG8_BAR; PG8_SCHED;
            PG8_LDA(At, 1, 1); PG8_STAGE(PG8_SB(1, 0), b3, voffB); PG8_STAGE(PG8_SB(1, 1), b3 + hstepB, voffB); PG8_STAGE(PG8_SA(1, 0), a3, voffA);
            PG8_WAIT_V(8); PG8_WAIT_L(0); PG8_BAR; PG8_MMA(1, 0, At, B0); PG8_MMA(1, 1, At, B1); PG8_BAR; PG8_SCHED;
        }
        if (wr == 0) PG8_BAR;
        E(acc, cur, wr, wc, fr, fq);
        if (!has_next) break;
#pragma unroll
        for (int a = 0; a < 2; ++a)
#pragma unroll
            for (int b = 0; b < 2; ++b)
#pragma unroll
                for (int m = 0; m < 4; ++m)
#pragma unroll
                    for (int n = 0; n < 2; ++n) acc[a][b][m][n] = (f32x4){0.f, 0.f, 0.f, 0.f};
        cur = nxt; cA = nA; cB = nB; ++ui;
        if (wr == 1) PG8_BAR;
    }
    PG8_WAIT_V(0);
    PG8_BAR;
    PG8_SCHED;
#undef PG8_SA
#undef PG8_SB
#undef PG8_STAGE
#undef PG8_LDA
#undef PG8_LDB
#undef PG8_MMA
#undef PG8_WAIT_V
#undef PG8_WAIT_L
#undef PG8_BAR
#undef PG8_SCHED
}
}
using pg8::Unit;
typedef f32x4 AccT[2][2][4][2];
#define EPI_ARGS const f32x4 (&acc)[2][2][4][2], const Unit& u, int wr, int wc, int fr, int fq
#define EPI_FOR_ROWS _Pragma("unroll") for (int ai = 0; ai < 2; ++ai) _Pragma("unroll") for (int m = 0; m < 4; ++m)
#define EPI_ROW (u.pm * 256 + ai * 128 + wr * 64 + m * 16 + fr)
#define EPI_V8(bj) { acc[ai][bj][m][0][0], acc[ai][bj][m][0][1], acc[ai][bj][m][0][2], acc[ai][bj][m][0][3], acc[ai][bj][m][1][0], acc[ai][bj][m][1][1], acc[ai][bj][m][1][2], acc[ai][bj][m][1][3] }

struct EpiIn {
    bf16* Z; const float* rope;
    DI void operator()(EPI_ARGS) const {
        const int pn = u.pn; size_t base; int ldc, colt, mode;
        if (pn < 4) { base = Z_Q; ldc = 1024; colt = pn * 256; mode = 0; }
        else if (pn == 4) { base = Z_K; ldc = 256; colt = 0; mode = 0; }
        else if (pn == 5) { base = Z_V; ldc = 256; colt = 0; mode = 1; }
        else { const int arr = (pn - 6) >> 2; base = (size_t)M * (1536 + 1024 * arr); ldc = 1024; colt = ((pn - 6) & 3) * 256; mode = arr == 0 ? 1 : (arr == 1 ? 2 : 3); }
        const float qs = pn < 4 ? QSCALE : 1.f;
        const bool rope_w = (mode == 0) && (wc == 0);
        EPI_FOR_ROWS {
            const int row = EPI_ROW;
            bf16* rowp = Z + base + (size_t)row * ldc + colt + wc * 32 + 8 * fq;
            f32x4 cs[4];
            if (rope_w) { const f32x4* rp = (const f32x4*)(rope + ((row & (SEQ - 1)) * 16 + 8 * (fq & 1)) * 2);
#pragma unroll
                for (int i = 0; i < 4; ++i) cs[i] = rp[i]; }
#pragma unroll
            for (int bj = 0; bj < 2; ++bj) {
                float v[8] = EPI_V8(bj);
                if (mode == 0) {
                    if (rope_w) {
#pragma unroll
                        for (int e = 0; e < 8; ++e) { const float pr = shx(v[e], 32, fq * 16 + fr); const float cc = cs[e >> 1][(e & 1) * 2], ss = cs[e >> 1][(e & 1) * 2 + 1];
                            v[e] = v[e] * cc + (fq < 2 ? -pr * ss : pr * ss); }
                    }
#pragma unroll
                    for (int e = 0; e < 8; ++e) v[e] *= qs;
                } else if (mode == 2) {
#pragma unroll
                    for (int e = 0; e < 8; ++e) v[e] = gelu_t(v[e]);
                } else if (mode == 3) {
#pragma unroll
                    for (int e = 0; e < 8; ++e) v[e] = sigm(v[e]);
                }
                *(u32x4*)(rowp + bj * 128) = pack8(v);
            }
        }
    }
};
struct EpiGate {
    const bf16* XFB; bf16* LA; bf16* U; const float* b_a; const float* b_x; const float* lam;
    DI void operator()(EPI_ARGS) const {
        const int dir = u.g >> 2, blk = u.g & 3;
        const int ch0 = blk * 256 + u.pn * 128 + wc * 32 + 8 * fq;
        float ba[8], bx[8], cl[8];
#pragma unroll
        for (int e = 0; e < 8; ++e) { ba[e] = b_a[dir * 1024 + ch0 + e]; bx[e] = b_x[dir * 1024 + ch0 + e];
            const float l = lam[dir * 1024 + ch0 + e]; cl[e] = -8.f * __builtin_amdgcn_logf(1.f + __builtin_amdgcn_exp2f(-LOG2E * l)); }
        EPI_FOR_ROWS {
            const int row = EPI_ROW; const int t = row & (SEQ - 1);
            const bool start = dir ? (t == SEQ - 1) : (t == 0);
            const size_t off = ((size_t)dir * M + row) * 1024 + ch0;
            float x[8]; unpack8(*(const u32x4*)(XFB + off), x);
            const float va[8] = EPI_V8(0); const float vx[8] = EPI_V8(1);
            float la[8], uu[8];
#pragma unroll
            for (int e = 0; e < 8; ++e) { const float ra = sigm(va[e] + ba[e]), gx = sigm(vx[e] + bx[e]); la[e] = ra * cl[e];
                const float mult = start ? 1.f : __builtin_amdgcn_sqrtf(fmaxf(1.f - __builtin_amdgcn_exp2f(2.f * la[e]), 0.f)); uu[e] = x[e] * gx * mult; }
            *(u32x4*)(LA + off) = pack8(la); *(u32x4*)(U + off) = pack8(uu);
            __builtin_amdgcn_sched_barrier(0);
        }
    }
};
enum { EP_PA = 0, EP_PR, EP_OUT, EP_PLE1, EP_PLE2, EP_DOWN, EP_UP };
template <int MODE> struct EpiX {
    float* F;
    float* TR;
    const bf16* S;
    bf16* O;
    DI void operator()(EPI_ARGS) const {
        EPI_FOR_ROWS {
            const int row = EPI_ROW;
#pragma unroll
            for (int bj = 0; bj < 2; ++bj) {
                const int col = u.pn * 256 + bj * 128 + wc * 32 + 8 * fq;
                float v[8] = EPI_V8(bj);
                if constexpr (MODE == EP_UP) { *(u32x4*)(O + (size_t)row * (2 * DFF) + col) = pack8(v); }
                else {
                    const size_t off = (size_t)row * 1024 + col;
                    if constexpr (MODE == EP_PA) { float s[8]; unpack8(*(const u32x4*)(S + off), s);
                        *(f32x4*)(F + off) = (f32x4){v[0] * s[0], v[1] * s[1], v[2] * s[2], v[3] * s[3]}; *(f32x4*)(F + off + 4) = (f32x4){v[4] * s[4], v[5] * s[5], v[6] * s[6], v[7] * s[7]}; }
                    if constexpr (MODE == EP_PR) { float s[8]; unpack8(*(const u32x4*)(S + off), s); const f32x4 t0 = *(const f32x4*)(F + off), t1 = *(const f32x4*)(F + off + 4);
                        float r[8] = {t0[0] + v[0] * s[0], t0[1] + v[1] * s[1], t0[2] + v[2] * s[2], t0[3] + v[3] * s[3], t1[0] + v[4] * s[4], t1[1] + v[5] * s[5], t1[2] + v[6] * s[6], t1[3] + v[7] * s[7]};
                        *(u32x4*)(O + off) = pack8(r); }
                    if constexpr (MODE == EP_OUT) { const f32x4 t0 = *(const f32x4*)(F + off), t1 = *(const f32x4*)(F + off + 4);
                        *(f32x4*)(F + off) = (f32x4){DN_ALPHA * t0[0] + v[0], DN_ALPHA * t0[1] + v[1], DN_ALPHA * t0[2] + v[2], DN_ALPHA * t0[3] + v[3]};
                        *(f32x4*)(F + off + 4) = (f32x4){DN_ALPHA * t1[0] + v[4], DN_ALPHA * t1[1] + v[5], DN_ALPHA * t1[2] + v[6], DN_ALPHA * t1[3] + v[7]}; }
                    if constexpr (MODE == EP_PLE1) { *(f32x4*)(F + off) = (f32x4){v[0], v[1], v[2], v[3]}; *(f32x4*)(F + off + 4) = (f32x4){v[4], v[5], v[6], v[7]}; }
                    if constexpr (MODE == EP_PLE2) { const f32x4 p0 = *(const f32x4*)(F + off), p1 = *(const f32x4*)(F + off + 4); const f32x4 t0 = *(const f32x4*)(TR + off), t1 = *(const f32x4*)(TR + off + 4);
                        *(f32x4*)(TR + off) = (f32x4){DN_ALPHA * t0[0] + sigm(v[0]) * p0[0], DN_ALPHA * t0[1] + sigm(v[1]) * p0[1], DN_ALPHA * t0[2] + sigm(v[2]) * p0[2], DN_ALPHA * t0[3] + sigm(v[3]) * p0[3]};
                        *(f32x4*)(TR + off + 4) = (f32x4){DN_ALPHA * t1[0] + sigm(v[4]) * p1[0], DN_ALPHA * t1[1] + sigm(v[5]) * p1[1], DN_ALPHA * t1[2] + sigm(v[6]) * p1[2], DN_ALPHA * t1[3] + sigm(v[7]) * p1[3]}; }
                    if constexpr (MODE == EP_DOWN) { const f32x4 t0 = *(const f32x4*)(F + off), t1 = *(const f32x4*)(F + off + 4);
                        *(f32x4*)(F + off) = (f32x4){t0[0] + v[0], t0[1] + v[1], t0[2] + v[2], t0[3] + v[3]}; *(f32x4*)(F + off + 4) = (f32x4){t1[0] + v[4], t1[1] + v[5], t1[2] + v[6], t1[3] + v[7]}; }
                }
            }
            if constexpr (MODE == EP_PLE2 || MODE == EP_PR) __builtin_amdgcn_sched_barrier(0);
            else if constexpr (MODE != EP_UP && MODE != EP_PLE1) { if (m & 1) __builtin_amdgcn_sched_barrier(0); }
        }
    }
};

DI void ln_rows(const float* src, float* dstf, bf16* dstb, const float* g, const float* bt, int gw, int NGW, int lane) {
    for (int mrow = gw; mrow < M; mrow += NGW) {
        const f32x4* xr = (const f32x4*)(src + (size_t)mrow * D) + lane;
        f32x4 v[4]; float s = 0.f;
#pragma unroll
        for (int j = 0; j < 4; ++j) { v[j] = xr[64 * j]; s += (v[j].x + v[j].y) + (v[j].z + v[j].w); }
        const float mean = wave_sum(s, lane) * (1.f / D); float s2 = 0.f;
#pragma unroll
        for (int j = 0; j < 4; ++j) { v[j] = v[j] - mean; s2 += (v[j].x * v[j].x + v[j].y * v[j].y) + (v[j].z * v[j].z + v[j].w * v[j].w); }
        const float rstd = __builtin_amdgcn_rsqf(wave_sum(s2, lane) * (1.f / D) + LN_EPS);
        f32x4* of = (f32x4*)(dstf + (size_t)mrow * D) + lane; u32x2* ob = (u32x2*)(dstb + (size_t)mrow * D) + lane;
#pragma unroll
        for (int j = 0; j < 4; ++j) { const f32x4 gg = ((const f32x4*)g)[lane + 64 * j], bb = ((const f32x4*)bt)[lane + 64 * j];
            const f32x4 y = v[j] * rstd * gg + bb; of[64 * j] = y; ob[64 * j] = (u32x2){pk2(y.x, y.y), pk2(y.z, y.w)}; }
    }
}
DI void tr_item(const float* W, int N, bf16* WT, int ldt, int rowmode, int dup, LAS float* scr, int kb, int nb, int lane) {
    const int k0 = 64 * kb, n0 = 32 * nb;
#pragma unroll 8
    for (int i = 0; i < 32; ++i) { const int kk = 2 * i + (lane >> 5); scr[kk * 33 + (lane & 31)] = W[(size_t)(k0 + kk) * N + n0 + (lane & 31)]; }
    LDS_WAIT(); asm volatile("" ::: "memory");
    const int c = lane & 7;
#pragma unroll
    for (int j = 0; j < 4; ++j) { const int n = (lane >> 3) + 8 * j; const LAS float* s = scr + (8 * c) * 33 + n;
        u32x4 o; o.x = pk2(s[0 * 33], s[1 * 33]); o.y = pk2(s[2 * 33], s[3 * 33]); o.z = pk2(s[4 * 33], s[5 * 33]); o.w = pk2(s[6 * 33], s[7 * 33]);
        const int nn = n0 + n; const int row = rowmode == 0 ? nn : ((nn >> 7) * 256 + (rowmode - 1) * 128 + (nn & 127));
        *(u32x4*)(WT + (size_t)row * ldt + k0 + 8 * c) = o; if (dup) *(u32x4*)(WT + (size_t)row * ldt + 1024 + k0 + 8 * c) = o; }
    LDS_WAIT(); asm volatile("" ::: "memory");
}
struct InPtrs { const float* in[26]; };
typedef const __attribute__((address_space(4))) unsigned char* kptr_t;
#define INP(i) (*(const float* const __attribute__((address_space(4)))*)(kp + 8 * (i)))
DI void convert_layer(kptr_t kp, unsigned char* ws, int l, LAS unsigned char* lds, int gw, int NGW, int wave, int lane) {
    LAS float* scr = (LAS float*)(lds + wave * 8448);
    bf16* Wb = (bf16*)(ws + WS_W);
    constexpr int I_IN = 16 * 176, I_G = 32, I_SQ = 16 * 32, I_UP = 16 * 192, I_DN = 48 * 32, I_PLE = 4 * 32;
    constexpr int NIT = I_IN + 16 * I_G + 3 * I_SQ + I_UP + I_DN + I_PLE + I_SQ;
    for (int it = gw; it < NIT; it += NGW) {
        int r = it;
        if (r < I_IN) { tr_item(INP(4) + (size_t)l * D * DIN, DIN, Wb + W_IN, D, 0, 0, scr, r / 176, r % 176, lane); continue; } r -= I_IN;
        if (r < 8 * I_G) { const int g = r / I_G, q = r % I_G; tr_item(INP(8) + ((size_t)l * 8 + g) * 65536, 256, Wb + W_G + (size_t)g * 512 * 256, 256, 1, 0, scr, q / 8, q % 8, lane); continue; } r -= 8 * I_G;
        if (r < 8 * I_G) { const int g = r / I_G, q = r % I_G; tr_item(INP(10) + ((size_t)l * 8 + g) * 65536, 256, Wb + W_G + (size_t)g * 512 * 256, 256, 2, 0, scr, q / 8, q % 8, lane); continue; } r -= 8 * I_G;
        if (r < I_SQ) { tr_item(INP(13) + (size_t)l * D * D, D, Wb + W_PA, D, 0, 0, scr, r / 32, r % 32, lane); continue; } r -= I_SQ;
        if (r < I_SQ) { tr_item(INP(14) + (size_t)l * D * D, D, Wb + W_PR, 2 * D, 0, 1, scr, r / 32, r % 32, lane); continue; } r -= I_SQ;
        if (r < I_SQ) { tr_item(INP(15) + (size_t)l * D * D, D, Wb + W_O, D, 0, 0, scr, r / 32, r % 32, lane); continue; } r -= I_SQ;
        if (r < I_UP) { tr_item(INP(18) + (size_t)l * D * 2 * DFF, 2 * DFF, Wb + W_UP, D, 0, 0, scr, r / 192, r % 192, lane); continue; } r -= I_UP;
        if (r < I_DN) { tr_item(INP(21) + (size_t)l * DFF * D, D, Wb + W_DN, DFF, 0, 0, scr, r / 32, r % 32, lane); continue; } r -= I_DN;
        if (r < I_PLE) { tr_item(INP(22) + (size_t)l * DPLE * D, D, Wb + W_PLE, DPLE, 0, 0, scr, r / 32, r % 32, lane); continue; } r -= I_PLE;
        tr_item(INP(23) + (size_t)l * D * D, D, Wb + W_PG, D, 0, 0, scr, r / 32, r % 32, lane);
    }
    const float* P = INP(1) + (size_t)l * M * DPLE; bf16* PB = (bf16*)(ws + WS_PB);
    for (size_t i = (size_t)gw * 64 + lane; i < (size_t)M * DPLE / 8; i += (size_t)NGW * 64) {
        const f32x4 a = ((const f32x4*)P)[2 * i], b = ((const f32x4*)P)[2 * i + 1];
        ((u32x4*)PB)[i] = (u32x4){pk2(a.x, a.y), pk2(a.z, a.w), pk2(b.x, b.y), pk2(b.z, b.w)};
    }
}
DI void rope_table(float* rope, int gtid, int nthr) {
    for (int i = gtid; i < SEQ * 16; i += nthr) {
        const int pos = i >> 4, j = i & 15;
        const float inv = exp2f(-(float)j * (18.931568569324174f / 16.0f));
        const float ang = (float)pos * inv;
        const double rev = (double)ang * 0.15915494309189535; const float fr = (float)(rev - floor(rev));
        rope[2 * i] = __builtin_amdgcn_cosf(fr); rope[2 * i + 1] = __builtin_amdgcn_sinf(fr);
    }
}
DI void conv_phase(const int wid_s, const bf16* xr, bf16* XFB, const float* cw, const float* cb, int c, int G) {
    const int tid = get_tid(wid_s); const int cg8 = (tid & 127) * 8, sub = tid >> 7;
    for (int it = c; it < M / 32; it += G) {
        const int r0 = it * 32 + sub * 8; const int t0 = r0 & (SEQ - 1);
        u32x4 xin[14];
#pragma unroll
        for (int i = 0; i < 14; ++i) { const int t = t0 - 3 + i; xin[i] = (t >= 0 && t < SEQ) ? *(const u32x4*)(xr + (size_t)(r0 - 3 + i) * 1024 + cg8) : (u32x4){0u, 0u, 0u, 0u}; }
#pragma unroll
        for (int dir = 0; dir < 2; ++dir) {
            float w[4][8], b8[8];
#pragma unroll
            for (int k = 0; k < 4; ++k) { const f32x4 w0 = *(const f32x4*)(cw + (dir * 4 + k) * 1024 + cg8), w1 = *(const f32x4*)(cw + (dir * 4 + k) * 1024 + cg8 + 4);
                w[k][0] = w0.x; w[k][1] = w0.y; w[k][2] = w0.z; w[k][3] = w0.w; w[k][4] = w1.x; w[k][5] = w1.y; w[k][6] = w1.z; w[k][7] = w1.w; }
            { const f32x4 w0 = *(const f32x4*)(cb + dir * 1024 + cg8), w1 = *(const f32x4*)(cb + dir * 1024 + cg8 + 4);
                b8[0] = w0.x; b8[1] = w0.y; b8[2] = w0.z; b8[3] = w0.w; b8[4] = w1.x; b8[5] = w1.y; b8[6] = w1.z; b8[7] = w1.w; }
#pragma unroll
            for (int j = 0; j < 8; ++j) {
                float o[8];
#pragma unroll
                for (int e = 0; e < 8; ++e) o[e] = b8[e];
#pragma unroll
                for (int k = 0; k < 4; ++k) { float xv[8]; unpack8(xin[dir ? (j + 3 + k) : (j + 3 - k)], xv);
#pragma unroll
                    for (int e = 0; e < 8; ++e) o[e] += w[k][e] * xv[e]; }
                *(u32x4*)(XFB + ((size_t)dir * M + r0 + j) * 1024 + cg8) = pack8(o);
            }
        }
    }
}
DI void attn_phase(const int wid_s, LAS unsigned char* lds, const bf16* zq, const bf16* zk, const bf16* zv, bf16* att, const float* sink, int c, int G) {
    const int tid = get_tid(wid_s); const int w = wid_s, lane = tid & 63, l32 = lane & 31, h = lane >> 5;
    LAS unsigned char* Ks = lds;
    LAS unsigned char* Vt = lds + 34816;
    for (int L = c; L < 512; L += G) {
        const int it = (L & 7) * 64 + (L >> 3);
        const int pair = it & 1, kvh = (it >> 1) & 1, n = (it >> 2) & 15, b = it >> 6;
        const int hq = kvh * 4 + pair * 2 + (w >> 2);
        const int qrl = (w & 3) * 32 + l32;
        const size_t qrow = (size_t)b * SEQ + n * 128 + qrl;
        bf16x8 qf[8];
#pragma unroll
        for (int c8 = 0; c8 < 8; ++c8) qf[c8] = *(const bf16x8*)(zq + qrow * 1024 + hq * 128 + c8 * 16 + h * 8);
        float mrun = sink[hq] * LOG2E, lrun = 1.f;
        f32x16 o[4];
#pragma unroll
        for (int dd = 0; dd < 4; ++dd)
#pragma unroll
            for (int i = 0; i < 16; ++i) o[dd][i] = 0.f;
        for (int kc = 0; kc < 3; ++kc) {
            const int kb = n - 1 + kc; if (kb < 0 || kb > 15) continue;
            __syncthreads();
            const size_t krow0 = (size_t)b * SEQ + kb * 128;
#pragma unroll
            for (int i = 0; i < 4; ++i) { const int piece = tid + i * 512; const int r = piece >> 4, cc = piece & 15;
                const u32x4 kv = *(const u32x4*)(zk + (krow0 + r) * 256 + kvh * 128 + cc * 8);
                *(LAS u32x4*)(Ks + r * 272 + cc * 16) = kv; }
#pragma unroll
            for (int i = 0; i < 4; ++i) { const int piece = tid + i * 512; const int r = piece & 127, cc = piece >> 7;
                const u32x4 vv = *(const u32x4*)(zv + (krow0 + r) * 256 + kvh * 128 + cc * 8);
#pragma unroll
                for (int e = 0; e < 8; ++e) { const unsigned wv = vv[e >> 1]; *(LAS unsigned short*)(Vt + (cc * 8 + e) * 264 + r * 2) = (unsigned short)((e & 1) ? (wv >> 16) : (wv & 0xffffu)); } }
            __syncthreads();
            f32x16 s[4];
#pragma unroll
            for (int j = 0; j < 4; ++j) {
#pragma unroll
                for (int i = 0; i < 16; ++i) s[j][i] = 0.f;
#pragma unroll
                for (int c8 = 0; c8 < 8; ++c8) { const bf16x8 kf = *(const LAS bf16x8*)(Ks + (j * 32 + l32) * 272 + c8 * 32 + h * 16);
                    s[j] = __builtin_amdgcn_mfma_f32_32x32x16_bf16(kf, qf[c8], s[j], 0, 0, 0); }
            }
            if (kc != 1) {
                int hb = (kc == 0) ? (4 * h - qrl) : (qrl - 4 * h); asm volatile("" : "+v"(hb));
#pragma unroll
                for (int j = 0; j < 4; ++j)
#pragma unroll
                    for (int i = 0; i < 16; ++i) { const int ko = j * 32 + (i & 3) + 8 * (i >> 2); const int dlt = (kc == 0) ? (hb + ko) : (hb - ko); const unsigned t = (unsigned)(dlt >> 31);
                        s[j][i] = __uint_as_float((__float_as_uint(s[j][i]) & ~t) | (0xF149F2CAu & t)); }
            }
            float mx = -3e38f;
#pragma unroll
            for (int j = 0; j < 4; ++j)
#pragma unroll
                for (int i = 0; i < 16; ++i) mx = fmaxf(mx, s[j][i]);
            mx = fmaxf(mx, shx(mx, 32, lane));
            const float mnew = fmaxf(mrun, mx); const float alpha = __builtin_amdgcn_exp2f(mrun - mnew); mrun = mnew;
            float psum = 0.f;
#pragma unroll
            for (int j = 0; j < 4; ++j)
#pragma unroll
                for (int i = 0; i < 16; ++i) { const float p = __builtin_amdgcn_exp2f(s[j][i] - mnew); s[j][i] = p; psum += p; }
            psum += shx(psum, 32, lane);
            lrun = lrun * alpha + psum;
#pragma unroll
            for (int dd = 0; dd < 4; ++dd)
#pragma unroll
                for (int i = 0; i < 16; ++i) o[dd][i] *= alpha;
#pragma unroll
            for (int j = 0; j < 4; ++j)
#pragma unroll
                for (int s2 = 0; s2 < 2; ++s2) {
                    u32x4 pw; pw.x = pk2(s[j][8 * s2 + 0], s[j][8 * s2 + 1]); pw.y = pk2(s[j][8 * s2 + 2], s[j][8 * s2 + 3]); pw.z = pk2(s[j][8 * s2 + 4], s[j][8 * s2 + 5]); pw.w = pk2(s[j][8 * s2 + 6], s[j][8 * s2 + 7]);
                    const bf16x8 pf = __builtin_bit_cast(bf16x8, pw);
#pragma unroll
                    for (int dd = 0; dd < 4; ++dd) { const LAS unsigned char* vp = Vt + (dd * 32 + l32) * 264 + (j * 32 + 16 * s2 + 4 * h) * 2;
                        const u32x2 lo = *(const LAS u32x2*)vp, hi = *(const LAS u32x2*)(vp + 16);
                        const u32x4 vw = {lo.x, lo.y, hi.x, hi.y};
                        o[dd] = __builtin_amdgcn_mfma_f32_32x32x16_bf16(__builtin_bit_cast(bf16x8, vw), pf, o[dd], 0, 0, 0); }
                }
        }
        const float inv = __builtin_amdgcn_rcpf(lrun);
        bf16* op = att + qrow * 1024 + hq * 128;
#pragma unroll
        for (int dd = 0; dd < 4; ++dd)
#pragma unroll
            for (int i4 = 0; i4 < 4; ++i4) { const int d0 = dd * 32 + 8 * i4 + 4 * h;
                *(u32x2*)(op + d0) = (u32x2){pk2(o[dd][4 * i4] * inv, o[dd][4 * i4 + 1] * inv), pk2(o[dd][4 * i4 + 2] * inv, o[dd][4 * i4 + 3] * inv)}; }
    }
}
DI void scan_phase(const int wid_s, LAS unsigned char* lds, const bf16* LA, const bf16* U, const bf16* gy, bf16* HG, int c, int G) {
    const int tid = get_tid(wid_s); const int w = wid_s, lane = tid & 63, cp = lane & 31, half = lane >> 5, sgi = 2 * w + half;
    LAS float* sP = (LAS float*)lds; LAS float* sH = sP + 16 * 64;
    for (int it = c; it < 256; it += G) {
        const int cgp = it & 15, dir = (it >> 4) & 1, b = it >> 5;
        const int ch = cgp * 64 + cp * 2;
        const size_t rb = (size_t)b * SEQ;
        const bf16* la = LA + ((size_t)dir * M + rb) * 1024 + ch; const bf16* uu = U + ((size_t)dir * M + rb) * 1024 + ch;
        const bf16* gp = gy + rb * 1024 + ch; bf16* hp = HG + rb * 2048 + dir * 1024 + ch;
        const int sbase = sgi * 128;
        float P0 = 1.f, P1 = 1.f, H0 = 0.f, H1 = 0.f;
        for (int j0 = 0; j0 < 128; j0 += 8) {
            unsigned lv[8], uv[8];
#pragma unroll
            for (int j = 0; j < 8; ++j) { const int sidx = sbase + j0 + j; const int t = dir ? (SEQ - 1 - sidx) : sidx; lv[j] = *(const unsigned*)(la + (size_t)t * 1024); uv[j] = *(const unsigned*)(uu + (size_t)t * 1024); }
#pragma unroll
            for (int j = 0; j < 8; ++j) { const float a0 = __builtin_amdgcn_exp2f(bflo(lv[j])), a1 = __builtin_amdgcn_exp2f(bfhi(lv[j]));
                H0 = a0 * H0 + bflo(uv[j]); H1 = a1 * H1 + bfhi(uv[j]); P0 *= a0; P1 *= a1; }
        }
        __syncthreads();
        sP[sgi * 64 + cp * 2] = P0; sP[sgi * 64 + cp * 2 + 1] = P1; sH[sgi * 64 + cp * 2] = H0; sH[sgi * 64 + cp * 2 + 1] = H1;
        __syncthreads();
        float c0 = 0.f, c1 = 0.f;
        for (int s = 0; s < sgi; ++s) { c0 = sP[s * 64 + cp * 2] * c0 + sH[s * 64 + cp * 2]; c1 = sP[s * 64 + cp * 2 + 1] * c1 + sH[s * 64 + cp * 2 + 1]; }
        H0 = c0; H1 = c1;
        for (int j0 = 0; j0 < 128; j0 += 8) {
            unsigned lv[8], uv[8], gv[8];
#pragma unroll
            for (int j = 0; j < 8; ++j) { const int sidx = sbase + j0 + j; const int t = dir ? (SEQ - 1 - sidx) : sidx; lv[j] = *(const unsigned*)(la + (size_t)t * 1024); uv[j] = *(const unsigned*)(uu + (size_t)t * 1024); gv[j] = *(const unsigned*)(gp + (size_t)t * 1024); }
#pragma unroll
            for (int j = 0; j < 8; ++j) { const int sidx = sbase + j0 + j; const int t = dir ? (SEQ - 1 - sidx) : sidx;
                const float a0 = __builtin_amdgcn_exp2f(bflo(lv[j])), a1 = __builtin_amdgcn_exp2f(bfhi(lv[j]));
                H0 = a0 * H0 + bflo(uv[j]); H1 = a1 * H1 + bfhi(uv[j]);
                *(unsigned*)(hp + (size_t)t * 2048) = pk2(H0 * bflo(gv[j]), H1 * bfhi(gv[j])); }
        }
    }
}
DI void geglu_phase(const int wid_s, const bf16* UP, bf16* ACT, const float* fw, const float* fb, int c, int G) {
    const int nthr = G * 512; const int tid = get_tid(wid_s);
    for (int i = c * 512 + tid; i < (M / 8) * 384; i += nthr) {
        const int cg8 = (i % 384) * 8, r0 = (i / 384) * 8, t0 = r0 & (SEQ - 1);
        float w[3][8], b8[8];
#pragma unroll
        for (int k = 0; k < 3; ++k) { const f32x4 w0 = *(const f32x4*)(fw + k * DFF + cg8), w1 = *(const f32x4*)(fw + k * DFF + cg8 + 4);
            w[k][0] = w0.x; w[k][1] = w0.y; w[k][2] = w0.z; w[k][3] = w0.w; w[k][4] = w1.x; w[k][5] = w1.y; w[k][6] = w1.z; w[k][7] = w1.w; }
        { const f32x4 w0 = *(const f32x4*)(fb + cg8), w1 = *(const f32x4*)(fb + cg8 + 4); b8[0] = w0.x; b8[1] = w0.y; b8[2] = w0.z; b8[3] = w0.w; b8[4] = w1.x; b8[5] = w1.y; b8[6] = w1.z; b8[7] = w1.w; }
        u32x4 gin[10];
#pragma unroll
        for (int q = 0; q < 10; ++q) { const int t = t0 - 1 + q; gin[q] = (t >= 0 && t < SEQ) ? *(const u32x4*)(UP + (size_t)(r0 - 1 + q) * (2 * DFF) + cg8) : (u32x4){0u, 0u, 0u, 0u}; }
#pragma unroll
        for (int j = 0; j < 8; ++j) {
            float o[8], vv[8]; unpack8(*(const u32x4*)(UP + (size_t)(r0 + j) * (2 * DFF) + DFF + cg8), vv);
#pragma unroll
            for (int e = 0; e < 8; ++e) o[e] = b8[e];
#pragma unroll
            for (int k = 0; k < 3; ++k) { float xv[8]; unpack8(gin[j + k], xv);
#pragma unroll
                for (int e = 0; e < 8; ++e) o[e] += w[k][e] * xv[e]; }
#pragma unroll
            for (int e = 0; e < 8; ++e) o[e] = gelu_t(o[e]) * vv[e];
            *(u32x4*)(ACT + (size_t)(r0 + j) * DFF + cg8) = pack8(o);
        }
    }
}

#define XB_TMO      128
#define XB_XCNT(j)  (256  + 64 * (j))
#define XB_XSUB(j)  (1280 + 64 * (j))
#define XB_XGEN(j)  (2304 + 64 * (j))
#define XB_TOP      3328
#define XB_TOPGEN   3392
#define XCD_BAR_WORDS 3456
#define XB_SPIN_CAP (1u << 18)

__device__ __forceinline__ unsigned xb_ld(unsigned* p)              { return __hip_atomic_load(p, __ATOMIC_RELAXED, __HIP_MEMORY_SCOPE_AGENT); }
__device__ __forceinline__ unsigned xb_add(unsigned* p, unsigned v) { return __hip_atomic_fetch_add(p, v, __ATOMIC_RELAXED, __HIP_MEMORY_SCOPE_AGENT); }
__device__ __forceinline__ unsigned xb_xcc_id() { return (unsigned)__builtin_amdgcn_s_getreg((3 << 11) | 20) & 0xFu; }
#define XB_SPIN(cond, bar) do { unsigned _sp = 0; while (cond) { __builtin_amdgcn_s_sleep(1); \
    if ((++_sp & 255u) == 0u) { if (xb_ld(&(bar)[XB_TMO])) break; if (_sp > XB_SPIN_CAP) { atomicAdd(&(bar)[XB_TMO], 1u); break; } } } } while (0)

struct XcdBarrier {
    unsigned* bar; unsigned x;
    volatile LAS unsigned* st;
};

__device__ __forceinline__ XcdBarrier xcd_barrier_post(unsigned* bar, volatile LAS unsigned* st, int tid) {
    XcdBarrier b; b.bar = bar; b.x = xb_xcc_id(); b.st = st;
    if (tid == 0) (void)xb_add(&bar[XB_XCNT(b.x)], 1u);
    return b;
}
__device__ __forceinline__ void xcd_barrier_complete(unsigned* bar, unsigned x, unsigned& nloc, unsigned& nx) {
    const unsigned G = gridDim.x * gridDim.y * gridDim.z;
    unsigned sum, cnt, mine, sp = 0u;
    for (;;) {
        sum = 0u; cnt = 0u; mine = 0u;
#pragma unroll
        for (unsigned j = 0; j < 16; ++j) { const unsigned c = xb_ld(&bar[XB_XCNT(j)]); sum += c; cnt += (c > 0u) ? 1u : 0u; mine = (j == x) ? c : mine; }
        if (sum == G) break;
        __builtin_amdgcn_s_sleep(1);
        if ((++sp & 255u) == 0u) { if (xb_ld(&bar[XB_TMO])) break; if (sp > XB_SPIN_CAP) { atomicAdd(&bar[XB_TMO], 1u); break; } }
    }
    nloc = mine > 0u ? mine : 1u; nx = cnt > 0u ? cnt : 1u;
}

__device__ __forceinline__ void xcd_barrier(const XcdBarrier& b, int tid) {
    asm volatile("s_waitcnt vmcnt(0)" ::: "memory");
    __syncthreads();
    if (tid == 0) {
        unsigned* bar = b.bar;
        __builtin_amdgcn_s_waitcnt(0);
        unsigned nloc = b.st[0], nx = b.st[1];
        if (nloc == 0u) { xcd_barrier_complete(bar, b.x, nloc, nx); b.st[0] = nloc; b.st[1] = nx; }
        const unsigned old = xb_add(&bar[XB_XSUB(b.x)], 1u);
        const unsigned gen = old / nloc;
        if (old + 1u == (gen + 1u) * nloc) {
            __builtin_amdgcn_fence(__ATOMIC_RELEASE, "agent");
            asm volatile("s_waitcnt vmcnt(0)" ::: "memory");
            const unsigned og = xb_add(&bar[XB_TOP], 1u);
            const unsigned tg = og / nx;
            if (og + 1u == (tg + 1u) * nx) xb_add(&bar[XB_TOPGEN], 1u);
            else XB_SPIN(xb_ld(&bar[XB_TOPGEN]) == tg, bar);
            __builtin_amdgcn_fence(__ATOMIC_ACQUIRE, "agent");
            xb_add(&bar[XB_XGEN(b.x)], 1u);
            asm volatile("s_waitcnt vmcnt(0)" ::: "memory");
        } else {
            XB_SPIN(xb_ld(&bar[XB_XGEN(b.x)]) == gen, bar);
            __builtin_amdgcn_fence(__ATOMIC_ACQUIRE, "agent");
            asm volatile("s_waitcnt vmcnt(0)" ::: "memory");
        }
    }
    __syncthreads();
}

struct Args { InPtrs I; float* out; unsigned char* ws; int ph_lo, ph_hi; };
#ifndef ONLY
#define ONLY -1
#endif
#define CASE_ON(n) if constexpr (ONLY < 0 || ONLY == (n))
constexpr int PH_PER_LAYER = 11, N_PHASES = 1 + DEPTH * PH_PER_LAYER;

__global__ void __launch_bounds__(512, 2) fwd_kernel(Args args) {
    extern __shared__ __attribute__((aligned(16))) unsigned char lds_raw[];
    LAS unsigned char* lds = (LAS unsigned char*)lds_raw;
    cg::grid_group grid = cg::this_grid();
    const int wid_s = __builtin_amdgcn_readfirstlane((int)threadIdx.x >> 6);
    XcdBarrier bar;
    {
        const int tid0 = get_tid(wid_s);
        unsigned* barw = (unsigned*)(args.ws + WS_BAR);
        volatile LAS unsigned* st = (volatile LAS unsigned*)(lds + 131072 + 64);
        if (blockIdx.x == 0) for (int i = tid0; i < XCD_BAR_WORDS; i += 512) __hip_atomic_store(barw + i, 0u, __ATOMIC_RELAXED, __HIP_MEMORY_SCOPE_AGENT);
        if (tid0 < 2) st[tid0] = 0u;
        __syncthreads();
        grid.sync();
        bar = xcd_barrier_post(barw, st, tid0);
    }
    for (int ph = args.ph_lo; ph < args.ph_hi; ++ph) {
        kptr_t kp = (kptr_t)__builtin_amdgcn_kernarg_segment_ptr(); asm volatile("" : "+s"(kp));
        float* trunk = *(float* const __attribute__((address_space(4)))*)(kp + 208);
        unsigned char* ws = *(unsigned char* const __attribute__((address_space(4)))*)(kp + 216);
        const int wave = wid_s;
        int G = gridDim.x, c = blockIdx.x; asm volatile("" : "+s"(G), "+s"(c));
        const int gw = c * 8 + wave, NGW = G * 8;
        float* rope = (float*)(ws + WS_ROPE);
        bf16* Wb = (bf16*)(ws + WS_W); bf16* PB = (bf16*)(ws + WS_PB); bf16* HB = (bf16*)(ws + WS_HB); bf16* Z = (bf16*)(ws + WS_Z);
        bf16* ATT = (bf16*)(ws + WS_ATT); bf16* XFB = (bf16*)(ws + WS_XFB); bf16* UB = (bf16*)(ws + WS_EXTRA); float* T = (float*)(ws + WS_EXTRA);
        bf16* LAb = Z; bf16* HG = XFB; bf16* UP = Z; bf16* ACT = XFB;
        if (ph > args.ph_lo) { xcd_barrier(bar, get_tid(wid_s));
#ifdef PROBE_SYNC2
            xcd_barrier(bar, get_tid(wid_s));
#endif
        }
        if (ph == 0) { CASE_ON(100) {
            const int tid = get_tid(wid_s), lane = tid & 63;
            convert_layer(kp, ws, 0, lds, gw, NGW, wave, lane);
            ln_rows(INP(0), trunk, HB, INP(2), INP(3), gw, NGW, lane);
            rope_table(rope, c * 512 + tid, G * 512); }
            continue;
        }
        const int l = (ph - 1) / PH_PER_LAYER, k = (ph - 1) % PH_PER_LAYER;
#ifndef PROBE_DUP
#define PROBE_DUP 0
#endif
        for (int rep = 0; rep < 1 + ((PROBE_DUP >> k) & 1); ++rep) {
        if (rep) xcd_barrier(bar, get_tid(wid_s));
        switch (k) {
        case 0: CASE_ON(0) {
            pg8::TileOrder S; S.init(M, DIN, G, c, HB, D, Wb + W_IN, D);
            EpiIn E{Z, rope};
            pg8::gemm_phase(lds, wid_s, D, D, S, E);
        } break;
        case 1: CASE_ON(1) {
            attn_phase(wid_s, lds, Z + Z_Q, Z + Z_K, Z + Z_V, ATT, INP(5) + l * NH, c, G);
            conv_phase(wid_s, Z + Z_XR, XFB, INP(6) + (size_t)l * 2 * 4 * D, INP(7) + (size_t)l * 2 * D, c, G);
        } break;
        case 2: CASE_ON(2) {
            pg8::GateOrder S{G, c, (const char*)XFB, (const char*)(Wb + W_G)};
            EpiGate E{XFB, LAb, UB, INP(9) + (size_t)l * 2 * D, INP(11) + (size_t)l * 2 * D, INP(12) + (size_t)l * 2 * D};
            pg8::gemm_phase(lds, wid_s, 256, 1024, S, E);
        } break;
        case 3: CASE_ON(3) {
            scan_phase(wid_s, lds, LAb, UB, Z + Z_GY, HG, c, G);
        } break;
        case 4: CASE_ON(4) {
#if !defined(SUB) || SUB==0
            { pg8::TileOrder S; S.init(M, D, G, c, ATT, D, Wb + W_PA, D); EpiX<EP_PA> E{T, nullptr, Z + Z_SA, nullptr}; pg8::gemm_phase(lds, wid_s, D, D, S, E); }
#endif
#if !defined(SUB) || SUB==1
            { pg8::TileOrder S; S.init(M, D, G, c, HG, 2 * D, Wb + W_PR, 2 * D); EpiX<EP_PR> E{T, nullptr, Z + Z_SR, HB}; pg8::gemm_phase(lds, wid_s, 2 * D, 2 * D, S, E); }
#endif
        } break;
        case 5: CASE_ON(5) {
            pg8::TileOrder S; S.init(M, D, G, c, HB, D, Wb + W_O, D); EpiX<EP_OUT> E{trunk, nullptr, nullptr, nullptr}; pg8::gemm_phase(lds, wid_s, D, D, S, E);
        } break;
        case 6: CASE_ON(6) {
            const int lane = get_tid(wid_s) & 63;
            ln_rows(trunk, trunk, HB, INP(16) + (size_t)l * D, INP(17) + (size_t)l * D, gw, NGW, lane);
        } break;
        case 7: CASE_ON(7) {
#if !defined(SUB7) || SUB7==0
            { pg8::TileOrder S; S.init(M, D, G, c, PB, DPLE, Wb + W_PLE, DPLE); EpiX<EP_PLE1> E{T, nullptr, nullptr, nullptr}; pg8::gemm_phase(lds, wid_s, DPLE, DPLE, S, E); }
#endif
#if !defined(SUB7) || SUB7==1
            { pg8::TileOrder S; S.init(M, D, G, c, HB, D, Wb + W_PG, D); EpiX<EP_PLE2> E{T, trunk, nullptr, nullptr}; pg8::gemm_phase(lds, wid_s, D, D, S, E); }
#endif
#if !defined(SUB7) || SUB7==2
            { pg8::TileOrder S; S.init(M, 2 * DFF, G, c, HB, D, Wb + W_UP, D); EpiX<EP_UP> E{nullptr, nullptr, nullptr, UP}; pg8::gemm_phase(lds, wid_s, D, D, S, E); }
#endif
        } break;
        case 8: CASE_ON(8) {
            geglu_phase(wid_s, UP, ACT, INP(19) + (size_t)l * 3 * DFF, INP(20) + (size_t)l * DFF, c, G);
        } break;
        case 9: CASE_ON(9) {
            pg8::TileOrder S; S.init(M, D, G, c, ACT, DFF, Wb + W_DN, DFF); EpiX<EP_DOWN> E{trunk, nullptr, nullptr, nullptr}; pg8::gemm_phase(lds, wid_s, DFF, DFF, S, E);
        } break;
        case 10: CASE_ON(10) {
            const int lane = get_tid(wid_s) & 63;
            ln_rows(trunk, trunk, HB, INP(24) + (size_t)l * D, INP(25) + (size_t)l * D, gw, NGW, lane);
            if (l + 1 < DEPTH) convert_layer(kp, ws, l + 1, lds, gw, NGW, wave, lane);
        } break;
        }
        }
    }
}

extern "C" void kernel_launch(void* const* d_in, const int* in_sizes, int n_in, void* d_out, int out_size, void* d_ws, size_t ws_size, hipStream_t stream) {
    static int grid = 0;
    if (grid == 0) {
        if (n_in != 26 || out_size != M * D || ws_size < WS_END) { fprintf(stderr, "kernel_launch: unexpected sizes n_in %d out %d ws %zu\n", n_in, out_size, ws_size); grid = -1; return; }
        int dev = 0, cus = 0, per_cu = 0;
        hipGetDevice(&dev); hipDeviceGetAttribute(&cus, hipDeviceAttributeMultiprocessorCount, dev);
        if (hipFuncSetAttribute((const void*)fwd_kernel, hipFuncAttributeMaxDynamicSharedMemorySize, LDS_BYTES) != hipSuccess) { fprintf(stderr, "kernel_launch: hipFuncSetAttribute failed\n"); grid = -1; return; }
        hipOccupancyMaxActiveBlocksPerMultiprocessor(&per_cu, (const void*)fwd_kernel, 512, LDS_BYTES);
        (void)hipGetLastError();
        if (per_cu < 1) per_cu = 1;
        grid = cus * 1;
        if (grid > 256) grid = 256;
        fprintf(stderr, "kernel_launch: cus %d per_cu %d grid %d ws %zu\n", cus, per_cu, grid, ws_size);
    }
    if (grid < 0) return;
    Args a{};
    for (int i = 0; i < 26; ++i) a.I.in[i] = (const float*)d_in[i];
    a.out = (float*)d_out; a.ws = (unsigned char*)d_ws; a.ph_lo = 0; a.ph_hi = N_PHASES;
    void* kargs[] = {&a};
    hipError_t e = hipLaunchCooperativeKernel((const void*)fwd_kernel, dim3(grid), dim3(512), kargs, LDS_BYTES, stream);
    if (e != hipSuccess) fprintf(stderr, "kernel_launch: cooperative launch failed: %s\n", hipGetErrorString(e));
}
```

```cpp
#include <hip/hip_runtime.h>
#include <hip/hip_cooperative_groups.h>
#include <cstdio>
#include <cstdint>
namespace cg = cooperative_groups;

#define LAS __attribute__((address_space(3)))
#define DI __device__ __forceinline__
typedef unsigned short bf16;
typedef short bf16x8 __attribute__((ext_vector_type(8)));
typedef float f32x4 __attribute__((ext_vector_type(4)));
typedef float f32x16 __attribute__((ext_vector_type(16)));
typedef unsigned u32x4 __attribute__((ext_vector_type(4)));
typedef unsigned u32x2 __attribute__((ext_vector_type(2)));
typedef __bf16 bf16x2_t __attribute__((ext_vector_type(2)));
typedef float f32x2_t __attribute__((ext_vector_type(2)));

constexpr int BATCH = 8, SEQ = 2048, D = 1024, DEPTH = 4, M = BATCH * SEQ;
constexpr int NH = 8, NKV = 2, HD = 128, DIN = 5632, DFF = 3072, DPLE = 256;
constexpr float LN_EPS = 1e-5f;
constexpr float DN_ALPHA = 1.6817928305074290f;
constexpr float LOG2E = 1.4426950408889634f;
constexpr float QSCALE = 0.08838834764831845f * LOG2E;

constexpr size_t MiB = 1u << 20;
constexpr size_t WS_ROPE = 0;
constexpr size_t WS_BAR = 512 * 1024;
constexpr size_t WS_W = 1 * MiB;
constexpr size_t W_IN = 0, W_G = W_IN + (size_t)DIN * D, W_PA = W_G + 8 * 512 * 256, W_PR = W_PA + (size_t)D * D, W_O = W_PR + (size_t)D * 2 * D,
                 W_UP = W_O + (size_t)D * D, W_DN = W_UP + (size_t)2 * DFF * D, W_PLE = W_DN + (size_t)D * DFF, W_PG = W_PLE + (size_t)D * DPLE, W_END = W_PG + (size_t)D * D;
static_assert(W_END * 2 <= 42 * MiB, "weights");
constexpr size_t WS_PB = WS_W + 42 * MiB;
constexpr size_t WS_HB = WS_PB + 8 * MiB;
constexpr size_t WS_Z = WS_HB + 32 * MiB;
constexpr size_t WS_ATT = WS_Z + 176 * MiB;
constexpr size_t WS_XFB = WS_ATT + 32 * MiB;
constexpr size_t WS_EXTRA = WS_XFB + 64 * MiB;
constexpr size_t WS_END = WS_EXTRA + 64 * MiB;
static_assert(WS_END <= 440 * MiB, "ws");
constexpr size_t Z_Q = 0, Z_K = (size_t)M * 1024, Z_V = (size_t)M * 1280, Z_XR = (size_t)M * 1536, Z_GY = (size_t)M * 2560, Z_SA = (size_t)M * 3584, Z_SR = (size_t)M * 4608;

constexpr int LDS_BYTES = 139264;

DI unsigned pk2(float lo, float hi) { f32x2_t v = {lo, hi}; bf16x2_t b = __builtin_convertvector(v, bf16x2_t); return __builtin_bit_cast(unsigned, b); }
DI float bflo(unsigned u) { return __uint_as_float(u << 16); }
DI float bfhi(unsigned u) { return __uint_as_float(u & 0xffff0000u); }
DI float sigm(float x) { return __builtin_amdgcn_rcpf(1.f + __builtin_amdgcn_exp2f(-LOG2E * x)); }
DI float gelu_t(float x) { const float u = 0.7978845608028654f * (x + 0.044715f * x * x * x); return x * sigm(2.f * u); }
DI void unpack8(const u32x4 w, float (&v)[8]) { v[0] = bflo(w.x); v[1] = bfhi(w.x); v[2] = bflo(w.y); v[3] = bfhi(w.y); v[4] = bflo(w.z); v[5] = bfhi(w.z); v[6] = bflo(w.w); v[7] = bfhi(w.w); }
DI u32x4 pack8(const float (&v)[8]) { u32x4 w; w.x = pk2(v[0], v[1]); w.y = pk2(v[2], v[3]); w.z = pk2(v[4], v[5]); w.w = pk2(v[6], v[7]); return w; }
DI float shx(float v, int mask, int lane) { return __int_as_float(__builtin_amdgcn_ds_bpermute((lane ^ mask) << 2, __float_as_int(v))); }
DI float wave_sum(float v, int lane) {
#pragma unroll
    for (int o = 1; o < 64; o <<= 1) v += shx(v, o, lane);
    return v;
}
DI int get_tid(int wid_s) { int l; asm volatile("v_mbcnt_lo_u32_b32 %0, -1, 0\n\tv_mbcnt_hi_u32_b32 %0, -1, %0" : "=v"(l)); return wid_s * 64 + l; }
#define LDS_WAIT() asm volatile("s_waitcnt lgkmcnt(0)" ::: "memory")

namespace pg8 {
constexpr int BM = 256, BK = 64, HALF = 128, HTB = HALF * BK * 2, NXCD = 8, WGM = 8;
DI int lds_byte(int r, int c) { const int st = (r >> 4) * 2 + (c >> 5), rr = r & 15, cc = c & 31, ob = rr * 64 + cc * 2; return st * 1024 + (ob ^ (((ob >> 9) & 1) << 5)); }
DI void stage_rc(int b, int& R, int& C) { const int st = b / 1024, sb = b % 1024, swz = sb ^ (((sb >> 9) & 1) << 5); R = (st >> 1) * 16 + swz / 64; C = (st & 1) * 32 + (swz % 64) / 2; }
DI int perm32(int rho) { const int n = rho >> 4, i = rho & 15; return 8 * (i >> 2) + 4 * n + (i & 3); }
struct Unit { int pm, pn, g; };

struct TileOrder {
    int nM, nN, nwg, G, c; const char* Ab; const char* Bb; size_t atile, btile;
    DI void init(int Mr, int N, int G_, int c_, const void* A, int lda, const void* Bt, int K) { nM = Mr / BM; nN = N / BM; nwg = nM * nN; G = G_; c = c_; Ab = (const char*)A; Bb = (const char*)Bt; atile = (size_t)BM * lda * 2; btile = (size_t)BM * K * 2; }
    DI bool next(int i, Unit& u) const {
        const int L = i * G + c; if (L >= nwg) return false;
        int wgid = L; { const int q = nwg / NXCD, r = nwg % NXCD, xcd = wgid % NXCD, off = wgid / NXCD; wgid = (xcd < r ? xcd * (q + 1) : r * (q + 1) + (xcd - r) * q) + off; }
        const int nig = WGM * nN, gid = wgid / nig, fm = gid * WGM, gsz = (nM - fm) < WGM ? (nM - fm) : WGM;
        u.pm = fm + ((wgid % nig) % gsz); u.pn = (wgid % nig) / gsz; u.g = 0; return true;
    }
    DI const char* A(const Unit& u) const { return Ab + (size_t)u.pm * atile; }
    DI const char* B(const Unit& u) const { return Bb + (size_t)u.pn * btile; }
};
struct GateOrder {
    int G, c; const char* Ab; const char* Bb;
    DI bool next(int i, Unit& u) const {
        const int L = i * G + c; if (L >= 1024) return false;
        const int id = (L & 7) * 128 + (L >> 3); u.g = id >> 7; u.pm = (id & 127) >> 1; u.pn = id & 1; return true;
    }
    DI const char* A(const Unit& u) const { const int dir = u.g >> 2, blk = u.g & 3; return Ab + (((size_t)dir * M + (size_t)u.pm * 256) * 1024 + blk * 256) * 2; }
    DI const char* B(const Unit& u) const { return Bb + ((size_t)u.g * 512 + u.pn * 256) * 256 * 2; }
};

template <class Epi, class Sched>
DI void gemm_phase(LAS unsigned char* lds, const int wid_s, const int K, const int lda, const Sched& S, const Epi& E) {
    int tid_ = get_tid(wid_s);
    const int tid = tid_, wid = __builtin_amdgcn_readfirstlane(tid >> 6), lane = tid & 63, wr = wid >> 2, wc = wid & 3, fr = lane & 15, fq = lane >> 4;
    const int nt = K / BK;
    unsigned voffA[2], voffB[2];
#pragma unroll
    for (int i = 0; i < 2; ++i) { int R, C; stage_rc(tid * 16 + i * 8192, R, C); const int Rb = (R & ~31) + perm32(R & 31);
        voffA[i] = (unsigned)(R * lda + C) * 2u; voffB[i] = (unsigned)(Rb * K + C) * 2u; }
    const size_t kstep = (size_t)(BK * 2);
    const size_t hstepA = (size_t)HALF * lda * 2, hstepB = (size_t)HALF * K * 2;
    const unsigned ldsw = (unsigned)wid * 1024u;
    const int aoff = lds_byte(wr * 64 + fr, fq * 8), boff = lds_byte(wc * 32 + fr, fq * 8);
#define PG8_SA(b, h) (((b) * 2 + (h)) * HTB)
#define PG8_SB(b, h) ((4 + (b) * 2 + (h)) * HTB)
#define PG8_STAGE(bufoff, gbase, voff) do { _Pragma("unroll") for (int _i = 0; _i < 2; ++_i) \
        __builtin_amdgcn_global_load_lds((const unsigned*)((const char*)(gbase) + (voff)[_i]), (LAS unsigned*)(lds + (bufoff) + ldsw + _i * 8192), 16, 0, 0); } while (0)
#define PG8_LDA(dst, b, h) do { _Pragma("unroll") for (int m = 0; m < 4; ++m) _Pragma("unroll") for (int k = 0; k < 2; ++k) dst[m][k] = *(const LAS bf16x8*)(lds + PG8_SA(b, h) + aoff + m * 2048 + k * 1024); } while (0)
#define PG8_LDB(dst, b, h) do { _Pragma("unroll") for (int n = 0; n < 2; ++n) _Pragma("unroll") for (int k = 0; k < 2; ++k) dst[n][k] = *(const LAS bf16x8*)(lds + PG8_SB(b, h) + boff + n * 2048 + k * 1024); } while (0)
#define PG8_MMA(ai, bj, At, Bt) do { __builtin_amdgcn_s_setprio(1); _Pragma("unroll") for (int m = 0; m < 4; ++m) _Pragma("unroll") for (int n = 0; n < 2; ++n) _Pragma("unroll") for (int k = 0; k < 2; ++k) \
        acc[ai][bj][m][n] = __builtin_amdgcn_mfma_f32_16x16x32_bf16(Bt[n][k], At[m][k], acc[ai][bj][m][n], 0, 0, 0); __builtin_amdgcn_s_setprio(0); } while (0)
#define PG8_WAIT_V(n) asm volatile("s_waitcnt vmcnt(" #n ")" ::: "memory")
#define PG8_WAIT_L(n) asm volatile("s_waitcnt lgkmcnt(" #n ")" ::: "memory")
#define PG8_BAR __builtin_amdgcn_s_barrier()
#define PG8_SCHED __builtin_amdgcn_sched_barrier(0)
    PG8_SCHED;
    Unit cur, nxt; int ui = 0;
    if (!S.next(0, cur)) return;
    f32x4 acc[2][2][4][2];
#pragma unroll
    for (int a = 0; a < 2; ++a)
#pragma unroll
        for (int b = 0; b < 2; ++b)
#pragma unroll
            for (int m = 0; m < 4; ++m)
#pragma unroll
                for (int n = 0; n < 2; ++n) acc[a][b][m][n] = (f32x4){0.f, 0.f, 0.f, 0.f};
    bf16x8 At[4][2], B0[2][2], B1[2][2];
    const char* cA = S.A(cur); const char* cB = S.B(cur);
    PG8_STAGE(PG8_SB(0, 0), cB, voffB); PG8_STAGE(PG8_SB(0, 1), cB + hstepB, voffB); PG8_STAGE(PG8_SA(0, 0), cA, voffA); PG8_STAGE(PG8_SA(0, 1), cA + hstepA, voffA);
    if (wr == 1) PG8_BAR;
    PG8_WAIT_V(2); PG8_BAR;
    PG8_STAGE(PG8_SB(1, 0), cB + kstep, voffB); PG8_STAGE(PG8_SA(1, 0), cA + kstep, voffA); PG8_STAGE(PG8_SB(1, 1), cB + hstepB + kstep, voffB);
    PG8_WAIT_V(6); PG8_BAR;
    for (;;) {
        const bool has_next = S.next(ui + 1, nxt);
        const char* nA = has_next ? S.A(nxt) : cA; const char* nB = has_next ? S.B(nxt) : cB;
        for (int t = 0; t < nt; t += 2) {
            const bool last = (t == nt - 2);
            const char* a1 = cA + (size_t)(t + 1) * kstep;
            const char* a2 = last ? nA : cA + (size_t)(t + 2) * kstep; const char* b2 = last ? nB : cB + (size_t)(t + 2) * kstep;
            const char* a3 = a2 + kstep; const char* b3 = b2 + kstep;
            PG8_LDB(B0, 0, 0); PG8_LDB(B1, 0, 1); PG8_SCHED; PG8_LDA(At, 0, 0); PG8_STAGE(PG8_SA(1, 1), a1 + hstepA, voffA);
            PG8_WAIT_V(8); PG8_WAIT_L(0); PG8_BAR; PG8_MMA(0, 0, At, B0); PG8_MMA(0, 1, At, B1); PG8_BAR; PG8_SCHED;
            PG8_LDA(At, 0, 1); PG8_STAGE(PG8_SB(0, 0), b2, voffB); PG8_STAGE(PG8_SB(0, 1), b2 + hstepB, voffB); PG8_STAGE(PG8_SA(0, 0), a2, voffA);
            PG8_WAIT_V(8); PG8_WAIT_L(0); PG8_BAR; PG8_MMA(1, 0, At, B0); PG8_MMA(1, 1, At, B1); PG8_BAR; PG8_SCHED;
            PG8_LDB(B0, 1, 0); PG8_LDB(B1, 1, 1); PG8_SCHED; PG8_LDA(At, 1, 0); PG8_STAGE(PG8_SA(0, 1), a2 + hstepA, voffA);
            PG8_WAIT_V(8); PG8_WAIT_L(0); PG8_BAR; PG8_MMA(0, 0, At, B0); PG8_MMA(0, 1, At, B1); PG8_BAR; PG8_SCHED;
            PG8_LDA(At, 1, 1); PG8_STAGE(PG8_SB(1, 0), b3, voffB); PG8_STAGE(PG8_SB(1, 1), b3 + hstepB, voffB); PG8_STAGE(PG8_SA(1, 0), a3, voffA);
            PG8_WAIT_V(8); PG8_WAIT_L(0); PG8_BAR; PG8_MMA(1, 0, At, B0); PG8_MMA(1, 1, At, B1); PG8_BAR; PG8_SCHED;
        }
        if (wr == 0) PG8_BAR;
        E(acc, cur, wr, wc, fr, fq);
        if (!has_next) break;
#pragma unroll
        for (int a = 0; a < 2; ++a)
#pragma unroll
            for (int b = 0; b < 2; ++b)
#pragma unroll
                for (int m = 0; m < 4; ++m)
#pragma unroll
                    for (int n = 0; n < 2; ++n) acc[a][b][m][n] = (f32x4){0.f, 0.f, 0.f, 0.f};
        cur = nxt; cA = nA; cB = nB; ++ui;
        if (wr == 1) PG8_BAR;
    }
    PG8_WAIT_V(0);
    PG8_BAR;
    PG8_SCHED;
#undef PG8_SA
#undef PG8_SB
#undef PG8_STAGE
#undef PG8_LDA
#undef PG8_LDB
#undef PG8_MMA
#undef PG8_WAIT_V
#undef PG8_WAIT_L
#undef PG8_BAR
#undef PG8_SCHED
}
}
using pg8::Unit;
typedef f32x4 AccT[2][2][4][2];
#define EPI_ARGS const f32x4 (&acc)[2][2][4][2], const Unit& u, int wr, int wc, int fr, int fq
#define EPI_FOR_ROWS _Pragma("unroll") for (int ai = 0; ai < 2; ++ai) _Pragma("unroll") for (int m = 0; m < 4; ++m)
#define EPI_ROW (u.pm * 256 + ai * 128 + wr * 64 + m * 16 + fr)
#define EPI_V8(bj) { acc[ai][bj][m][0][0], acc[ai][bj][m][0][1], acc[ai][bj][m][0][2], acc[ai][bj][m][0][3], acc[ai][bj][m][1][0], acc[ai][bj][m][1][1], acc[ai][bj][m][1][2], acc[ai][bj][m][1][3] }

struct EpiIn {
    bf16* Z; const float* rope;
    DI void operator()(EPI_ARGS) const {
        const int pn = u.pn; size_t base; int ldc, colt, mode;
        if (pn < 4) { base = Z_Q; ldc = 1024; colt = pn * 256; mode = 0; }
        else if (pn == 4) { base = Z_K; ldc = 256; colt = 0; mode = 0; }
        else if (pn == 5) { base = Z_V; ldc = 256; colt = 0; mode = 1; }
        else { const int arr = (pn - 6) >> 2; base = (size_t)M * (1536 + 1024 * arr); ldc = 1024; colt = ((pn - 6) & 3) * 256; mode = arr == 0 ? 1 : (arr == 1 ? 2 : 3); }
        const float qs = pn < 4 ? QSCALE : 1.f;
        const bool rope_w = (mode == 0) && (wc == 0);
        EPI_FOR_ROWS {
            const int row = EPI_ROW;
            bf16* rowp = Z + base + (size_t)row * ldc + colt + wc * 32 + 8 * fq;
            f32x4 cs[4];
            if (rope_w) { const f32x4* rp = (const f32x4*)(rope + ((row & (SEQ - 1)) * 16 + 8 * (fq & 1)) * 2);
#pragma unroll
                for (int i = 0; i < 4; ++i) cs[i] = rp[i]; }
#pragma unroll
            for (int bj = 0; bj < 2; ++bj) {
                float v[8] = EPI_V8(bj);
                if (mode == 0) {
                    if (rope_w) {
#pragma unroll
                        for (int e = 0; e < 8; ++e) { const float pr = shx(v[e], 32, fq * 16 + fr); const float cc = cs[e >> 1][(e & 1) * 2], ss = cs[e >> 1][(e & 1) * 2 + 1];
                            v[e] = v[e] * cc + (fq < 2 ? -pr * ss : pr * ss); }
                    }
#pragma unroll
                    for (int e = 0; e < 8; ++e) v[e] *= qs;
                } else if (mode == 2) {
#pragma unroll
                    for (int e = 0; e < 8; ++e) v[e] = gelu_t(v[e]);
                } else if (mode == 3) {
#pragma unroll
                    for (int e = 0; e < 8; ++e) v[e] = sigm(v[e]);
                }
                *(u32x4*)(rowp + bj * 128) = pack8(v);
            }
        }
    }
};
struct EpiGate {
    const bf16* XFB; bf16* LA; bf16* U; const float* b_a; const float* b_x; const float* lam;
    DI void operator()(EPI_ARGS) const {
        const int dir = u.g >> 2, blk = u.g & 3;
        const int ch0 = blk * 256 + u.pn * 128 + wc * 32 + 8 * fq;
        float ba[8], bx[8], cl[8];
#pragma unroll
        for (int e = 0; e < 8; ++e) { ba[e] = b_a[dir * 1024 + ch0 + e]; bx[e] = b_x[dir * 1024 + ch0 + e];
            const float l = lam[dir * 1024 + ch0 + e]; cl[e] = -8.f * __builtin_amdgcn_logf(1.f + __builtin_amdgcn_exp2f(-LOG2E * l)); }
        EPI_FOR_ROWS {
            const int row = EPI_ROW; const int t = row & (SEQ - 1);
            const bool start = dir ? (t == SEQ - 1) : (t == 0);
            const size_t off = ((size_t)dir * M + row) * 1024 + ch0;
            float x[8]; unpack8(*(const u32x4*)(XFB + off), x);
            const float va[8] = EPI_V8(0); const float vx[8] = EPI_V8(1);
            float la[8], uu[8];
#pragma unroll
            for (int e = 0; e < 8; ++e) { const float ra = sigm(va[e] + ba[e]), gx = sigm(vx[e] + bx[e]); la[e] = ra * cl[e];
                const float mult = start ? 1.f : __builtin_amdgcn_sqrtf(fmaxf(1.f - __builtin_amdgcn_exp2f(2.f * la[e]), 0.f)); uu[e] = x[e] * gx * mult; }
            *(u32x4*)(LA + off) = pack8(la); *(u32x4*)(U + off) = pack8(uu);
            __builtin_amdgcn_sched_barrier(0);
        }
    }
};
enum { EP_PA = 0, EP_PR, EP_OUT, EP_PLE1, EP_PLE2, EP_DOWN, EP_UP };
template <int MODE> struct EpiX {
    float* F;
    float* TR;
    const bf16* S;
    bf16* O;
    DI void operator()(EPI_ARGS) const {
        EPI_FOR_ROWS {
            const int row = EPI_ROW;
#pragma unroll
            for (int bj = 0; bj < 2; ++bj) {
                const int col = u.pn * 256 + bj * 128 + wc * 32 + 8 * fq;
                float v[8] = EPI_V8(bj);
                if constexpr (MODE == EP_UP) { *(u32x4*)(O + (size_t)row * (2 * DFF) + col) = pack8(v); }
                else {
                    const size_t off = (size_t)row * 1024 + col;
                    if constexpr (MODE == EP_PA) { float s[8]; unpack8(*(const u32x4*)(S + off), s);
                        *(f32x4*)(F + off) = (f32x4){v[0] * s[0], v[1] * s[1], v[2] * s[2], v[3] * s[3]}; *(f32x4*)(F + off + 4) = (f32x4){v[4] * s[4], v[5] * s[5], v[6] * s[6], v[7] * s[7]}; }
                    if constexpr (MODE == EP_PR) { float s[8]; unpack8(*(const u32x4*)(S + off), s); const f32x4 t0 = *(const f32x4*)(F + off), t1 = *(const f32x4*)(F + off + 4);
                        float r[8] = {t0[0] + v[0] * s[0], t0[1] + v[1] * s[1], t0[2] + v[2] * s[2], t0[3] + v[3] * s[3], t1[0] + v[4] * s[4], t1[1] + v[5] * s[5], t1[2] + v[6] * s[6], t1[3] + v[7] * s[7]};
                        *(u32x4*)(O + off) = pack8(r); }
                    if constexpr (MODE == EP_OUT) { const f32x4 t0 = *(const f32x4*)(F + off), t1 = *(const f32x4*)(F + off + 4);
                        *(f32x4*)(F + off) = (f32x4){DN_ALPHA * t0[0] + v[0], DN_ALPHA * t0[1] + v[1], DN_ALPHA * t0[2] + v[2], DN_ALPHA * t0[3] + v[3]};
                        *(f32x4*)(F + off + 4) = (f32x4){DN_ALPHA * t1[0] + v[4], DN_ALPHA * t1[1] + v[5], DN_ALPHA * t1[2] + v[6], DN_ALPHA * t1[3] + v[7]}; }
                    if constexpr (MODE == EP_PLE1) { *(f32x4*)(F + off) = (f32x4){v[0], v[1], v[2], v[3]}; *(f32x4*)(F + off + 4) = (f32x4){v[4], v[5], v[6], v[7]}; }
                    if constexpr (MODE == EP_PLE2) { const f32x4 p0 = *(const f32x4*)(F + off), p1 = *(const f32x4*)(F + off + 4); const f32x4 t0 = *(const f32x4*)(TR + off), t1 = *(const f32x4*)(TR + off + 4);
                        *(f32x4*)(TR + off) = (f32x4){DN_ALPHA * t0[0] + sigm(v[0]) * p0[0], DN_ALPHA * t0[1] + sigm(v[1]) * p0[1], DN_ALPHA * t0[2] + sigm(v[2]) * p0[2], DN_ALPHA * t0[3] + sigm(v[3]) * p0[3]};
                        *(f32x4*)(TR + off + 4) = (f32x4){DN_ALPHA * t1[0] + sigm(v[4]) * p1[0], DN_ALPHA * t1[1] + sigm(v[5]) * p1[1], DN_ALPHA * t1[2] + sigm(v[6]) * p1[2], DN_ALPHA * t1[3] + sigm(v[7]) * p1[3]}; }
                    if constexpr (MODE == EP_DOWN) { const f32x4 t0 = *(const f32x4*)(F + off), t1 = *(const f32x4*)(F + off + 4);
                        *(f32x4*)(F + off) = (f32x4){t0[0] + v[0], t0[1] + v[1], t0[2] + v[2], t0[3] + v[3]}; *(f32x4*)(F + off + 4) = (f32x4){t1[0] + v[4], t1[1] + v[5], t1[2] + v[6], t1[3] + v[7]}; }
                }
            }
            if constexpr (MODE == EP_PLE2 || MODE == EP_PR) __builtin_amdgcn_sched_barrier(0);
            else if constexpr (MODE != EP_UP && MODE != EP_PLE1) { if (m & 1) __builtin_amdgcn_sched_barrier(0); }
        }
    }
};

DI float dpp_ror1(float v) { return __int_as_float(__builtin_amdgcn_update_dpp(0, __float_as_int(v), 0x121, 0xf, 0xf, false)); }
DI float dpp_ror15(float v) { return __int_as_float(__builtin_amdgcn_update_dpp(0, __float_as_int(v), 0x12F, 0xf, 0xf, false)); }
constexpr size_t SIDE_STRIDE = 3 * DFF;
struct EpiUpG {
    bf16* ACT; float* SIDE; const float* fw; const float* fb; LAS float* xch;
    DI void operator()(EPI_ARGS) const {
        const int ch0 = u.pn * 128 + wc * 32 + 8 * fq;
        float w0[8], w1[8], w2[8], bb[8];
        { const f32x4 a0 = *(const f32x4*)(fw + ch0), a1 = *(const f32x4*)(fw + ch0 + 4), b0 = *(const f32x4*)(fw + DFF + ch0), b1 = *(const f32x4*)(fw + DFF + ch0 + 4),
                      c0 = *(const f32x4*)(fw + 2 * DFF + ch0), c1 = *(const f32x4*)(fw + 2 * DFF + ch0 + 4), d0 = *(const f32x4*)(fb + ch0), d1 = *(const f32x4*)(fb + ch0 + 4);
#pragma unroll
          for (int e = 0; e < 4; ++e) { w0[e] = a0[e]; w0[e + 4] = a1[e]; w1[e] = b0[e]; w1[e + 4] = b1[e]; w2[e] = c0[e]; w2[e + 4] = c1[e]; bb[e] = d0[e]; bb[e + 4] = d1[e]; } }
#pragma unroll
        for (int ai = 0; ai < 2; ++ai) { const int gi = 2 * ai + wr;
            if (fr == 0) { LAS float* p = xch + ((gi * 4 + wc) * 2 + 0) * 32 + 8 * fq; *(LAS f32x4*)p = acc[ai][0][0][0]; *(LAS f32x4*)(p + 4) = acc[ai][0][0][1]; }
            if (fr == 15) { LAS float* p = xch + ((gi * 4 + wc) * 2 + 1) * 32 + 8 * fq; *(LAS f32x4*)p = acc[ai][0][3][0]; *(LAS f32x4*)(p + 4) = acc[ai][0][3][1]; } }
        LDS_WAIT(); __builtin_amdgcn_s_barrier(); asm volatile("" ::: "memory");
        const bool seq_first = (u.pm & 7) == 0, seq_last = (u.pm & 7) == 7;
#pragma unroll
        for (int ai = 0; ai < 2; ++ai) { const int gi = 2 * ai + wr;
            float pf[8], nf[8];
#pragma unroll
            for (int e = 0; e < 8; ++e) { pf[e] = 0.f; nf[e] = 0.f; }
            if (gi > 0) { const LAS float* p = xch + (((gi - 1) * 4 + wc) * 2 + 1) * 32 + 8 * fq; const f32x4 a = *(const LAS f32x4*)p, b = *(const LAS f32x4*)(p + 4);
#pragma unroll
                for (int e = 0; e < 4; ++e) { pf[e] = a[e]; pf[e + 4] = b[e]; } }
            if (gi < 3) { const LAS float* p = xch + (((gi + 1) * 4 + wc) * 2 + 0) * 32 + 8 * fq; const f32x4 a = *(const LAS f32x4*)p, b = *(const LAS f32x4*)(p + 4);
#pragma unroll
                for (int e = 0; e < 4; ++e) { nf[e] = a[e]; nf[e + 4] = b[e]; } }
#pragma unroll
            for (int m = 0; m < 4; ++m) {
                const int row = EPI_ROW;
                float cv[8], o[8];
#pragma unroll
                for (int e = 0; e < 8; ++e) {
                    const float g = acc[ai][0][m][e >> 2][e & 3];
                    const float upn = dpp_ror1(g), dnn = dpp_ror15(g);
                    const float upe = (m > 0) ? dpp_ror1(acc[ai][0][m > 0 ? m - 1 : 0][e >> 2][e & 3]) : pf[e];
                    const float dne = (m < 3) ? dpp_ror15(acc[ai][0][m < 3 ? m + 1 : 3][e >> 2][e & 3]) : nf[e];
                    const float up = (fr == 0) ? upe : upn, dn = (fr == 15) ? dne : dnn;
                    cv[e] = bb[e] + w0[e] * up + w1[e] * g + w2[e] * dn;
                    o[e] = gelu_t(cv[e]) * acc[ai][1][m][e >> 2][e & 3];
                }
                *(u32x4*)(ACT + (size_t)row * DFF + ch0) = pack8(o);
                if (gi == 0 && m == 0 && fr == 0 && !seq_first) { float* sp = SIDE + ((size_t)u.pm * 2 + 0) * SIDE_STRIDE + ch0;
                    *(f32x4*)sp = (f32x4){cv[0], cv[1], cv[2], cv[3]}; *(f32x4*)(sp + 4) = (f32x4){cv[4], cv[5], cv[6], cv[7]};
                    *(f32x4*)(sp + DFF) = acc[ai][1][m][0]; *(f32x4*)(sp + DFF + 4) = acc[ai][1][m][1]; *(f32x4*)(sp + 2 * DFF) = acc[ai][0][m][0]; *(f32x4*)(sp + 2 * DFF + 4) = acc[ai][0][m][1]; }
                if (gi == 3 && m == 3 && fr == 15 && !seq_last) { float* sp = SIDE + ((size_t)u.pm * 2 + 1) * SIDE_STRIDE + ch0;
                    *(f32x4*)sp = (f32x4){cv[0], cv[1], cv[2], cv[3]}; *(f32x4*)(sp + 4) = (f32x4){cv[4], cv[5], cv[6], cv[7]};
                    *(f32x4*)(sp + DFF) = acc[ai][1][m][0]; *(f32x4*)(sp + DFF + 4) = acc[ai][1][m][1]; *(f32x4*)(sp + 2 * DFF) = acc[ai][0][m][0]; *(f32x4*)(sp + 2 * DFF + 4) = acc[ai][0][m][1]; }
                __builtin_amdgcn_sched_barrier(0);
            }
        }
    }
};
DI void geglu_fix(const int wid_s, bf16* ACT, const float* SIDE, const float* fw, const float* fb, int c, int G) {
    const int tid = get_tid(wid_s);
    for (int i = c * 512 + tid; i < 63 * (DFF / 4); i += G * 512) {
        const int pm = i / (DFF / 4), ch = (i % (DFF / 4)) * 4;
        if ((pm & 7) == 7) continue;
        const float* sl = SIDE + ((size_t)pm * 2 + 1) * SIDE_STRIDE + ch;
        const float* sf = SIDE + ((size_t)(pm + 1) * 2 + 0) * SIDE_STRIDE + ch;
        const f32x4 pl = *(const f32x4*)sl, vl = *(const f32x4*)(sl + DFF), gl = *(const f32x4*)(sl + 2 * DFF);
        const f32x4 pf = *(const f32x4*)sf, vf = *(const f32x4*)(sf + DFF), gf = *(const f32x4*)(sf + 2 * DFF);
        const f32x4 w0 = *(const f32x4*)(fw + ch), w2 = *(const f32x4*)(fw + 2 * DFF + ch);
        float ol[4], of[4];
#pragma unroll
        for (int e = 0; e < 4; ++e) { ol[e] = gelu_t(pl[e] + w2[e] * gf[e]) * vl[e]; of[e] = gelu_t(pf[e] + w0[e] * gl[e]) * vf[e]; }
        *(u32x2*)(ACT + (size_t)(pm * 256 + 255) * DFF + ch) = (u32x2){pk2(ol[0], ol[1]), pk2(ol[2], ol[3])};
        *(u32x2*)(ACT + (size_t)(pm * 256 + 256) * DFF + ch) = (u32x2){pk2(of[0], of[1]), pk2(of[2], of[3])};
    }
}
DI void ln_rows(const float* src, float* dstf, bf16* dstb, const float* g, const float* bt, int gw, int NGW, int lane) {
    for (int mrow = gw; mrow < M; mrow += NGW) {
        const f32x4* xr = (const f32x4*)(src + (size_t)mrow * D) + lane;
        f32x4 v[4]; float s = 0.f;
#pragma unroll
        for (int j = 0; j < 4; ++j) { v[j] = xr[64 * j]; s += (v[j].x + v[j].y) + (v[j].z + v[j].w); }
        const float mean = wave_sum(s, lane) * (1.f / D); float s2 = 0.f;
#pragma unroll
        for (int j = 0; j < 4; ++j) { v[j] = v[j] - mean; s2 += (v[j].x * v[j].x + v[j].y * v[j].y) + (v[j].z * v[j].z + v[j].w * v[j].w); }
        const float rstd = __builtin_amdgcn_rsqf(wave_sum(s2, lane) * (1.f / D) + LN_EPS);
        f32x4* of = (f32x4*)(dstf + (size_t)mrow * D) + lane; u32x2* ob = (u32x2*)(dstb + (size_t)mrow * D) + lane;
#pragma unroll
        for (int j = 0; j < 4; ++j) { const f32x4 gg = ((const f32x4*)g)[lane + 64 * j], bb = ((const f32x4*)bt)[lane + 64 * j];
            const f32x4 y = v[j] * rstd * gg + bb; of[64 * j] = y; ob[64 * j] = (u32x2){pk2(y.x, y.y), pk2(y.z, y.w)}; }
    }
}
DI void tr_item(const float* W, int N, bf16* WT, int ldt, int rowmode, int dup, LAS float* scr, int kb, int nb, int lane) {
    const int k0 = 64 * kb, n0 = 32 * nb;
#pragma unroll 8
    for (int i = 0; i < 32; ++i) { const int kk = 2 * i + (lane >> 5); scr[kk * 33 + (lane & 31)] = W[(size_t)(k0 + kk) * N + n0 + (lane & 31)]; }
    LDS_WAIT(); asm volatile("" ::: "memory");
    const int c = lane & 7;
#pragma unroll
    for (int j = 0; j < 4; ++j) { const int n = (lane >> 3) + 8 * j; const LAS float* s = scr + (8 * c) * 33 + n;
        u32x4 o; o.x = pk2(s[0 * 33], s[1 * 33]); o.y = pk2(s[2 * 33], s[3 * 33]); o.z = pk2(s[4 * 33], s[5 * 33]); o.w = pk2(s[6 * 33], s[7 * 33]);
        const int nn = n0 + n; const int row = rowmode == 0 ? nn : ((nn >> 7) * 256 + (rowmode - 1) * 128 + (nn & 127));
        *(u32x4*)(WT + (size_t)row * ldt + k0 + 8 * c) = o; if (dup) *(u32x4*)(WT + (size_t)row * ldt + 1024 + k0 + 8 * c) = o; }
    LDS_WAIT(); asm volatile("" ::: "memory");
}
struct InPtrs { const float* in[26]; };
typedef const __attribute__((address_space(4))) unsigned char* kptr_t;
#define INP(i) (*(const float* const __attribute__((address_space(4)))*)(kp + 8 * (i)))
DI void convert_layer(kptr_t kp, unsigned char* ws, int l, LAS unsigned char* lds, int gw, int NGW, int wave, int lane) {
    LAS float* scr = (LAS float*)(lds + wave * 8448);
    bf16* Wb = (bf16*)(ws + WS_W);
    constexpr int I_IN = 16 * 176, I_G = 32, I_SQ = 16 * 32, I_UP = 16 * 192, I_DN = 48 * 32, I_PLE = 4 * 32;
    constexpr int NIT = I_IN + 16 * I_G + 3 * I_SQ + I_UP + I_DN + I_PLE + I_SQ;
    for (int it = gw; it < NIT; it += NGW) {
        int r = it;
        if (r < I_IN) { tr_item(INP(4) + (size_t)l * D * DIN, DIN, Wb + W_IN, D, 0, 0, scr, r / 176, r % 176, lane); continue; } r -= I_IN;
        if (r < 8 * I_G) { const int g = r / I_G, q = r % I_G; tr_item(INP(8) + ((size_t)l * 8 + g) * 65536, 256, Wb + W_G + (size_t)g * 512 * 256, 256, 1, 0, scr, q / 8, q % 8, lane); continue; } r -= 8 * I_G;
        if (r < 8 * I_G) { const int g = r / I_G, q = r % I_G; tr_item(INP(10) + ((size_t)l * 8 + g) * 65536, 256, Wb + W_G + (size_t)g * 512 * 256, 256, 2, 0, scr, q / 8, q % 8, lane); continue; } r -= 8 * I_G;
        if (r < I_SQ) { tr_item(INP(13) + (size_t)l * D * D, D, Wb + W_PA, D, 0, 0, scr, r / 32, r % 32, lane); continue; } r -= I_SQ;
        if (r < I_SQ) { tr_item(INP(14) + (size_t)l * D * D, D, Wb + W_PR, 2 * D, 0, 1, scr, r / 32, r % 32, lane); continue; } r -= I_SQ;
        if (r < I_SQ) { tr_item(INP(15) + (size_t)l * D * D, D, Wb + W_O, D, 0, 0, scr, r / 32, r % 32, lane); continue; } r -= I_SQ;
        if (r < I_UP) { const int kb = r / 192, nb = r % 192, hf = nb >= 96;
            tr_item(INP(18) + (size_t)l * D * 2 * DFF + hf * DFF, 2 * DFF, Wb + W_UP, D, 1 + hf, 0, scr, kb, nb - hf * 96, lane); continue; } r -= I_UP;
        if (r < I_DN) { tr_item(INP(21) + (size_t)l * DFF * D, D, Wb + W_DN, DFF, 0, 0, scr, r / 32, r % 32, lane); continue; } r -= I_DN;
        if (r < I_PLE) { tr_item(INP(22) + (size_t)l * DPLE * D, D, Wb + W_PLE, DPLE, 0, 0, scr, r / 32, r % 32, lane); continue; } r -= I_PLE;
        tr_item(INP(23) + (size_t)l * D * D, D, Wb + W_PG, D, 0, 0, scr, r / 32, r % 32, lane);
    }
    const float* P = INP(1) + (size_t)l * M * DPLE; bf16* PB = (bf16*)(ws + WS_PB);
    for (size_t i = (size_t)gw * 64 + lane; i < (size_t)M * DPLE / 8; i += (size_t)NGW * 64) {
        const f32x4 a = ((const f32x4*)P)[2 * i], b = ((const f32x4*)P)[2 * i + 1];
        ((u32x4*)PB)[i] = (u32x4){pk2(a.x, a.y), pk2(a.z, a.w), pk2(b.x, b.y), pk2(b.z, b.w)};
    }
}
DI void rope_table(float* rope, int gtid, int nthr) {
    for (int i = gtid; i < SEQ * 16; i += nthr) {
        const int pos = i >> 4, j = i & 15;
        const float inv = exp2f(-(float)j * (18.931568569324174f / 16.0f));
        const float ang = (float)pos * inv;
        const double rev = (double)ang * 0.15915494309189535; const float fr = (float)(rev - floor(rev));
        rope[2 * i] = __builtin_amdgcn_cosf(fr); rope[2 * i + 1] = __builtin_amdgcn_sinf(fr);
    }
}
DI void conv_phase(const int wid_s, const bf16* xr, bf16* XFB, const float* cw, const float* cb, int c, int G) {
    const int tid = get_tid(wid_s); const int cg8 = (tid & 127) * 8, sub = tid >> 7;
    for (int it = c; it < M / 32; it += G) {
        const int r0 = it * 32 + sub * 8; const int t0 = r0 & (SEQ - 1);
        u32x4 xin[14];
#pragma unroll
        for (int i = 0; i < 14; ++i) { const int t = t0 - 3 + i; xin[i] = (t >= 0 && t < SEQ) ? *(const u32x4*)(xr + (size_t)(r0 - 3 + i) * 1024 + cg8) : (u32x4){0u, 0u, 0u, 0u}; }
#pragma unroll
        for (int dir = 0; dir < 2; ++dir) {
            float w[4][8], b8[8];
#pragma unroll
            for (int k = 0; k < 4; ++k) { const f32x4 w0 = *(const f32x4*)(cw + (dir * 4 + k) * 1024 + cg8), w1 = *(const f32x4*)(cw + (dir * 4 + k) * 1024 + cg8 + 4);
                w[k][0] = w0.x; w[k][1] = w0.y; w[k][2] = w0.z; w[k][3] = w0.w; w[k][4] = w1.x; w[k][5] = w1.y; w[k][6] = w1.z; w[k][7] = w1.w; }
            { const f32x4 w0 = *(const f32x4*)(cb + dir * 1024 + cg8), w1 = *(const f32x4*)(cb + dir * 1024 + cg8 + 4);
                b8[0] = w0.x; b8[1] = w0.y; b8[2] = w0.z; b8[3] = w0.w; b8[4] = w1.x; b8[5] = w1.y; b8[6] = w1.z; b8[7] = w1.w; }
#pragma unroll
            for (int j = 0; j < 8; ++j) {
                float o[8];
#pragma unroll
                for (int e = 0; e < 8; ++e) o[e] = b8[e];
#pragma unroll
                for (int k = 0; k < 4; ++k) { float xv[8]; unpack8(xin[dir ? (j + 3 + k) : (j + 3 - k)], xv);
#pragma unroll
                    for (int e = 0; e < 8; ++e) o[e] += w[k][e] * xv[e]; }
                *(u32x4*)(XFB + ((size_t)dir * M + r0 + j) * 1024 + cg8) = pack8(o);
            }
        }
    }
}
DI void attn_phase(const int wid_s, LAS unsigned char* lds, const bf16* zq, const bf16* zk, const bf16* zv, bf16* att, const float* sink, int c, int G) {
    const int tid = get_tid(wid_s); const int w = wid_s, lane = tid & 63, l32 = lane & 31, h = lane >> 5;
    LAS unsigned char* Ks = lds;
    LAS unsigned char* Vt = lds + 34816;
    for (int L = c; L < 512; L += G) {
        const int it = (L & 7) * 64 + (L >> 3);
        const int pair = it & 1, kvh = (it >> 1) & 1, n = (it >> 2) & 15, b = it >> 6;
        const int hq = kvh * 4 + pair * 2 + (w >> 2);
        const int qrl = (w & 3) * 32 + l32;
        const size_t qrow = (size_t)b * SEQ + n * 128 + qrl;
        bf16x8 qf[8];
#pragma unroll
        for (int c8 = 0; c8 < 8; ++c8) qf[c8] = *(const bf16x8*)(zq + qrow * 1024 + hq * 128 + c8 * 16 + h * 8);
        float mrun = sink[hq] * LOG2E, lrun = 1.f;
        f32x16 o[4];
#pragma unroll
        for (int dd = 0; dd < 4; ++dd)
#pragma unroll
            for (int i = 0; i < 16; ++i) o[dd][i] = 0.f;
        for (int kc = 0; kc < 3; ++kc) {
            const int kb = n - 1 + kc; if (kb < 0 || kb > 15) continue;
            __syncthreads();
            const size_t krow0 = (size_t)b * SEQ + kb * 128;
#pragma unroll
            for (int i = 0; i < 4; ++i) { const int piece = tid + i * 512; const int r = piece >> 4, cc = piece & 15;
                const u32x4 kv = *(const u32x4*)(zk + (krow0 + r) * 256 + kvh * 128 + cc * 8);
                *(LAS u32x4*)(Ks + r * 272 + cc * 16) = kv; }
#pragma unroll
            for (int i = 0; i < 4; ++i) { const int piece = tid + i * 512; const int r = piece & 127, cc = piece >> 7;
                const u32x4 vv = *(const u32x4*)(zv + (krow0 + r) * 256 + kvh * 128 + cc * 8);
#pragma unroll
                for (int e = 0; e < 8; ++e) { const unsigned wv = vv[e >> 1]; *(LAS unsigned short*)(Vt + (cc * 8 + e) * 264 + r * 2) = (unsigned short)((e & 1) ? (wv >> 16) : (wv & 0xffffu)); } }
            __syncthreads();
            f32x16 s[4];
#pragma unroll
            for (int j = 0; j < 4; ++j) {
#pragma unroll
                for (int i = 0; i < 16; ++i) s[j][i] = 0.f;
#pragma unroll
                for (int c8 = 0; c8 < 8; ++c8) { const bf16x8 kf = *(const LAS bf16x8*)(Ks + (j * 32 + l32) * 272 + c8 * 32 + h * 16);
                    s[j] = __builtin_amdgcn_mfma_f32_32x32x16_bf16(kf, qf[c8], s[j], 0, 0, 0); }
            }
            if (kc != 1) {
                int hb = (kc == 0) ? (4 * h - qrl) : (qrl - 4 * h); asm volatile("" : "+v"(hb));
#pragma unroll
                for (int j = 0; j < 4; ++j)
#pragma unroll
                    for (int i = 0; i < 16; ++i) { const int ko = j * 32 + (i & 3) + 8 * (i >> 2); const int dlt = (kc == 0) ? (hb + ko) : (hb - ko); const unsigned t = (unsigned)(dlt >> 31);
                        s[j][i] = __uint_as_float((__float_as_uint(s[j][i]) & ~t) | (0xF149F2CAu & t)); }
            }
            float mx = -3e38f;
#pragma unroll
            for (int j = 0; j < 4; ++j)
#pragma unroll
                for (int i = 0; i < 16; ++i) mx = fmaxf(mx, s[j][i]);
            mx = fmaxf(mx, shx(mx, 32, lane));
            const float mnew = fmaxf(mrun, mx); const float alpha = __builtin_amdgcn_exp2f(mrun - mnew); mrun = mnew;
            float psum = 0.f;
#pragma unroll
            for (int j = 0; j < 4; ++j)
#pragma unroll
                for (int i = 0; i < 16; ++i) { const float p = __builtin_amdgcn_exp2f(s[j][i] - mnew); s[j][i] = p; psum += p; }
            psum += shx(psum, 32, lane);
            lrun = lrun * alpha + psum;
#pragma unroll
            for (int dd = 0; dd < 4; ++dd)
#pragma unroll
                for (int i = 0; i < 16; ++i) o[dd][i] *= alpha;
#pragma unroll
            for (int j = 0; j < 4; ++j)
#pragma unroll
                for (int s2 = 0; s2 < 2; ++s2) {
                    u32x4 pw; pw.x = pk2(s[j][8 * s2 + 0], s[j][8 * s2 + 1]); pw.y = pk2(s[j][8 * s2 + 2], s[j][8 * s2 + 3]); pw.z = pk2(s[j][8 * s2 + 4], s[j][8 * s2 + 5]); pw.w = pk2(s[j][8 * s2 + 6], s[j][8 * s2 + 7]);
                    const bf16x8 pf = __builtin_bit_cast(bf16x8, pw);
#pragma unroll
                    for (int dd = 0; dd < 4; ++dd) { const LAS unsigned char* vp = Vt + (dd * 32 + l32) * 264 + (j * 32 + 16 * s2 + 4 * h) * 2;
                        const u32x2 lo = *(const LAS u32x2*)vp, hi = *(const LAS u32x2*)(vp + 16);
                        const u32x4 vw = {lo.x, lo.y, hi.x, hi.y};
                        o[dd] = __builtin_amdgcn_mfma_f32_32x32x16_bf16(__builtin_bit_cast(bf16x8, vw), pf, o[dd], 0, 0, 0); }
                }
        }
        const float inv = __builtin_amdgcn_rcpf(lrun);
        bf16* op = att + qrow * 1024 + hq * 128;
#pragma unroll
        for (int dd = 0; dd < 4; ++dd)
#pragma unroll
            for (int i4 = 0; i4 < 4; ++i4) { const int d0 = dd * 32 + 8 * i4 + 4 * h;
                *(u32x2*)(op + d0) = (u32x2){pk2(o[dd][4 * i4] * inv, o[dd][4 * i4 + 1] * inv), pk2(o[dd][4 * i4 + 2] * inv, o[dd][4 * i4 + 3] * inv)}; }
    }
}
DI void scan_phase(const int wid_s, LAS unsigned char* lds, const bf16* LA, const bf16* U, const bf16* gy, bf16* HG, int c, int G) {
    const int tid = get_tid(wid_s); const int w = wid_s, lane = tid & 63, cp = lane & 31, half = lane >> 5, sgi = 2 * w + half;
    LAS float* sP = (LAS float*)lds; LAS float* sH = sP + 16 * 64;
    for (int it = c; it < 256; it += G) {
        const int cgp = it & 15, dir = (it >> 4) & 1, b = it >> 5;
        const int ch = cgp * 64 + cp * 2;
        const size_t rb = (size_t)b * SEQ;
        const bf16* la = LA + ((size_t)dir * M + rb) * 1024 + ch; const bf16* uu = U + ((size_t)dir * M + rb) * 1024 + ch;
        const bf16* gp = gy + rb * 1024 + ch; bf16* hp = HG + rb * 2048 + dir * 1024 + ch;
        const int sbase = sgi * 128;
        float P0 = 1.f, P1 = 1.f, H0 = 0.f, H1 = 0.f;
        for (int j0 = 0; j0 < 128; j0 += 8) {
            unsigned lv[8], uv[8];
#pragma unroll
            for (int j = 0; j < 8; ++j) { const int sidx = sbase + j0 + j; const int t = dir ? (SEQ - 1 - sidx) : sidx; lv[j] = *(const unsigned*)(la + (size_t)t * 1024); uv[j] = *(const unsigned*)(uu + (size_t)t * 1024); }
#pragma unroll
            for (int j = 0; j < 8; ++j) { const float a0 = __builtin_amdgcn_exp2f(bflo(lv[j])), a1 = __builtin_amdgcn_exp2f(bfhi(lv[j]));
                H0 = a0 * H0 + bflo(uv[j]); H1 = a1 * H1 + bfhi(uv[j]); P0 *= a0; P1 *= a1; }
        }
        __syncthreads();
        sP[sgi * 64 + cp * 2] = P0; sP[sgi * 64 + cp * 2 + 1] = P1; sH[sgi * 64 + cp * 2] = H0; sH[sgi * 64 + cp * 2 + 1] = H1;
        __syncthreads();
        float c0 = 0.f, c1 = 0.f;
        for (int s = 0; s < sgi; ++s) { c0 = sP[s * 64 + cp * 2] * c0 + sH[s * 64 + cp * 2]; c1 = sP[s * 64 + cp * 2 + 1] * c1 + sH[s * 64 + cp * 2 + 1]; }
        H0 = c0; H1 = c1;
        for (int j0 = 0; j0 < 128; j0 += 8) {
            unsigned lv[8], uv[8], gv[8];
#pragma unroll
            for (int j = 0; j < 8; ++j) { const int sidx = sbase + j0 + j; const int t = dir ? (SEQ - 1 - sidx) : sidx; lv[j] = *(const unsigned*)(la + (size_t)t * 1024); uv[j] = *(const unsigned*)(uu + (size_t)t * 1024); gv[j] = *(const unsigned*)(gp + (size_t)t * 1024); }
#pragma unroll
            for (int j = 0; j < 8; ++j) { const int sidx = sbase + j0 + j; const int t = dir ? (SEQ - 1 - sidx) : sidx;
                const float a0 = __builtin_amdgcn_exp2f(bflo(lv[j])), a1 = __builtin_amdgcn_exp2f(bfhi(lv[j]));
                H0 = a0 * H0 + bflo(uv[j]); H1 = a1 * H1 + bfhi(uv[j]);
                *(unsigned*)(hp + (size_t)t * 2048) = pk2(H0 * bflo(gv[j]), H1 * bfhi(gv[j])); }
        }
    }
}
#define XB_TMO      128
#define XB_XCNT(j)  (256  + 64 * (j))
#define XB_XSUB(j)  (1280 + 64 * (j))
#define XB_XGEN(j)  (2304 + 64 * (j))
#define XB_TOP      3328
#define XB_TOPGEN   3392
#define XCD_BAR_WORDS 3456
#define XB_SPIN_CAP (1u << 18)

__device__ __forceinline__ unsigned xb_ld(unsigned* p)              { return __hip_atomic_load(p, __ATOMIC_RELAXED, __HIP_MEMORY_SCOPE_AGENT); }
__device__ __forceinline__ unsigned xb_add(unsigned* p, unsigned v) { return __hip_atomic_fetch_add(p, v, __ATOMIC_RELAXED, __HIP_MEMORY_SCOPE_AGENT); }
__device__ __forceinline__ unsigned xb_xcc_id() { return (unsigned)__builtin_amdgcn_s_getreg((3 << 11) | 20) & 0xFu; }
#define XB_SPIN(cond, bar) do { unsigned _sp = 0; while (cond) { __builtin_amdgcn_s_sleep(1); \
    if ((++_sp & 255u) == 0u) { if (xb_ld(&(bar)[XB_TMO])) break; if (_sp > XB_SPIN_CAP) { atomicAdd(&(bar)[XB_TMO], 1u); break; } } } } while (0)

struct XcdBarrier {
    unsigned* bar; unsigned x;
    volatile LAS unsigned* st;
};

__device__ __forceinline__ XcdBarrier xcd_barrier_post(unsigned* bar, volatile LAS unsigned* st, int tid) {
    XcdBarrier b; b.bar = bar; b.x = xb_xcc_id(); b.st = st;
    if (tid == 0) (void)xb_add(&bar[XB_XCNT(b.x)], 1u);
    return b;
}
__device__ __forceinline__ void xcd_barrier_complete(unsigned* bar, unsigned x, unsigned& nloc, unsigned& nx) {
    const unsigned G = gridDim.x * gridDim.y * gridDim.z;
    unsigned sum, cnt, mine, sp = 0u;
    for (;;) {
        sum = 0u; cnt = 0u; mine = 0u;
#pragma unroll
        for (unsigned j = 0; j < 16; ++j) { const unsigned c = xb_ld(&bar[XB_XCNT(j)]); sum += c; cnt += (c > 0u) ? 1u : 0u; mine = (j == x) ? c : mine; }
        if (sum == G) break;
        __builtin_amdgcn_s_sleep(1);
        if ((++sp & 255u) == 0u) { if (xb_ld(&bar[XB_TMO])) break; if (sp > XB_SPIN_CAP) { atomicAdd(&bar[XB_TMO], 1u); break; } }
    }
    nloc = mine > 0u ? mine : 1u; nx = cnt > 0u ? cnt : 1u;
}

__device__ __forceinline__ void xcd_barrier(const XcdBarrier& b, int tid) {
    asm volatile("s_waitcnt vmcnt(0)" ::: "memory");
    __syncthreads();
    if (tid == 0) {
        unsigned* bar = b.bar;
        __builtin_amdgcn_s_waitcnt(0);
        unsigned nloc = b.st[0], nx = b.st[1];
        if (nloc == 0u) { xcd_barrier_complete(bar, b.x, nloc, nx); b.st[0] = nloc; b.st[1] = nx; }
        const unsigned old = xb_add(&bar[XB_XSUB(b.x)], 1u);
        const unsigned gen = old / nloc;
        if (old + 1u == (gen + 1u) * nloc) {
            __builtin_amdgcn_fence(__ATOMIC_RELEASE, "agent");
            asm volatile("s_waitcnt vmcnt(0)" ::: "memory");
            const unsigned og = xb_add(&bar[XB_TOP], 1u);
            const unsigned tg = og / nx;
            if (og + 1u == (tg + 1u) * nx) xb_add(&bar[XB_TOPGEN], 1u);
            else XB_SPIN(xb_ld(&bar[XB_TOPGEN]) == tg, bar);
            __builtin_amdgcn_fence(__ATOMIC_ACQUIRE, "agent");
            xb_add(&bar[XB_XGEN(b.x)], 1u);
            asm volatile("s_waitcnt vmcnt(0)" ::: "memory");
        } else {
            XB_SPIN(xb_ld(&bar[XB_XGEN(b.x)]) == gen, bar);
            __builtin_amdgcn_fence(__ATOMIC_ACQUIRE, "agent");
            asm volatile("s_waitcnt vmcnt(0)" ::: "memory");
        }
    }
    __syncthreads();
}

struct Args { InPtrs I; float* out; unsigned char* ws; int ph_lo, ph_hi; };
#ifndef ONLY
#define ONLY -1
#endif
#define CASE_ON(n) if constexpr (ONLY < 0 || ONLY == (n))
#ifndef PROBE_K
#define PROBE_K -1
#endif
constexpr int PH_PER_LAYER = 11 + (PROBE_K >= 0 ? 1 : 0), N_PHASES = 1 + DEPTH * PH_PER_LAYER;

__global__ void __launch_bounds__(512, 2) fwd_kernel(Args args) {
    extern __shared__ __attribute__((aligned(16))) unsigned char lds_raw[];
    LAS unsigned char* lds = (LAS unsigned char*)lds_raw;
    cg::grid_group grid = cg::this_grid();
    const int wid_s = __builtin_amdgcn_readfirstlane((int)threadIdx.x >> 6);
    XcdBarrier bar;
    {
        const int tid0 = get_tid(wid_s);
        unsigned* barw = (unsigned*)(args.ws + WS_BAR);
        volatile LAS unsigned* st = (volatile LAS unsigned*)(lds + 131072 + 64);
        if (blockIdx.x == 0) for (int i = tid0; i < XCD_BAR_WORDS; i += 512) __hip_atomic_store(barw + i, 0u, __ATOMIC_RELAXED, __HIP_MEMORY_SCOPE_AGENT);
        if (tid0 < 2) st[tid0] = 0u;
        __syncthreads();
        grid.sync();
        bar = xcd_barrier_post(barw, st, tid0);
    }
    for (int ph = args.ph_lo; ph < args.ph_hi; ++ph) {
        kptr_t kp = (kptr_t)__builtin_amdgcn_kernarg_segment_ptr(); asm volatile("" : "+s"(kp));
        float* trunk = *(float* const __attribute__((address_space(4)))*)(kp + 208);
        unsigned char* ws = *(unsigned char* const __attribute__((address_space(4)))*)(kp + 216);
        const int wave = wid_s;
        int G = gridDim.x, c = blockIdx.x; asm volatile("" : "+s"(G), "+s"(c));
        const int gw = c * 8 + wave, NGW = G * 8;
        float* rope = (float*)(ws + WS_ROPE);
        bf16* Wb = (bf16*)(ws + WS_W); bf16* PB = (bf16*)(ws + WS_PB); bf16* HB = (bf16*)(ws + WS_HB); bf16* Z = (bf16*)(ws + WS_Z);
        bf16* ATT = (bf16*)(ws + WS_ATT); bf16* XFB = (bf16*)(ws + WS_XFB); bf16* UB = (bf16*)(ws + WS_EXTRA); float* T = (float*)(ws + WS_EXTRA);
        bf16* LAb = Z; bf16* HG = XFB; bf16* ACT = Z; float* SIDE = (float*)(ws + WS_ATT);
        if (ph > args.ph_lo) { xcd_barrier(bar, get_tid(wid_s));
#ifdef PROBE_SYNC2
            xcd_barrier(bar, get_tid(wid_s));
#endif
        }
        if (ph == 0) { CASE_ON(100) {
            const int tid = get_tid(wid_s), lane = tid & 63;
            convert_layer(kp, ws, 0, lds, gw, NGW, wave, lane);
            ln_rows(INP(0), trunk, HB, INP(2), INP(3), gw, NGW, lane);
            rope_table(rope, c * 512 + tid, G * 512); }
            continue;
        }
        const int l = (ph - 1) / PH_PER_LAYER; int k = (ph - 1) % PH_PER_LAYER; if (PROBE_K >= 0 && k == 11) k = PROBE_K;
        switch (k) {
        case 0: CASE_ON(0) {
            pg8::TileOrder S; S.init(M, DIN, G, c, HB, D, Wb + W_IN, D);
            EpiIn E{Z, rope};
            pg8::gemm_phase(lds, wid_s, D, D, S, E);
        } break;
        case 1: CASE_ON(1) {
            attn_phase(wid_s, lds, Z + Z_Q, Z + Z_K, Z + Z_V, ATT, INP(5) + l * NH, c, G);
            conv_phase(wid_s, Z + Z_XR, XFB, INP(6) + (size_t)l * 2 * 4 * D, INP(7) + (size_t)l * 2 * D, c, G);
        } break;
        case 2: CASE_ON(2) {
            pg8::GateOrder S{G, c, (const char*)XFB, (const char*)(Wb + W_G)};
            EpiGate E{XFB, LAb, UB, INP(9) + (size_t)l * 2 * D, INP(11) + (size_t)l * 2 * D, INP(12) + (size_t)l * 2 * D};
            pg8::gemm_phase(lds, wid_s, 256, 1024, S, E);
        } break;
        case 3: CASE_ON(3) {
            scan_phase(wid_s, lds, LAb, UB, Z + Z_GY, HG, c, G);
        } break;
        case 4: CASE_ON(4) {
#if !defined(SUB) || SUB==0
            { pg8::TileOrder S; S.init(M, D, G, c, ATT, D, Wb + W_PA, D); EpiX<EP_PA> E{T, nullptr, Z + Z_SA, nullptr}; pg8::gemm_phase(lds, wid_s, D, D, S, E); }
#endif
#if !defined(SUB) || SUB==1
            { pg8::TileOrder S; S.init(M, D, G, c, HG, 2 * D, Wb + W_PR, 2 * D); EpiX<EP_PR> E{T, nullptr, Z + Z_SR, HB}; pg8::gemm_phase(lds, wid_s, 2 * D, 2 * D, S, E); }
#endif
        } break;
        case 5: CASE_ON(5) {
            pg8::TileOrder S; S.init(M, D, G, c, HB, D, Wb + W_O, D); EpiX<EP_OUT> E{trunk, nullptr, nullptr, nullptr}; pg8::gemm_phase(lds, wid_s, D, D, S, E);
        } break;
        case 6: CASE_ON(6) {
            const int lane = get_tid(wid_s) & 63;
            ln_rows(trunk, trunk, HB, INP(16) + (size_t)l * D, INP(17) + (size_t)l * D, gw, NGW, lane);
        } break;
        case 7: CASE_ON(7) {
            pg8::TileOrder S; S.init(M, 2 * DFF, G, c, HB, D, Wb + W_UP, D);
            EpiUpG E{ACT, SIDE, INP(19) + (size_t)l * 3 * DFF, INP(20) + (size_t)l * DFF, (LAS float*)(lds + 131072 + 1024)};
            pg8::gemm_phase(lds, wid_s, D, D, S, E);
        } break;
        case 8: CASE_ON(8) {
            geglu_fix(wid_s, ACT, SIDE, INP(19) + (size_t)l * 3 * DFF, INP(20) + (size_t)l * DFF, c, G);
            { pg8::TileOrder S; S.init(M, D, G, c, PB, DPLE, Wb + W_PLE, DPLE); EpiX<EP_PLE1> E{T, nullptr, nullptr, nullptr}; pg8::gemm_phase(lds, wid_s, DPLE, DPLE, S, E); }
            { pg8::TileOrder S; S.init(M, D, G, c, HB, D, Wb + W_PG, D); EpiX<EP_PLE2> E{T, trunk, nullptr, nullptr}; pg8::gemm_phase(lds, wid_s, D, D, S, E); }
        } break;
        case 9: CASE_ON(9) {
            pg8::TileOrder S; S.init(M, D, G, c, ACT, DFF, Wb + W_DN, DFF); EpiX<EP_DOWN> E{trunk, nullptr, nullptr, nullptr}; pg8::gemm_phase(lds, wid_s, DFF, DFF, S, E);
        } break;
        case 10: CASE_ON(10) {
            const int lane = get_tid(wid_s) & 63;
            ln_rows(trunk, trunk, HB, INP(24) + (size_t)l * D, INP(25) + (size_t)l * D, gw, NGW, lane);
            if (l + 1 < DEPTH) convert_layer(kp, ws, l + 1, lds, gw, NGW, wave, lane);
        } break;
        }
    }
}

extern "C" void kernel_launch(void* const* d_in, const int* in_sizes, int n_in, void* d_out, int out_size, void* d_ws, size_t ws_size, hipStream_t stream) {
    static int grid = 0;
    if (grid == 0) {
        if (n_in != 26 || out_size != M * D || ws_size < WS_END) { fprintf(stderr, "kernel_launch: unexpected sizes n_in %d out %d ws %zu\n", n_in, out_size, ws_size); grid = -1; return; }
        int dev = 0, cus = 0, per_cu = 0;
        hipGetDevice(&dev); hipDeviceGetAttribute(&cus, hipDeviceAttributeMultiprocessorCount, dev);
        if (hipFuncSetAttribute((const void*)fwd_kernel, hipFuncAttributeMaxDynamicSharedMemorySize, LDS_BYTES) != hipSuccess) { fprintf(stderr, "kernel_launch: hipFuncSetAttribute failed\n"); grid = -1; return; }
        hipOccupancyMaxActiveBlocksPerMultiprocessor(&per_cu, (const void*)fwd_kernel, 512, LDS_BYTES);
        (void)hipGetLastError();
        if (per_cu < 1) per_cu = 1;
        grid = cus * 1;
        if (grid > 256) grid = 256;
        fprintf(stderr, "kernel_launch: cus %d per_cu %d grid %d ws %zu\n", cus, per_cu, grid, ws_size);
    }
    if (grid < 0) return;
    Args a{};
    for (int i = 0; i < 26; ++i) a.I.in[i] = (const float*)d_in[i];
    a.out = (float*)d_out; a.ws = (unsigned char*)d_ws; a.ph_lo = 0; a.ph_hi = N_PHASES;
    void* kargs[] = {&a};
    hipError_t e = hipLaunchCooperativeKernel((const void*)fwd_kernel, dim3(grid), dim3(512), kargs, LDS_BYTES, stream);
    if (e != hipSuccess) fprintf(stderr, "kernel_launch: cooperative launch failed: %s\n", hipGetErrorString(e));
}
```

```cpp
#include <hip/hip_runtime.h>
#include <hip/hip_cooperative_groups.h>
#include <cstdio>
#include <cstdint>
namespace cg = cooperative_groups;

#define LAS __attribute__((address_space(3)))
#define DI __device__ __forceinline__
typedef unsigned short bf16;
typedef short bf16x8 __attribute__((ext_vector_type(8)));
typedef float f32x4 __attribute__((ext_vector_type(4)));
typedef float f32x16 __attribute__((ext_vector_type(16)));
typedef unsigned u32x4 __attribute__((ext_vector_type(4)));
typedef unsigned u32x2 __attribute__((ext_vector_type(2)));
typedef __bf16 bf16x2_t __attribute__((ext_vector_type(2)));
typedef float f32x2_t __attribute__((ext_vector_type(2)));

constexpr int BATCH = 8, SEQ = 2048, D = 1024, DEPTH = 4, M = BATCH * SEQ;
constexpr int NH = 8, NKV = 2, HD = 128, DIN = 5632, DFF = 3072, DPLE = 256;
constexpr float LN_EPS = 1e-5f;
constexpr float DN_ALPHA = 1.6817928305074290f;
constexpr float LOG2E = 1.4426950408889634f;
constexpr float QSCALE = 0.08838834764831845f * LOG2E;

constexpr size_t MiB = 1u << 20;
constexpr size_t WS_ROPE = 0;
constexpr size_t WS_BAR = 512 * 1024;
constexpr size_t WS_CNT = 512 * 1024 + 65536;
constexpr int CNT_WORDS = 8 * 64 * 16;
constexpr size_t WS_W = 1 * MiB;
constexpr size_t W_IN = 0, W_G = W_IN + (size_t)DIN * D, W_PA = W_G + 8 * 512 * 256, W_PR = W_PA + (size_t)D * D, W_O = W_PR + (size_t)D * 2 * D,
                 W_UP = W_O + (size_t)D * D, W_DN = W_UP + (size_t)2 * DFF * D, W_PLE = W_DN + (size_t)D * DFF, W_PG = W_PLE + (size_t)D * DPLE, W_END = W_PG + (size_t)D * D;
static_assert(W_END * 2 <= 42 * MiB, "weights");
constexpr size_t WS_PB = WS_W + 42 * MiB;
constexpr size_t WS_HB = WS_PB + 8 * MiB;
constexpr size_t WS_Z = WS_HB + 32 * MiB;
constexpr size_t WS_ATT = WS_Z + 176 * MiB;
constexpr size_t WS_XFB = WS_ATT + 32 * MiB;
constexpr size_t WS_EXTRA = WS_XFB + 64 * MiB;
constexpr size_t WS_END = WS_EXTRA + 64 * MiB;
static_assert(WS_END <= 440 * MiB, "ws");
constexpr size_t Z_Q = 0, Z_K = (size_t)M * 1024, Z_V = (size_t)M * 1280, Z_XR = (size_t)M * 1536, Z_GY = (size_t)M * 2560, Z_SA = (size_t)M * 3584, Z_SR = (size_t)M * 4608;

constexpr int LDS_BYTES = 139264;

DI unsigned pk2(float lo, float hi) { f32x2_t v = {lo, hi}; bf16x2_t b = __builtin_convertvector(v, bf16x2_t); return __builtin_bit_cast(unsigned, b); }
DI float bflo(unsigned u) { return __uint_as_float(u << 16); }
DI float bfhi(unsigned u) { return __uint_as_float(u & 0xffff0000u); }
DI float sigm(float x) { return __builtin_amdgcn_rcpf(1.f + __builtin_amdgcn_exp2f(-LOG2E * x)); }
DI float gelu_t(float x) { const float u = 0.7978845608028654f * (x + 0.044715f * x * x * x); return x * sigm(2.f * u); }
DI void unpack8(const u32x4 w, float (&v)[8]) { v[0] = bflo(w.x); v[1] = bfhi(w.x); v[2] = bflo(w.y); v[3] = bfhi(w.y); v[4] = bflo(w.z); v[5] = bfhi(w.z); v[6] = bflo(w.w); v[7] = bfhi(w.w); }
DI u32x4 pack8(const float (&v)[8]) { u32x4 w; w.x = pk2(v[0], v[1]); w.y = pk2(v[2], v[3]); w.z = pk2(v[4], v[5]); w.w = pk2(v[6], v[7]); return w; }
DI float shx(float v, int mask, int lane) { return __int_as_float(__builtin_amdgcn_ds_bpermute((lane ^ mask) << 2, __float_as_int(v))); }
DI float wave_sum(float v, int lane) {
#pragma unroll
    for (int o = 1; o < 64; o <<= 1) v += shx(v, o, lane);
    return v;
}
DI int get_tid(int wid_s) { int l; asm volatile("v_mbcnt_lo_u32_b32 %0, -1, 0\n\tv_mbcnt_hi_u32_b32 %0, -1, %0" : "=v"(l)); return wid_s * 64 + l; }
#define LDS_WAIT() asm volatile("s_waitcnt lgkmcnt(0)" ::: "memory")

namespace pg8 {
constexpr int BM = 256, BK = 64, HALF = 128, HTB = HALF * BK * 2, NXCD = 8, WGM = 8;
DI int lds_byte(int r, int c) { const int st = (r >> 4) * 2 + (c >> 5), rr = r & 15, cc = c & 31, ob = rr * 64 + cc * 2; return st * 1024 + (ob ^ (((ob >> 9) & 1) << 5)); }
DI void stage_rc(int b, int& R, int& C) { const int st = b / 1024, sb = b % 1024, swz = sb ^ (((sb >> 9) & 1) << 5); R = (st >> 1) * 16 + swz / 64; C = (st & 1) * 32 + (swz % 64) / 2; }
DI int perm32(int rho) { const int n = rho >> 4, i = rho & 15; return 8 * (i >> 2) + 4 * n + (i & 3); }
struct Unit { int pm, pn, g; };

struct TileOrder {
    int nM, nN, nwg, G, c; const char* Ab; const char* Bb; size_t atile, btile;
    DI void init(int Mr, int N, int G_, int c_, const void* A, int lda, const void* Bt, int K) { nM = Mr / BM; nN = N / BM; nwg = nM * nN; G = G_; c = c_; Ab = (const char*)A; Bb = (const char*)Bt; atile = (size_t)BM * lda * 2; btile = (size_t)BM * K * 2; }
    DI bool next(int i, Unit& u) const {
        const int L = i * G + c; if (L >= nwg) return false;
        int wgid = L; { const int q = nwg / NXCD, r = nwg % NXCD, xcd = wgid % NXCD, off = wgid / NXCD; wgid = (xcd < r ? xcd * (q + 1) : r * (q + 1) + (xcd - r) * q) + off; }
        const int nig = WGM * nN, gid = wgid / nig, fm = gid * WGM, gsz = (nM - fm) < WGM ? (nM - fm) : WGM;
        u.pm = fm + ((wgid % nig) % gsz); u.pn = (wgid % nig) / gsz; u.g = 0; return true;
    }
    DI const char* A(const Unit& u) const { return Ab + (size_t)u.pm * atile; }
    DI const char* B(const Unit& u) const { return Bb + (size_t)u.pn * btile; }
};
struct GateOrder {
    int G, c; const char* Ab; const char* Bb;
    DI bool next(int i, Unit& u) const {
        const int L = i * G + c; if (L >= 1024) return false;
        const int id = (L & 7) * 128 + (L >> 3); u.g = id >> 7; u.pm = (id & 127) >> 1; u.pn = id & 1; return true;
    }
    DI const char* A(const Unit& u) const { const int dir = u.g >> 2, blk = u.g & 3; return Ab + (((size_t)dir * M + (size_t)u.pm * 256) * 1024 + blk * 256) * 2; }
    DI const char* B(const Unit& u) const { return Bb + ((size_t)u.g * 512 + u.pn * 256) * 256 * 2; }
};

template <class Epi, class Sched>
DI void gemm_phase(LAS unsigned char* lds, const int wid_s, const int K, const int lda, const Sched& S, const Epi& E) {
    int tid_ = get_tid(wid_s);
    const int tid = tid_, wid = __builtin_amdgcn_readfirstlane(tid >> 6), lane = tid & 63, wr = wid >> 2, wc = wid & 3, fr = lane & 15, fq = lane >> 4;
    const int nt = K / BK;
    unsigned voffA[2], voffB[2];
#pragma unroll
    for (int i = 0; i < 2; ++i) { int R, C; stage_rc(tid * 16 + i * 8192, R, C); const int Rb = (R & ~31) + perm32(R & 31);
        voffA[i] = (unsigned)(R * lda + C) * 2u; voffB[i] = (unsigned)(Rb * K + C) * 2u; }
    const size_t kstep = (size_t)(BK * 2);
    const size_t hstepA = (size_t)HALF * lda * 2, hstepB = (size_t)HALF * K * 2;
    const unsigned ldsw = (unsigned)wid * 1024u;
    const int aoff = lds_byte(wr * 64 + fr, fq * 8), boff = lds_byte(wc * 32 + fr, fq * 8);
#define PG8_SA(b, h) (((b) * 2 + (h)) * HTB)
#define PG8_SB(b, h) ((4 + (b) * 2 + (h)) * HTB)
#define PG8_STAGE(bufoff, gbase, voff) do { _Pragma("unroll") for (int _i = 0; _i < 2; ++_i) \
        __builtin_amdgcn_global_load_lds((const unsigned*)((const char*)(gbase) + (voff)[_i]), (LAS unsigned*)(lds + (bufoff) + ldsw + _i * 8192), 16, 0, 0); } while (0)
#define PG8_LDA(dst, b, h) do { _Pragma("unroll") for (int m = 0; m < 4; ++m) _Pragma("unroll") for (int k = 0; k < 2; ++k) dst[m][k] = *(const LAS bf16x8*)(lds + PG8_SA(b, h) + aoff + m * 2048 + k * 1024); } while (0)
#define PG8_LDB(dst, b, h) do { _Pragma("unroll") for (int n = 0; n < 2; ++n) _Pragma("unroll") for (int k = 0; k < 2; ++k) dst[n][k] = *(const LAS bf16x8*)(lds + PG8_SB(b, h) + boff + n * 2048 + k * 1024); } while (0)
#define PG8_MMA(ai, bj, At, Bt) do { __builtin_amdgcn_s_setprio(1); _Pragma("unroll") for (int m = 0; m < 4; ++m) _Pragma("unroll") for (int n = 0; n < 2; ++n) _Pragma("unroll") for (int k = 0; k < 2; ++k) \
        acc[ai][bj][m][n] = __builtin_amdgcn_mfma_f32_16x16x32_bf16(Bt[n][k], At[m][k], acc[ai][bj][m][n], 0, 0, 0); __builtin_amdgcn_s_setprio(0); } while (0)
#define PG8_WAIT_V(n) asm volatile("s_waitcnt vmcnt(" #n ")" ::: "memory")
#define PG8_WAIT_L(n) asm volatile("s_waitcnt lgkmcnt(" #n ")" ::: "memory")
#define PG8_BAR __builtin_amdgcn_s_barrier()
#define PG8_SCHED __builtin_amdgcn_sched_barrier(0)
    PG8_SCHED;
    Unit cur, nxt; int ui = 0;
    if (!S.next(0, cur)) return;
    f32x4 acc[2][2][4][2];
#pragma unroll
    for (int a = 0; a < 2; ++a)
#pragma unroll
        for (int b = 0; b < 2; ++b)
#pragma unroll
            for (int m = 0; m < 4; ++m)
#pragma unroll
                for (int n = 0; n < 2; ++n) acc[a][b][m][n] = (f32x4){0.f, 0.f, 0.f, 0.f};
    bf16x8 At[4][2], B0[2][2], B1[2][2];
    const char* cA = S.A(cur); const char* cB = S.B(cur);
    PG8_STAGE(PG8_SB(0, 0), cB, voffB); PG8_STAGE(PG8_SB(0, 1), cB + hstepB, voffB); PG8_STAGE(PG8_SA(0, 0), cA, voffA); PG8_STAGE(PG8_SA(0, 1), cA + hstepA, voffA);
    if (wr == 1) PG8_BAR;
    PG8_WAIT_V(2); PG8_BAR;
    PG8_STAGE(PG8_SB(1, 0), cB + kstep, voffB); PG8_STAGE(PG8_SA(1, 0), cA + kstep, voffA); PG8_STAGE(PG8_SB(1, 1), cB + hstepB + kstep, voffB);
    PG8_WAIT_V(6); PG8_BAR;
    for (;;) {
        const bool has_next = S.next(ui + 1, nxt);
        const char* nA = has_next ? S.A(nxt) : cA; const char* nB = has_next ? S.B(nxt) : cB;
        for (int t = 0; t < nt; t += 2) {
            const bool last = (t == nt - 2);
            const char* a1 = cA + (size_t)(t + 1) * kstep;
            const char* a2 = last ? nA : cA + (size_t)(t + 2) * kstep; const char* b2 = last ? nB : cB + (size_t)(t + 2) * kstep;
            const char* a3 = a2 + kstep; const char* b3 = b2 + kstep;
            PG8_LDB(B0, 0, 0); PG8_LDB(B1, 0, 1); PG8_SCHED; PG8_LDA(At, 0, 0); PG8_STAGE(PG8_SA(1, 1), a1 + hstepA, voffA);
            PG8_WAIT_V(8); PG8_WAIT_L(0); PG8_BAR; PG8_MMA(0, 0, At, B0); PG8_MMA(0, 1, At, B1); PG8_BAR; PG8_SCHED;
            PG8_LDA(At, 0, 1); PG8_STAGE(PG8_SB(0, 0), b2, voffB); PG8_STAGE(PG8_SB(0, 1), b2 + hstepB, voffB); PG8_STAGE(PG8_SA(0, 0), a2, voffA);
            PG8_WAIT_V(8); PG8_WAIT_L(0); PG8_BAR; PG8_MMA(1, 0, At, B0); PG8_MMA(1, 1, At, B1); PG8_BAR; PG8_SCHED;
            PG8_LDB(B0, 1, 0); PG8_LDB(B1, 1, 1); PG8_SCHED; PG8_LDA(At, 1, 0); PG8_STAGE(PG8_SA(0, 1), a2 + hstepA, voffA);
            PG8_WAIT_V(8); PG8_WAIT_L(0); PG8_BAR; PG8_MMA(0, 0, At, B0); PG8_MMA(0, 1, At, B1); PG8_BAR; PG8_SCHED;
            PG8_LDA(At, 1, 1); PG8_STAGE(PG8_SB(1, 0), b3, voffB); PG8_STAGE(PG8_SB(1, 1), b3 + hstepB, voffB); PG8_STAGE(PG8_SA(1, 0), a3, voffA);
            PG8_WAIT_V(8); PG8_WAIT_L(0); PG8_BAR; PG8_MMA(1, 0, At, B0); PG8_MMA(1, 1, At, B1); PG8_BAR; PG8_SCHED;
        }
        if (wr == 0) PG8_BAR;
        if constexpr (!Epi::AFTER_DRAIN) E(acc, cur, wr, wc, fr, fq);
        if (!has_next) break;
#pragma unroll
        for (int a = 0; a < 2; ++a)
#pragma unroll
            for (int b = 0; b < 2; ++b)
#pragma unroll
                for (int m = 0; m < 4; ++m)
#pragma unroll
                    for (int n = 0; n < 2; ++n) acc[a][b][m][n] = (f32x4){0.f, 0.f, 0.f, 0.f};
        cur = nxt; cA = nA; cB = nB; ++ui;
        if (wr == 1) PG8_BAR;
    }
    PG8_WAIT_V(0);
    PG8_BAR;
    PG8_SCHED;
    if constexpr (Epi::AFTER_DRAIN) E.fused(acc, cur, wr, wc, fr, fq, lds, tid);
#undef PG8_SA
#undef PG8_SB
#undef PG8_STAGE
#undef PG8_LDA
#undef PG8_LDB
#undef PG8_MMA
#undef PG8_WAIT_V
#undef PG8_WAIT_L
#undef PG8_BAR
#undef PG8_SCHED
}
}
using pg8::Unit;
typedef f32x4 AccT[2][2][4][2];
#define EPI_ARGS const f32x4 (&acc)[2][2][4][2], const Unit& u, int wr, int wc, int fr, int fq
#define EPI_FOR_ROWS _Pragma("unroll") for (int ai = 0; ai < 2; ++ai) _Pragma("unroll") for (int m = 0; m < 4; ++m)
#define EPI_ROW (u.pm * 256 + ai * 128 + wr * 64 + m * 16 + fr)
#define EPI_V8(bj) { acc[ai][bj][m][0][0], acc[ai][bj][m][0][1], acc[ai][bj][m][0][2], acc[ai][bj][m][0][3], acc[ai][bj][m][1][0], acc[ai][bj][m][1][1], acc[ai][bj][m][1][2], acc[ai][bj][m][1][3] }

struct EpiIn {
    static constexpr bool AFTER_DRAIN = false;
    bf16* Z; const float* rope;
    DI void operator()(EPI_ARGS) const {
        const int pn = u.pn; size_t base; int ldc, colt, mode;
        if (pn < 4) { base = Z_Q; ldc = 1024; colt = pn * 256; mode = 0; }
        else if (pn == 4) { base = Z_K; ldc = 256; colt = 0; mode = 0; }
        else if (pn == 5) { base = Z_V; ldc = 256; colt = 0; mode = 1; }
        else { const int arr = (pn - 6) >> 2; base = (size_t)M * (1536 + 1024 * arr); ldc = 1024; colt = ((pn - 6) & 3) * 256; mode = arr == 0 ? 1 : (arr == 1 ? 2 : 3); }
        const float qs = pn < 4 ? QSCALE : 1.f;
        const bool rope_w = (mode == 0) && (wc == 0);
        EPI_FOR_ROWS {
            const int row = EPI_ROW;
            bf16* rowp = Z + base + (size_t)row * ldc + colt + wc * 32 + 8 * fq;
            f32x4 cs[4];
            if (rope_w) { const f32x4* rp = (const f32x4*)(rope + ((row & (SEQ - 1)) * 16 + 8 * (fq & 1)) * 2);
#pragma unroll
                for (int i = 0; i < 4; ++i) cs[i] = rp[i]; }
#pragma unroll
            for (int bj = 0; bj < 2; ++bj) {
                float v[8] = EPI_V8(bj);
                if (mode == 0) {
                    if (rope_w) {
#pragma unroll
                        for (int e = 0; e < 8; ++e) { const float pr = shx(v[e], 32, fq * 16 + fr); const float cc = cs[e >> 1][(e & 1) * 2], ss = cs[e >> 1][(e & 1) * 2 + 1];
                            v[e] = v[e] * cc + (fq < 2 ? -pr * ss : pr * ss); }
                    }
#pragma unroll
                    for (int e = 0; e < 8; ++e) v[e] *= qs;
                } else if (mode == 2) {
#pragma unroll
                    for (int e = 0; e < 8; ++e) v[e] = gelu_t(v[e]);
                } else if (mode == 3) {
#pragma unroll
                    for (int e = 0; e < 8; ++e) v[e] = sigm(v[e]);
                }
                *(u32x4*)(rowp + bj * 128) = pack8(v);
            }
        }
    }
};
struct EpiGate {
    static constexpr bool AFTER_DRAIN = false;
    const bf16* XFB; bf16* LA; bf16* U; const float* b_a; const float* b_x; const float* lam;
    DI void operator()(EPI_ARGS) const {
        const int dir = u.g >> 2, blk = u.g & 3;
        const int ch0 = blk * 256 + u.pn * 128 + wc * 32 + 8 * fq;
        float ba[8], bx[8], cl[8];
#pragma unroll
        for (int e = 0; e < 8; ++e) { ba[e] = b_a[dir * 1024 + ch0 + e]; bx[e] = b_x[dir * 1024 + ch0 + e];
            const float l = lam[dir * 1024 + ch0 + e]; cl[e] = -8.f * __builtin_amdgcn_logf(1.f + __builtin_amdgcn_exp2f(-LOG2E * l)); }
        EPI_FOR_ROWS {
            const int row = EPI_ROW; const int t = row & (SEQ - 1);
            const bool start = dir ? (t == SEQ - 1) : (t == 0);
            const size_t off = ((size_t)dir * M + row) * 1024 + ch0;
            float x[8]; unpack8(*(const u32x4*)(XFB + off), x);
            const float va[8] = EPI_V8(0); const float vx[8] = EPI_V8(1);
            float la[8], uu[8];
#pragma unroll
            for (int e = 0; e < 8; ++e) { const float ra = sigm(va[e] + ba[e]), gx = sigm(vx[e] + bx[e]); la[e] = ra * cl[e];
                const float mult = start ? 1.f : __builtin_amdgcn_sqrtf(fmaxf(1.f - __builtin_amdgcn_exp2f(2.f * la[e]), 0.f)); uu[e] = x[e] * gx * mult; }
            *(u32x4*)(LA + off) = pack8(la); *(u32x4*)(U + off) = pack8(uu);
            __builtin_amdgcn_sched_barrier(0);
        }
    }
};
enum { EP_PA = 0, EP_PR, EP_OUT, EP_PLE1, EP_PLE2, EP_DOWN, EP_UP };
template <int MODE> struct EpiX {
    static constexpr bool AFTER_DRAIN = false;
    float* F;
    float* TR;
    const bf16* S;
    bf16* O;
    DI void operator()(EPI_ARGS) const {
        EPI_FOR_ROWS {
            const int row = EPI_ROW;
#pragma unroll
            for (int bj = 0; bj < 2; ++bj) {
                const int col = u.pn * 256 + bj * 128 + wc * 32 + 8 * fq;
                float v[8] = EPI_V8(bj);
                if constexpr (MODE == EP_UP) { *(u32x4*)(O + (size_t)row * (2 * DFF) + col) = pack8(v); }
                else {
                    const size_t off = (size_t)row * 1024 + col;
                    if constexpr (MODE == EP_PA) { float s[8]; unpack8(*(const u32x4*)(S + off), s);
                        *(f32x4*)(F + off) = (f32x4){v[0] * s[0], v[1] * s[1], v[2] * s[2], v[3] * s[3]}; *(f32x4*)(F + off + 4) = (f32x4){v[4] * s[4], v[5] * s[5], v[6] * s[6], v[7] * s[7]}; }
                    if constexpr (MODE == EP_PR) { float s[8]; unpack8(*(const u32x4*)(S + off), s); const f32x4 t0 = *(const f32x4*)(F + off), t1 = *(const f32x4*)(F + off + 4);
                        float r[8] = {t0[0] + v[0] * s[0], t0[1] + v[1] * s[1], t0[2] + v[2] * s[2], t0[3] + v[3] * s[3], t1[0] + v[4] * s[4], t1[1] + v[5] * s[5], t1[2] + v[6] * s[6], t1[3] + v[7] * s[7]};
                        *(u32x4*)(O + off) = pack8(r); }
                    if constexpr (MODE == EP_OUT) { const f32x4 t0 = *(const f32x4*)(F + off), t1 = *(const f32x4*)(F + off + 4);
                        *(f32x4*)(F + off) = (f32x4){DN_ALPHA * t0[0] + v[0], DN_ALPHA * t0[1] + v[1], DN_ALPHA * t0[2] + v[2], DN_ALPHA * t0[3] + v[3]};
                        *(f32x4*)(F + off + 4) = (f32x4){DN_ALPHA * t1[0] + v[4], DN_ALPHA * t1[1] + v[5], DN_ALPHA * t1[2] + v[6], DN_ALPHA * t1[3] + v[7]}; }
                    if constexpr (MODE == EP_PLE1) { *(f32x4*)(F + off) = (f32x4){v[0], v[1], v[2], v[3]}; *(f32x4*)(F + off + 4) = (f32x4){v[4], v[5], v[6], v[7]}; }
                    if constexpr (MODE == EP_PLE2) { const f32x4 p0 = *(const f32x4*)(F + off), p1 = *(const f32x4*)(F + off + 4); const f32x4 t0 = *(const f32x4*)(TR + off), t1 = *(const f32x4*)(TR + off + 4);
                        *(f32x4*)(TR + off) = (f32x4){DN_ALPHA * t0[0] + sigm(v[0]) * p0[0], DN_ALPHA * t0[1] + sigm(v[1]) * p0[1], DN_ALPHA * t0[2] + sigm(v[2]) * p0[2], DN_ALPHA * t0[3] + sigm(v[3]) * p0[3]};
                        *(f32x4*)(TR + off + 4) = (f32x4){DN_ALPHA * t1[0] + sigm(v[4]) * p1[0], DN_ALPHA * t1[1] + sigm(v[5]) * p1[1], DN_ALPHA * t1[2] + sigm(v[6]) * p1[2], DN_ALPHA * t1[3] + sigm(v[7]) * p1[3]}; }
                    if constexpr (MODE == EP_DOWN) { const f32x4 t0 = *(const f32x4*)(F + off), t1 = *(const f32x4*)(F + off + 4);
                        *(f32x4*)(F + off) = (f32x4){t0[0] + v[0], t0[1] + v[1], t0[2] + v[2], t0[3] + v[3]}; *(f32x4*)(F + off + 4) = (f32x4){t1[0] + v[4], t1[1] + v[5], t1[2] + v[6], t1[3] + v[7]}; }
                }
            }
            if constexpr (MODE == EP_PLE2 || MODE == EP_PR) __builtin_amdgcn_sched_barrier(0);
            else if constexpr (MODE != EP_UP && MODE != EP_PLE1) { if (m & 1) __builtin_amdgcn_sched_barrier(0); }
        }
    }
};

struct EpiLn {
    static constexpr bool AFTER_DRAIN = true;
    float* trunk; bf16* HB; const float* g; const float* bt; unsigned long long* X; unsigned* cnt; float scale;
    DI void operator()(EPI_ARGS) const {}
    DI void fused(f32x4 (&acc)[2][2][4][2], const Unit& u, int wr, int wc, int fr, int fq, LAS unsigned char* lds, int tid) const {
        LAS f32x2_t* P = (LAS f32x2_t*)lds;
        LAS f32x2_t* Sst = (LAS f32x2_t*)(lds + 8192);
        const int lane = fq * 16 + fr;
        const int col0 = u.pn * 256 + wc * 32 + 8 * fq;
        EPI_FOR_ROWS {
            const int row = EPI_ROW; float s1 = 0.f, s2 = 0.f;
#pragma unroll
            for (int bj = 0; bj < 2; ++bj) { const float* tp = trunk + (size_t)row * 1024 + col0 + bj * 128;
#pragma unroll
                for (int n = 0; n < 2; ++n) { const f32x4 t = *(const f32x4*)(tp + 4 * n); f32x4 y = acc[ai][bj][m][n] + scale * t; acc[ai][bj][m][n] = y;
                    s1 += (y[0] + y[1]) + (y[2] + y[3]); s2 += (y[0] * y[0] + y[1] * y[1]) + (y[2] * y[2] + y[3] * y[3]); } }
            s1 += shx(s1, 16, lane); s2 += shx(s2, 16, lane); s1 += shx(s1, 32, lane); s2 += shx(s2, 32, lane);
            if (fq == 0) P[(ai * 128 + wr * 64 + m * 16 + fr) * 4 + wc] = (f32x2_t){s1, s2};
            if (m & 1) __builtin_amdgcn_sched_barrier(0);
        }
        LDS_WAIT(); __builtin_amdgcn_s_barrier(); asm volatile("" ::: "memory");
        unsigned long long* slot = X + ((size_t)u.pm * 256 + (tid & 255)) * 4;
        if (tid < 256) { const f32x2_t a = P[tid * 4 + 0], b = P[tid * 4 + 1], c2 = P[tid * 4 + 2], d = P[tid * 4 + 3];
            const float t1 = (a.x + b.x) + (c2.x + d.x), t2 = (a.y + b.y) + (c2.y + d.y);
            __hip_atomic_store(slot + u.pn, ((unsigned long long)__float_as_uint(t2) << 32) | __float_as_uint(t1), __ATOMIC_RELAXED, __HIP_MEMORY_SCOPE_AGENT); }
        asm volatile("s_waitcnt vmcnt(0)" ::: "memory"); __builtin_amdgcn_s_barrier(); asm volatile("" ::: "memory");
        if (tid == 0) {
            __hip_atomic_fetch_add(cnt + u.pm * 16, 1u, __ATOMIC_RELAXED, __HIP_MEMORY_SCOPE_AGENT);
            unsigned sp = 0; while (__hip_atomic_load(cnt + u.pm * 16, __ATOMIC_RELAXED, __HIP_MEMORY_SCOPE_AGENT) < 4u) { __builtin_amdgcn_s_sleep(1); if (++sp > (1u << 22)) break; }
            __builtin_amdgcn_fence(__ATOMIC_ACQUIRE, "agent"); asm volatile("s_waitcnt vmcnt(0)" ::: "memory");
        }
        __builtin_amdgcn_s_barrier(); asm volatile("" ::: "memory");
        if (tid < 256) { float t1 = 0.f, t2 = 0.f;
#pragma unroll
            for (int j = 0; j < 4; ++j) { const unsigned long long v = __hip_atomic_load(slot + j, __ATOMIC_RELAXED, __HIP_MEMORY_SCOPE_AGENT); t1 += __uint_as_float((unsigned)v); t2 += __uint_as_float((unsigned)(v >> 32)); }
            const float mean = t1 * (1.f / D), var = fmaxf(t2 * (1.f / D) - mean * mean, 0.f);
            Sst[tid] = (f32x2_t){mean, __builtin_amdgcn_rsqf(var + LN_EPS)}; }
        LDS_WAIT(); __builtin_amdgcn_s_barrier(); asm volatile("" ::: "memory");
        f32x4 gg[2][2], bb[2][2];
#pragma unroll
        for (int bj = 0; bj < 2; ++bj)
#pragma unroll
            for (int n = 0; n < 2; ++n) { gg[bj][n] = *(const f32x4*)(g + col0 + bj * 128 + 4 * n); bb[bj][n] = *(const f32x4*)(bt + col0 + bj * 128 + 4 * n); }
        EPI_FOR_ROWS {
            const int row = EPI_ROW; const f32x2_t st = Sst[ai * 128 + wr * 64 + m * 16 + fr];
#pragma unroll
            for (int bj = 0; bj < 2; ++bj) { const size_t off = (size_t)row * 1024 + col0 + bj * 128;
                const f32x4 o0 = (acc[ai][bj][m][0] - st.x) * st.y * gg[bj][0] + bb[bj][0], o1 = (acc[ai][bj][m][1] - st.x) * st.y * gg[bj][1] + bb[bj][1];
                *(f32x4*)(trunk + off) = o0; *(f32x4*)(trunk + off + 4) = o1;
                *(u32x4*)(HB + off) = (u32x4){pk2(o0[0], o0[1]), pk2(o0[2], o0[3]), pk2(o1[0], o1[1]), pk2(o1[2], o1[3])}; }
            if (m & 1) __builtin_amdgcn_sched_barrier(0);
        }
    }
};
DI float dpp_ror1(float v) { return __int_as_float(__builtin_amdgcn_update_dpp(0, __float_as_int(v), 0x121, 0xf, 0xf, false)); }
DI float dpp_ror15(float v) { return __int_as_float(__builtin_amdgcn_update_dpp(0, __float_as_int(v), 0x12F, 0xf, 0xf, false)); }
constexpr size_t SIDE_STRIDE = 3 * DFF;
struct EpiUpG {
    static constexpr bool AFTER_DRAIN = false;
    bf16* ACT; float* SIDE; const float* fw; const float* fb; LAS float* xch;
    DI void operator()(EPI_ARGS) const {
        const int ch0 = u.pn * 128 + wc * 32 + 8 * fq;
        float w0[8], w1[8], w2[8], bb[8];
        { const f32x4 a0 = *(const f32x4*)(fw + ch0), a1 = *(const f32x4*)(fw + ch0 + 4), b0 = *(const f32x4*)(fw + DFF + ch0), b1 = *(const f32x4*)(fw + DFF + ch0 + 4),
                      c0 = *(const f32x4*)(fw + 2 * DFF + ch0), c1 = *(const f32x4*)(fw + 2 * DFF + ch0 + 4), d0 = *(const f32x4*)(fb + ch0), d1 = *(const f32x4*)(fb + ch0 + 4);
#pragma unroll
          for (int e = 0; e < 4; ++e) { w0[e] = a0[e]; w0[e + 4] = a1[e]; w1[e] = b0[e]; w1[e + 4] = b1[e]; w2[e] = c0[e]; w2[e + 4] = c1[e]; bb[e] = d0[e]; bb[e + 4] = d1[e]; } }
#pragma unroll
        for (int ai = 0; ai < 2; ++ai) { const int gi = 2 * ai + wr;
            if (fr == 0) { LAS float* p = xch + ((gi * 4 + wc) * 2 + 0) * 32 + 8 * fq; *(LAS f32x4*)p = acc[ai][0][0][0]; *(LAS f32x4*)(p + 4) = acc[ai][0][0][1]; }
            if (fr == 15) { LAS float* p = xch + ((gi * 4 + wc) * 2 + 1) * 32 + 8 * fq; *(LAS f32x4*)p = acc[ai][0][3][0]; *(LAS f32x4*)(p + 4) = acc[ai][0][3][1]; } }
        LDS_WAIT(); __builtin_amdgcn_s_barrier(); asm volatile("" ::: "memory");
        const bool seq_first = (u.pm & 7) == 0, seq_last = (u.pm & 7) == 7;
#pragma unroll
        for (int ai = 0; ai < 2; ++ai) { const int gi = 2 * ai + wr;
            float pf[8], nf[8];
#pragma unroll
            for (int e = 0; e < 8; ++e) { pf[e] = 0.f; nf[e] = 0.f; }
            if (gi > 0) { const LAS float* p = xch + (((gi - 1) * 4 + wc) * 2 + 1) * 32 + 8 * fq; const f32x4 a = *(const LAS f32x4*)p, b = *(const LAS f32x4*)(p + 4);
#pragma unroll
                for (int e = 0; e < 4; ++e) { pf[e] = a[e]; pf[e + 4] = b[e]; } }
            if (gi < 3) { const LAS float* p = xch + (((gi + 1) * 4 + wc) * 2 + 0) * 32 + 8 * fq; const f32x4 a = *(const LAS f32x4*)p, b = *(const LAS f32x4*)(p + 4);
#pragma unroll
                for (int e = 0; e < 4; ++e) { nf[e] = a[e]; nf[e + 4] = b[e]; } }
#pragma unroll
            for (int m = 0; m < 4; ++m) {
                const int row = EPI_ROW;
                float cv[8], o[8];
#pragma unroll
                for (int e = 0; e < 8; ++e) {
                    const float g = acc[ai][0][m][e >> 2][e & 3];
                    const float upn = dpp_ror1(g), dnn = dpp_ror15(g);
                    const float upe = (m > 0) ? dpp_ror1(acc[ai][0][m > 0 ? m - 1 : 0][e >> 2][e & 3]) : pf[e];
                    const float dne = (m < 3) ? dpp_ror15(acc[ai][0][m < 3 ? m + 1 : 3][e >> 2][e & 3]) : nf[e];
                    const float up = (fr == 0) ? upe : upn, dn = (fr == 15) ? dne : dnn;
                    cv[e] = bb[e] + w0[e] * up + w1[e] * g + w2[e] * dn;
                    o[e] = gelu_t(cv[e]) * acc[ai][1][m][e >> 2][e & 3];
                }
                *(u32x4*)(ACT + (size_t)row * DFF + ch0) = pack8(o);
                if (gi == 0 && m == 0 && fr == 0 && !seq_first) { float* sp = SIDE + ((size_t)u.pm * 2 + 0) * SIDE_STRIDE + ch0;
                    *(f32x4*)sp = (f32x4){cv[0], cv[1], cv[2], cv[3]}; *(f32x4*)(sp + 4) = (f32x4){cv[4], cv[5], cv[6], cv[7]};
                    *(f32x4*)(sp + DFF) = acc[ai][1][m][0]; *(f32x4*)(sp + DFF + 4) = acc[ai][1][m][1]; *(f32x4*)(sp + 2 * DFF) = acc[ai][0][m][0]; *(f32x4*)(sp + 2 * DFF + 4) = acc[ai][0][m][1]; }
                if (gi == 3 && m == 3 && fr == 15 && !seq_last) { float* sp = SIDE + ((size_t)u.pm * 2 + 1) * SIDE_STRIDE + ch0;
                    *(f32x4*)sp = (f32x4){cv[0], cv[1], cv[2], cv[3]}; *(f32x4*)(sp + 4) = (f32x4){cv[4], cv[5], cv[6], cv[7]};
                    *(f32x4*)(sp + DFF) = acc[ai][1][m][0]; *(f32x4*)(sp + DFF + 4) = acc[ai][1][m][1]; *(f32x4*)(sp + 2 * DFF) = acc[ai][0][m][0]; *(f32x4*)(sp + 2 * DFF + 4) = acc[ai][0][m][1]; }
                __builtin_amdgcn_sched_barrier(0);
            }
        }
    }
};
DI void geglu_fix(const int wid_s, bf16* ACT, const float* SIDE, const float* fw, const float* fb, int c, int G) {
    const int tid = get_tid(wid_s);
    for (int i = c * 512 + tid; i < 63 * (DFF / 4); i += G * 512) {
        const int pm = i / (DFF / 4), ch = (i % (DFF / 4)) * 4;
        if ((pm & 7) == 7) continue;
        const float* sl = SIDE + ((size_t)pm * 2 + 1) * SIDE_STRIDE + ch;
        const float* sf = SIDE + ((size_t)(pm + 1) * 2 + 0) * SIDE_STRIDE + ch;
        const f32x4 pl = *(const f32x4*)sl, vl = *(const f32x4*)(sl + DFF), gl = *(const f32x4*)(sl + 2 * DFF);
        const f32x4 pf = *(const f32x4*)sf, vf = *(const f32x4*)(sf + DFF), gf = *(const f32x4*)(sf + 2 * DFF);
        const f32x4 w0 = *(const f32x4*)(fw + ch), w2 = *(const f32x4*)(fw + 2 * DFF + ch);
        float ol[4], of[4];
#pragma unroll
        for (int e = 0; e < 4; ++e) { ol[e] = gelu_t(pl[e] + w2[e] * gf[e]) * vl[e]; of[e] = gelu_t(pf[e] + w0[e] * gl[e]) * vf[e]; }
        *(u32x2*)(ACT + (size_t)(pm * 256 + 255) * DFF + ch) = (u32x2){pk2(ol[0], ol[1]), pk2(ol[2], ol[3])};
        *(u32x2*)(ACT + (size_t)(pm * 256 + 256) * DFF + ch) = (u32x2){pk2(of[0], of[1]), pk2(of[2], of[3])};
    }
}
DI void ln_rows(const float* src, float* dstf, bf16* dstb, const float* g, const float* bt, int gw, int NGW, int lane) {
    for (int mrow = gw; mrow < M; mrow += NGW) {
        const f32x4* xr = (const f32x4*)(src + (size_t)mrow * D) + lane;
        f32x4 v[4]; float s = 0.f;
#pragma unroll
        for (int j = 0; j < 4; ++j) { v[j] = xr[64 * j]; s += (v[j].x + v[j].y) + (v[j].z + v[j].w); }
        const float mean = wave_sum(s, lane) * (1.f / D); float s2 = 0.f;
#pragma unroll
        for (int j = 0; j < 4; ++j) { v[j] = v[j] - mean; s2 += (v[j].x * v[j].x + v[j].y * v[j].y) + (v[j].z * v[j].z + v[j].w * v[j].w); }
        const float rstd = __builtin_amdgcn_rsqf(wave_sum(s2, lane) * (1.f / D) + LN_EPS);
        f32x4* of = (f32x4*)(dstf + (size_t)mrow * D) + lane; u32x2* ob = (u32x2*)(dstb + (size_t)mrow * D) + lane;
#pragma unroll
        for (int j = 0; j < 4; ++j) { const f32x4 gg = ((const f32x4*)g)[lane + 64 * j], bb = ((const f32x4*)bt)[lane + 64 * j];
            const f32x4 y = v[j] * rstd * gg + bb; of[64 * j] = y; ob[64 * j] = (u32x2){pk2(y.x, y.y), pk2(y.z, y.w)}; }
    }
}
DI void tr_item(const float* W, int N, bf16* WT, int ldt, int rowmode, int dup, LAS float* scr, int kb, int nb, int lane) {
    const int k0 = 64 * kb, n0 = 32 * nb;
#pragma unroll 8
    for (int i = 0; i < 32; ++i) { const int kk = 2 * i + (lane >> 5); scr[kk * 33 + (lane & 31)] = W[(size_t)(k0 + kk) * N + n0 + (lane & 31)]; }
    LDS_WAIT(); asm volatile("" ::: "memory");
    const int c = lane & 7;
#pragma unroll
    for (int j = 0; j < 4; ++j) { const int n = (lane >> 3) + 8 * j; const LAS float* s = scr + (8 * c) * 33 + n;
        u32x4 o; o.x = pk2(s[0 * 33], s[1 * 33]); o.y = pk2(s[2 * 33], s[3 * 33]); o.z = pk2(s[4 * 33], s[5 * 33]); o.w = pk2(s[6 * 33], s[7 * 33]);
        const int nn = n0 + n; const int row = rowmode == 0 ? nn : ((nn >> 7) * 256 + (rowmode - 1) * 128 + (nn & 127));
        *(u32x4*)(WT + (size_t)row * ldt + k0 + 8 * c) = o; if (dup) *(u32x4*)(WT + (size_t)row * ldt + 1024 + k0 + 8 * c) = o; }
    LDS_WAIT(); asm volatile("" ::: "memory");
}
struct InPtrs { const float* in[26]; };
typedef const __attribute__((address_space(4))) unsigned char* kptr_t;
#define INP(i) (*(const float* const __attribute__((address_space(4)))*)(kp + 8 * (i)))
enum { CJ_IN = 1, CJ_G = 2, CJ_PA = 4, CJ_PR = 8, CJ_O = 16, CJ_UP = 32, CJ_DN = 64, CJ_PLE = 128, CJ_PG = 256, CJ_P = 512, CJ_ALL = 1023 };
DI void convert_layer(kptr_t kp, unsigned char* ws, int l, int mask, LAS unsigned char* lds, int gw, int NGW, int wave, int lane) {
    LAS float* scr = (LAS float*)(lds + wave * 8448);
    bf16* Wb = (bf16*)(ws + WS_W);
    if (mask & CJ_IN) for (int r = gw; r < 16 * 176; r += NGW) tr_item(INP(4) + (size_t)l * D * DIN, DIN, Wb + W_IN, D, 0, 0, scr, r / 176, r % 176, lane);
    if (mask & CJ_G) for (int r = gw; r < 512; r += NGW) { const int x = r >> 8, rr = r & 255, g = rr >> 5, q = rr & 31;
        tr_item(INP(x ? 10 : 8) + ((size_t)l * 8 + g) * 65536, 256, Wb + W_G + (size_t)g * 512 * 256, 256, 1 + x, 0, scr, q / 8, q % 8, lane); }
    if (mask & CJ_PA) for (int r = gw; r < 512; r += NGW) tr_item(INP(13) + (size_t)l * D * D, D, Wb + W_PA, D, 0, 0, scr, r / 32, r % 32, lane);
    if (mask & CJ_PR) for (int r = gw; r < 512; r += NGW) tr_item(INP(14) + (size_t)l * D * D, D, Wb + W_PR, 2 * D, 0, 1, scr, r / 32, r % 32, lane);
    if (mask & CJ_O) for (int r = gw; r < 512; r += NGW) tr_item(INP(15) + (size_t)l * D * D, D, Wb + W_O, D, 0, 0, scr, r / 32, r % 32, lane);
    if (mask & CJ_UP) for (int r = gw; r < 16 * 192; r += NGW) { const int kb = r / 192, nb = r % 192, hf = nb >= 96;
        tr_item(INP(18) + (size_t)l * D * 2 * DFF + hf * DFF, 2 * DFF, Wb + W_UP, D, 1 + hf, 0, scr, kb, nb - hf * 96, lane); }
    if (mask & CJ_DN) for (int r = gw; r < 48 * 32; r += NGW) tr_item(INP(21) + (size_t)l * DFF * D, D, Wb + W_DN, DFF, 0, 0, scr, r / 32, r % 32, lane);
    if (mask & CJ_PLE) for (int r = gw; r < 4 * 32; r += NGW) tr_item(INP(22) + (size_t)l * DPLE * D, D, Wb + W_PLE, DPLE, 0, 0, scr, r / 32, r % 32, lane);
    if (mask & CJ_PG) for (int r = gw; r < 512; r += NGW) tr_item(INP(23) + (size_t)l * D * D, D, Wb + W_PG, D, 0, 0, scr, r / 32, r % 32, lane);
    if (mask & CJ_P) {
        const float* P = INP(1) + (size_t)l * M * DPLE; bf16* PB = (bf16*)(ws + WS_PB);
        for (size_t i = (size_t)gw * 64 + lane; i < (size_t)M * DPLE / 8; i += (size_t)NGW * 64) {
            const f32x4 a = ((const f32x4*)P)[2 * i], b = ((const f32x4*)P)[2 * i + 1];
            ((u32x4*)PB)[i] = (u32x4){pk2(a.x, a.y), pk2(a.z, a.w), pk2(b.x, b.y), pk2(b.z, b.w)};
        }
    }
}
DI void rope_table(float* rope, int gtid, int nthr) {
    for (int i = gtid; i < SEQ * 16; i += nthr) {
        const int pos = i >> 4, j = i & 15;
        const float inv = exp2f(-(float)j * (18.931568569324174f / 16.0f));
        const float ang = (float)pos * inv;
        const double rev = (double)ang * 0.15915494309189535; const float fr = (float)(rev - floor(rev));
        rope[2 * i] = __builtin_amdgcn_cosf(fr); rope[2 * i + 1] = __builtin_amdgcn_sinf(fr);
    }
}
DI void conv_phase(const int wid_s, const bf16* xr, bf16* XFB, const float* cw, const float* cb, int c, int G) {
    const int tid = get_tid(wid_s); const int cg8 = (tid & 127) * 8, sub = tid >> 7;
    for (int it = c; it < M / 32; it += G) {
        const int r0 = it * 32 + sub * 8; const int t0 = r0 & (SEQ - 1);
        u32x4 xin[14];
#pragma unroll
        for (int i = 0; i < 14; ++i) { const int t = t0 - 3 + i; xin[i] = (t >= 0 && t < SEQ) ? *(const u32x4*)(xr + (size_t)(r0 - 3 + i) * 1024 + cg8) : (u32x4){0u, 0u, 0u, 0u}; }
#pragma unroll
        for (int dir = 0; dir < 2; ++dir) {
            float w[4][8], b8[8];
#pragma unroll
            for (int k = 0; k < 4; ++k) { const f32x4 w0 = *(const f32x4*)(cw + (dir * 4 + k) * 1024 + cg8), w1 = *(const f32x4*)(cw + (dir * 4 + k) * 1024 + cg8 + 4);
                w[k][0] = w0.x; w[k][1] = w0.y; w[k][2] = w0.z; w[k][3] = w0.w; w[k][4] = w1.x; w[k][5] = w1.y; w[k][6] = w1.z; w[k][7] = w1.w; }
            { const f32x4 w0 = *(const f32x4*)(cb + dir * 1024 + cg8), w1 = *(const f32x4*)(cb + dir * 1024 + cg8 + 4);
                b8[0] = w0.x; b8[1] = w0.y; b8[2] = w0.z; b8[3] = w0.w; b8[4] = w1.x; b8[5] = w1.y; b8[6] = w1.z; b8[7] = w1.w; }
#pragma unroll
            for (int j = 0; j < 8; ++j) {
                float o[8];
#pragma unroll
                for (int e = 0; e < 8; ++e) o[e] = b8[e];
#pragma unroll
                for (int k = 0; k < 4; ++k) { float xv[8]; unpack8(xin[dir ? (j + 3 + k) : (j + 3 - k)], xv);
#pragma unroll
                    for (int e = 0; e < 8; ++e) o[e] += w[k][e] * xv[e]; }
                *(u32x4*)(XFB + ((size_t)dir * M + r0 + j) * 1024 + cg8) = pack8(o);
            }
        }
    }
}
DI void attn_phase(const int wid_s, LAS unsigned char* lds, const bf16* zq, const bf16* zk, const bf16* zv, bf16* att, const float* sink, int c, int G) {
    const int tid = get_tid(wid_s); const int w = wid_s, lane = tid & 63, l32 = lane & 31, h = lane >> 5;
    LAS unsigned char* Ks = lds;
    LAS unsigned char* Vt = lds + 34816;
    for (int L = c; L < 512; L += G) {
        const int it = (L & 7) * 64 + (L >> 3);
        const int pair = it & 1, kvh = (it >> 1) & 1, n = (it >> 2) & 15, b = it >> 6;
        const int hq = kvh * 4 + pair * 2 + (w >> 2);
        const int qrl = (w & 3) * 32 + l32;
        const size_t qrow = (size_t)b * SEQ + n * 128 + qrl;
        bf16x8 qf[8];
#pragma unroll
        for (int c8 = 0; c8 < 8; ++c8) qf[c8] = *(const bf16x8*)(zq + qrow * 1024 + hq * 128 + c8 * 16 + h * 8);
        float mrun = sink[hq] * LOG2E, lrun = 1.f;
        f32x16 o[4];
#pragma unroll
        for (int dd = 0; dd < 4; ++dd)
#pragma unroll
            for (int i = 0; i < 16; ++i) o[dd][i] = 0.f;
        for (int kc = 0; kc < 3; ++kc) {
            const int kb = n - 1 + kc; if (kb < 0 || kb > 15) continue;
            __syncthreads();
            const size_t krow0 = (size_t)b * SEQ + kb * 128;
#pragma unroll
            for (int i = 0; i < 4; ++i) { const int piece = tid + i * 512; const int r = piece >> 4, cc = piece & 15;
                const u32x4 kv = *(const u32x4*)(zk + (krow0 + r) * 256 + kvh * 128 + cc * 8);
                *(LAS u32x4*)(Ks + r * 272 + cc * 16) = kv; }
#pragma unroll
            for (int i = 0; i < 4; ++i) { const int piece = tid + i * 512; const int r = piece & 127, cc = piece >> 7;
                const u32x4 vv = *(const u32x4*)(zv + (krow0 + r) * 256 + kvh * 128 + cc * 8);
#pragma unroll
                for (int e = 0; e < 8; ++e) { const unsigned wv = vv[e >> 1]; *(LAS unsigned short*)(Vt + (cc * 8 + e) * 264 + r * 2) = (unsigned short)((e & 1) ? (wv >> 16) : (wv & 0xffffu)); } }
            __syncthreads();
            f32x16 s[4];
#pragma unroll
            for (int j = 0; j < 4; ++j) {
#pragma unroll
                for (int i = 0; i < 16; ++i) s[j][i] = 0.f;
#pragma unroll
                for (int c8 = 0; c8 < 8; ++c8) { const bf16x8 kf = *(const LAS bf16x8*)(Ks + (j * 32 + l32) * 272 + c8 * 32 + h * 16);
                    s[j] = __builtin_amdgcn_mfma_f32_32x32x16_bf16(kf, qf[c8], s[j], 0, 0, 0); }
            }
            if (kc != 1) {
                int hb = (kc == 0) ? (4 * h - qrl) : (qrl - 4 * h); asm volatile("" : "+v"(hb));
#pragma unroll
                for (int j = 0; j < 4; ++j)
#pragma unroll
                    for (int i = 0; i < 16; ++i) { const int ko = j * 32 + (i & 3) + 8 * (i >> 2); const int dlt = (kc == 0) ? (hb + ko) : (hb - ko); const unsigned t = (unsigned)(dlt >> 31);
                        s[j][i] = __uint_as_float((__float_as_uint(s[j][i]) & ~t) | (0xF149F2CAu & t)); }
            }
            float mx = -3e38f;
#pragma unroll
            for (int j = 0; j < 4; ++j)
#pragma unroll
                for (int i = 0; i < 16; ++i) mx = fmaxf(mx, s[j][i]);
            mx = fmaxf(mx, shx(mx, 32, lane));
            const float mnew = fmaxf(mrun, mx); const float alpha = __builtin_amdgcn_exp2f(mrun - mnew); mrun = mnew;
            float psum = 0.f;
#pragma unroll
            for (int j = 0; j < 4; ++j)
#pragma unroll
                for (int i = 0; i < 16; ++i) { const float p = __builtin_amdgcn_exp2f(s[j][i] - mnew); s[j][i] = p; psum += p; }
            psum += shx(psum, 32, lane);
            lrun = lrun * alpha + psum;
#pragma unroll
            for (int dd = 0; dd < 4; ++dd)
#pragma unroll
                for (int i = 0; i < 16; ++i) o[dd][i] *= alpha;
#pragma unroll
            for (int j = 0; j < 4; ++j)
#pragma unroll
                for (int s2 = 0; s2 < 2; ++s2) {
                    u32x4 pw; pw.x = pk2(s[j][8 * s2 + 0], s[j][8 * s2 + 1]); pw.y = pk2(s[j][8 * s2 + 2], s[j][8 * s2 + 3]); pw.z = pk2(s[j][8 * s2 + 4], s[j][8 * s2 + 5]); pw.w = pk2(s[j][8 * s2 + 6], s[j][8 * s2 + 7]);
                    const bf16x8 pf = __builtin_bit_cast(bf16x8, pw);
#pragma unroll
                    for (int dd = 0; dd < 4; ++dd) { const LAS unsigned char* vp = Vt + (dd * 32 + l32) * 264 + (j * 32 + 16 * s2 + 4 * h) * 2;
                        const u32x2 lo = *(const LAS u32x2*)vp, hi = *(const LAS u32x2*)(vp + 16);
                        const u32x4 vw = {lo.x, lo.y, hi.x, hi.y};
                        o[dd] = __builtin_amdgcn_mfma_f32_32x32x16_bf16(__builtin_bit_cast(bf16x8, vw), pf, o[dd], 0, 0, 0); }
                }
        }
        const float inv = __builtin_amdgcn_rcpf(lrun);
        bf16* op = att + qrow * 1024 + hq * 128;
#pragma unroll
        for (int dd = 0; dd < 4; ++dd)
#pragma unroll
            for (int i4 = 0; i4 < 4; ++i4) { const int d0 = dd * 32 + 8 * i4 + 4 * h;
                *(u32x2*)(op + d0) = (u32x2){pk2(o[dd][4 * i4] * inv, o[dd][4 * i4 + 1] * inv), pk2(o[dd][4 * i4 + 2] * inv, o[dd][4 * i4 + 3] * inv)}; }
    }
}
DI void scan_phase(const int wid_s, LAS unsigned char* lds, const bf16* LA, const bf16* U, const bf16* gy, bf16* HG, int c, int G) {
    const int tid = get_tid(wid_s); const int w = wid_s, lane = tid & 63, cp = lane & 31, half = lane >> 5, sgi = 2 * w + half;
    LAS float* sP = (LAS float*)lds; LAS float* sH = sP + 16 * 64;
    for (int it = c; it < 256; it += G) {
        const int cgp = it & 15, dir = (it >> 4) & 1, b = it >> 5;
        const int ch = cgp * 64 + cp * 2;
        const size_t rb = (size_t)b * SEQ;
        const bf16* la = LA + ((size_t)dir * M + rb) * 1024 + ch; const bf16* uu = U + ((size_t)dir * M + rb) * 1024 + ch;
        const bf16* gp = gy + rb * 1024 + ch; bf16* hp = HG + rb * 2048 + dir * 1024 + ch;
        const int sbase = sgi * 128;
        float P0 = 1.f, P1 = 1.f, H0 = 0.f, H1 = 0.f;
        for (int j0 = 0; j0 < 128; j0 += 8) {
            unsigned lv[8], uv[8];
#pragma unroll
            for (int j = 0; j < 8; ++j) { const int sidx = sbase + j0 + j; const int t = dir ? (SEQ - 1 - sidx) : sidx; lv[j] = *(const unsigned*)(la + (size_t)t * 1024); uv[j] = *(const unsigned*)(uu + (size_t)t * 1024); }
#pragma unroll
            for (int j = 0; j < 8; ++j) { const float a0 = __builtin_amdgcn_exp2f(bflo(lv[j])), a1 = __builtin_amdgcn_exp2f(bfhi(lv[j]));
                H0 = a0 * H0 + bflo(uv[j]); H1 = a1 * H1 + bfhi(uv[j]); P0 *= a0; P1 *= a1; }
        }
        __syncthreads();
        sP[sgi * 64 + cp * 2] = P0; sP[sgi * 64 + cp * 2 + 1] = P1; sH[sgi * 64 + cp * 2] = H0; sH[sgi * 64 + cp * 2 + 1] = H1;
        __syncthreads();
        float c0 = 0.f, c1 = 0.f;
        for (int s = 0; s < sgi; ++s) { c0 = sP[s * 64 + cp * 2] * c0 + sH[s * 64 + cp * 2]; c1 = sP[s * 64 + cp * 2 + 1] * c1 + sH[s * 64 + cp * 2 + 1]; }
        H0 = c0; H1 = c1;
        for (int j0 = 0; j0 < 128; j0 += 8) {
            unsigned lv[8], uv[8], gv[8];
#pragma unroll
            for (int j = 0; j < 8; ++j) { const int sidx = sbase + j0 + j; const int t = dir ? (SEQ - 1 - sidx) : sidx; lv[j] = *(const unsigned*)(la + (size_t)t * 1024); uv[j] = *(const unsigned*)(uu + (size_t)t * 1024); gv[j] = *(const unsigned*)(gp + (size_t)t * 1024); }
#pragma unroll
            for (int j = 0; j < 8; ++j) { const int sidx = sbase + j0 + j; const int t = dir ? (SEQ - 1 - sidx) : sidx;
                const float a0 = __builtin_amdgcn_exp2f(bflo(lv[j])), a1 = __builtin_amdgcn_exp2f(bfhi(lv[j]));
                H0 = a0 * H0 + bflo(uv[j]); H1 = a1 * H1 + bfhi(uv[j]);
                *(unsigned*)(hp + (size_t)t * 2048) = pk2(H0 * bflo(gv[j]), H1 * bfhi(gv[j])); }
        }
    }
}
#define XB_TMO      128
#define XB_XCNT(j)  (256  + 64 * (j))
#define XB_XSUB(j)  (1280 + 64 * (j))
#define XB_XGEN(j)  (2304 + 64 * (j))
#define XB_TOP      3328
#define XB_TOPGEN   3392
#define XCD_BAR_WORDS 3456
#define XB_SPIN_CAP (1u << 18)

__device__ __forceinline__ unsigned xb_ld(unsigned* p)              { return __hip_atomic_load(p, __ATOMIC_RELAXED, __HIP_MEMORY_SCOPE_AGENT); }
__device__ __forceinline__ unsigned xb_add(unsigned* p, unsigned v) { return __hip_atomic_fetch_add(p, v, __ATOMIC_RELAXED, __HIP_MEMORY_SCOPE_AGENT); }
__device__ __forceinline__ unsigned xb_xcc_id() { return (unsigned)__builtin_amdgcn_s_getreg((3 << 11) | 20) & 0xFu; }
#define XB_SPIN(cond, bar) do { unsigned _sp = 0; while (cond) { __builtin_amdgcn_s_sleep(1); \
    if ((++_sp & 255u) == 0u) { if (xb_ld(&(bar)[XB_TMO])) break; if (_sp > XB_SPIN_CAP) { atomicAdd(&(bar)[XB_TMO], 1u); break; } } } } while (0)

struct XcdBarrier {
    unsigned* bar; unsigned x;
    volatile LAS unsigned* st;
};

__device__ __forceinline__ XcdBarrier xcd_barrier_post(unsigned* bar, volatile LAS unsigned* st, int tid) {
    XcdBarrier b; b.bar = bar; b.x = xb_xcc_id(); b.st = st;
    if (tid == 0) (void)xb_add(&bar[XB_XCNT(b.x)], 1u);
    return b;
}
__device__ __forceinline__ void xcd_barrier_complete(unsigned* bar, unsigned x, unsigned& nloc, unsigned& nx) {
    const unsigned G = gridDim.x * gridDim.y * gridDim.z;
    unsigned sum, cnt, mine, sp = 0u;
    for (;;) {
        sum = 0u; cnt = 0u; mine = 0u;
#pragma unroll
        for (unsigned j = 0; j < 16; ++j) { const unsigned c = xb_ld(&bar[XB_XCNT(j)]); sum += c; cnt += (c > 0u) ? 1u : 0u; mine = (j == x) ? c : mine; }
        if (sum == G) break;
        __builtin_amdgcn_s_sleep(1);
        if ((++sp & 255u) == 0u) { if (xb_ld(&bar[XB_TMO])) break; if (sp > XB_SPIN_CAP) { atomicAdd(&bar[XB_TMO], 1u); break; } }
    }
    nloc = mine > 0u ? mine : 1u; nx = cnt > 0u ? cnt : 1u;
}

__device__ __forceinline__ void xcd_barrier(const XcdBarrier& b, int tid) {
    asm volatile("s_waitcnt vmcnt(0)" ::: "memory");
    __syncthreads();
    if (tid == 0) {
        unsigned* bar = b.bar;
        __builtin_amdgcn_s_waitcnt(0);
        unsigned nloc = b.st[0], nx = b.st[1];
        if (nloc == 0u) { xcd_barrier_complete(bar, b.x, nloc, nx); b.st[0] = nloc; b.st[1] = nx; }
        const unsigned old = xb_add(&bar[XB_XSUB(b.x)], 1u);
        const unsigned gen = old / nloc;
        if (old + 1u == (gen + 1u) * nloc) {
            __builtin_amdgcn_fence(__ATOMIC_RELEASE, "agent");
            asm volatile("s_waitcnt vmcnt(0)" ::: "memory");
            const unsigned og = xb_add(&bar[XB_TOP], 1u);
            const unsigned tg = og / nx;
            if (og + 1u == (tg + 1u) * nx) xb_add(&bar[XB_TOPGEN], 1u);
            else XB_SPIN(xb_ld(&bar[XB_TOPGEN]) == tg, bar);
            __builtin_amdgcn_fence(__ATOMIC_ACQUIRE, "agent");
            xb_add(&bar[XB_XGEN(b.x)], 1u);
            asm volatile("s_waitcnt vmcnt(0)" ::: "memory");
        } else {
            XB_SPIN(xb_ld(&bar[XB_XGEN(b.x)]) == gen, bar);
            __builtin_amdgcn_fence(__ATOMIC_ACQUIRE, "agent");
            asm volatile("s_waitcnt vmcnt(0)" ::: "memory");
        }
    }
    __syncthreads();
}

struct Args { InPtrs I; float* out; unsigned char* ws; int ph_lo, ph_hi; };
#ifndef ONLY
#define ONLY -1
#endif
#define CASE_ON(n) if constexpr (ONLY < 0 || ONLY == (n))
#ifndef PROBE_K
#define PROBE_K -1
#endif
constexpr int PH_PER_LAYER = 9 + (PROBE_K >= 0 ? 1 : 0), N_PHASES = 1 + DEPTH * PH_PER_LAYER;

__global__ void __launch_bounds__(512, 2) fwd_kernel(Args args) {
    extern __shared__ __attribute__((aligned(16))) unsigned char lds_raw[];
    LAS unsigned char* lds = (LAS unsigned char*)lds_raw;
    cg::grid_group grid = cg::this_grid();
    const int wid_s = __builtin_amdgcn_readfirstlane((int)threadIdx.x >> 6);
    XcdBarrier bar;
    {
        const int tid0 = get_tid(wid_s);
        unsigned* barw = (unsigned*)(args.ws + WS_BAR);
        volatile LAS unsigned* st = (volatile LAS unsigned*)(lds + 131072 + 64);
        if (blockIdx.x == 0) { for (int i = tid0; i < XCD_BAR_WORDS; i += 512) __hip_atomic_store(barw + i, 0u, __ATOMIC_RELAXED, __HIP_MEMORY_SCOPE_AGENT);
            unsigned* cw = (unsigned*)(args.ws + WS_CNT); for (int i = tid0; i < CNT_WORDS; i += 512) __hip_atomic_store(cw + i, 0u, __ATOMIC_RELAXED, __HIP_MEMORY_SCOPE_AGENT); }
        if (tid0 < 2) st[tid0] = 0u;
        __syncthreads();
        grid.sync();
        bar = xcd_barrier_post(barw, st, tid0);
    }
    for (int ph = args.ph_lo; ph < args.ph_hi; ++ph) {
        kptr_t kp = (kptr_t)__builtin_amdgcn_kernarg_segment_ptr(); asm volatile("" : "+s"(kp));
        float* trunk = *(float* const __attribute__((address_space(4)))*)(kp + 208);
        unsigned char* ws = *(unsigned char* const __attribute__((address_space(4)))*)(kp + 216);
        const int wave = wid_s;
        int G = gridDim.x, c = blockIdx.x; asm volatile("" : "+s"(G), "+s"(c));
        const int gw = c * 8 + wave, NGW = G * 8;
        float* rope = (float*)(ws + WS_ROPE);
        bf16* Wb = (bf16*)(ws + WS_W); bf16* PB = (bf16*)(ws + WS_PB); bf16* HB = (bf16*)(ws + WS_HB); bf16* Z = (bf16*)(ws + WS_Z);
        bf16* ATT = (bf16*)(ws + WS_ATT); bf16* XFB = (bf16*)(ws + WS_XFB); bf16* UB = (bf16*)(ws + WS_EXTRA); float* T = (float*)(ws + WS_EXTRA);
        bf16* LAb = Z; bf16* HG = XFB; bf16* ACT = Z; float* SIDE = (float*)(ws + WS_ATT);
        if (ph > args.ph_lo) { xcd_barrier(bar, get_tid(wid_s));
#ifdef PROBE_SYNC2
            xcd_barrier(bar, get_tid(wid_s));
#endif
        }
        if (ph == 0) { CASE_ON(100) {
            const int tid = get_tid(wid_s), lane = tid & 63;
            convert_layer(kp, ws, 0, CJ_ALL, lds, gw, NGW, wave, lane);
            ln_rows(INP(0), trunk, HB, INP(2), INP(3), gw, NGW, lane);
            rope_table(rope, c * 512 + tid, G * 512); }
            continue;
        }
        const int l = (ph - 1) / PH_PER_LAYER; int k = (ph - 1) % PH_PER_LAYER; if (PROBE_K >= 0 && k == 9) k = PROBE_K;
        switch (k) {
        case 0: CASE_ON(0) {
            pg8::TileOrder S; S.init(M, DIN, G, c, HB, D, Wb + W_IN, D);
            EpiIn E{Z, rope};
            pg8::gemm_phase(lds, wid_s, D, D, S, E);
        } break;
        case 1: CASE_ON(1) {
            attn_phase(wid_s, lds, Z + Z_Q, Z + Z_K, Z + Z_V, ATT, INP(5) + l * NH, c, G);
            conv_phase(wid_s, Z + Z_XR, XFB, INP(6) + (size_t)l * 2 * 4 * D, INP(7) + (size_t)l * 2 * D, c, G);
            __syncthreads();
            const int lane = get_tid(wid_s) & 63;
            if (l > 0) convert_layer(kp, ws, l, CJ_DN, lds, gw, NGW, wave, lane);
            if (l + 1 < DEPTH) convert_layer(kp, ws, l + 1, CJ_IN, lds, gw, NGW, wave, lane);
        } break;
        case 2: CASE_ON(2) {
            pg8::GateOrder S{G, c, (const char*)XFB, (const char*)(Wb + W_G)};
            EpiGate E{XFB, LAb, UB, INP(9) + (size_t)l * 2 * D, INP(11) + (size_t)l * 2 * D, INP(12) + (size_t)l * 2 * D};
            pg8::gemm_phase(lds, wid_s, 256, 1024, S, E);
        } break;
        case 3: CASE_ON(3) {
            scan_phase(wid_s, lds, LAb, UB, Z + Z_GY, HG, c, G);
            __syncthreads();
            if (l + 1 < DEPTH) convert_layer(kp, ws, l + 1, CJ_G, lds, gw, NGW, wave, get_tid(wid_s) & 63);
        } break;
        case 4: CASE_ON(4) {
            { pg8::TileOrder S; S.init(M, D, G, c, ATT, D, Wb + W_PA, D); EpiX<EP_PA> E{T, nullptr, Z + Z_SA, nullptr}; pg8::gemm_phase(lds, wid_s, D, D, S, E); }
            { pg8::TileOrder S; S.init(M, D, G, c, HG, 2 * D, Wb + W_PR, 2 * D); EpiX<EP_PR> E{T, nullptr, Z + Z_SR, HB}; pg8::gemm_phase(lds, wid_s, 2 * D, 2 * D, S, E); }
        } break;
        case 5: CASE_ON(5) {
            pg8::TileOrder S; S.init(M, D, G, c, HB, D, Wb + W_O, D);
            EpiLn E{trunk, HB, INP(16) + (size_t)l * D, INP(17) + (size_t)l * D, (unsigned long long*)(ws + WS_ATT + 16 * MiB), (unsigned*)(ws + WS_CNT) + (2 * l) * 1024, DN_ALPHA};
            pg8::gemm_phase(lds, wid_s, D, D, S, E);
        } break;
        case 6: CASE_ON(6) {
            pg8::TileOrder S; S.init(M, 2 * DFF, G, c, HB, D, Wb + W_UP, D);
            EpiUpG E{ACT, SIDE, INP(19) + (size_t)l * 3 * DFF, INP(20) + (size_t)l * DFF, (LAS float*)(lds + 131072 + 1024)};
            pg8::gemm_phase(lds, wid_s, D, D, S, E);
        } break;
        case 7: CASE_ON(7) {
            geglu_fix(wid_s, ACT, SIDE, INP(19) + (size_t)l * 3 * DFF, INP(20) + (size_t)l * DFF, c, G);
            { pg8::TileOrder S; S.init(M, D, G, c, PB, DPLE, Wb + W_PLE, DPLE); EpiX<EP_PLE1> E{T, nullptr, nullptr, nullptr}; pg8::gemm_phase(lds, wid_s, DPLE, DPLE, S, E); }
            { pg8::TileOrder S; S.init(M, D, G, c, HB, D, Wb + W_PG, D); EpiX<EP_PLE2> E{T, trunk, nullptr, nullptr}; pg8::gemm_phase(lds, wid_s, D, D, S, E); }
            if (l + 1 < DEPTH) convert_layer(kp, ws, l + 1, CJ_PA | CJ_PR | CJ_O, lds, gw, NGW, wave, get_tid(wid_s) & 63);
        } break;
        case 8: CASE_ON(8) {
            pg8::TileOrder S; S.init(M, D, G, c, ACT, DFF, Wb + W_DN, DFF);
            EpiLn E{trunk, HB, INP(24) + (size_t)l * D, INP(25) + (size_t)l * D, (unsigned long long*)(ws + WS_ATT + 16 * MiB), (unsigned*)(ws + WS_CNT) + (2 * l + 1) * 1024, 1.f};
            pg8::gemm_phase(lds, wid_s, DFF, DFF, S, E);
            __syncthreads();
            if (l + 1 < DEPTH) convert_layer(kp, ws, l + 1, CJ_UP | CJ_PLE | CJ_PG | CJ_P, lds, gw, NGW, wave, get_tid(wid_s) & 63);
        } break;
        }
    }
}

extern "C" void kernel_launch(void* const* d_in, const int* in_sizes, int n_in, void* d_out, int out_size, void* d_ws, size_t ws_size, hipStream_t stream) {
    static int grid = 0;
    if (grid == 0) {
        if (n_in != 26 || out_size != M * D || ws_size < WS_END) { fprintf(stderr, "kernel_launch: unexpected sizes n_in %d out %d ws %zu\n", n_in, out_size, ws_size); grid = -1; return; }
        int dev = 0, cus = 0, per_cu = 0;
        hipGetDevice(&dev); hipDeviceGetAttribute(&cus, hipDeviceAttributeMultiprocessorCount, dev);
        if (hipFuncSetAttribute((const void*)fwd_kernel, hipFuncAttributeMaxDynamicSharedMemorySize, LDS_BYTES) != hipSuccess) { fprintf(stderr, "kernel_launch: hipFuncSetAttribute failed\n"); grid = -1; return; }
        hipOccupancyMaxActiveBlocksPerMultiprocessor(&per_cu, (const void*)fwd_kernel, 512, LDS_BYTES);
        (void)hipGetLastError();
        if (per_cu < 1) per_cu = 1;
        grid = cus * 1;
        if (grid > 256) grid = 256;
        if (grid != 256) { fprintf(stderr, "kernel_launch: needs a 256-CU device (one 256x256 unit per workgroup in the fused-LayerNorm phases)\n"); grid = -1; return; }
        fprintf(stderr, "kernel_launch: cus %d per_cu %d grid %d ws %zu\n", cus, per_cu, grid, ws_size);
    }
    if (grid < 0) return;
    Args a{};
    for (int i = 0; i < 26; ++i) a.I.in[i] = (const float*)d_in[i];
    a.out = (float*)d_out; a.ws = (unsigned char*)d_ws; a.ph_lo = 0; a.ph_hi = N_PHASES;
    void* kargs[] = {&a};
    hipError_t e = hipLaunchCooperativeKernel((const void*)fwd_kernel, dim3(grid), dim3(512), kargs, LDS_BYTES, stream);
    if (e != hipSuccess) fprintf(stderr, "kernel_launch: cooperative launch failed: %s\n", hipGetErrorString(e));
}
```

```cpp
#include <hip/hip_runtime.h>
#include <hip/hip_cooperative_groups.h>
#include <cstdio>
#include <cstdint>
namespace cg = cooperative_groups;

#define LAS __attribute__((address_space(3)))
#define DI __device__ __forceinline__
typedef unsigned short bf16;
typedef short bf16x8 __attribute__((ext_vector_type(8)));
typedef float f32x4 __attribute__((ext_vector_type(4)));
typedef float f32x16 __attribute__((ext_vector_type(16)));
typedef unsigned u32x4 __attribute__((ext_vector_type(4)));
typedef unsigned u32x2 __attribute__((ext_vector_type(2)));
typedef __bf16 bf16x2_t __attribute__((ext_vector_type(2)));
typedef float f32x2_t __attribute__((ext_vector_type(2)));

constexpr int BATCH = 8, SEQ = 2048, D = 1024, DEPTH = 4, M = BATCH * SEQ;
constexpr int NH = 8, NKV = 2, HD = 128, DIN = 5632, DFF = 3072, DPLE = 256;
constexpr float LN_EPS = 1e-5f;
constexpr float DN_ALPHA = 1.6817928305074290f;
constexpr float LOG2E = 1.4426950408889634f;
constexpr float QSCALE = 0.08838834764831845f * LOG2E;

constexpr size_t MiB = 1u << 20;
constexpr size_t WS_ROPE = 0;
constexpr size_t WS_BAR = 512 * 1024;
constexpr size_t WS_CNT = 512 * 1024 + 65536;
constexpr int CNT_WORDS = 8 * 64 * 16;
constexpr size_t WS_W = 1 * MiB;
constexpr size_t W_IN = 0, W_G = W_IN + (size_t)DIN * D, W_PA = W_G + 8 * 512 * 256, W_PR = W_PA + (size_t)D * D, W_O = W_PR + (size_t)D * 2 * D,
                 W_UP = W_O + (size_t)D * D, W_DN = W_UP + (size_t)2 * DFF * D, W_PLE = W_DN + (size_t)D * DFF, W_PG = W_PLE + (size_t)D * DPLE, W_END = W_PG + (size_t)D * D;
static_assert(W_END * 2 <= 42 * MiB, "weights");
constexpr size_t WS_PB = WS_W + 42 * MiB;
constexpr size_t WS_HB = WS_PB + 8 * MiB;
constexpr size_t WS_Z = WS_HB + 32 * MiB;
constexpr size_t WS_ATT = WS_Z + 176 * MiB;
constexpr size_t WS_XFB = WS_ATT + 32 * MiB;
constexpr size_t WS_EXTRA = WS_XFB + 64 * MiB;
constexpr size_t WS_END = WS_EXTRA + 64 * MiB;
static_assert(WS_END <= 440 * MiB, "ws");
constexpr size_t Z_Q = 0, Z_K = (size_t)M * 1024, Z_V = (size_t)M * 1280, Z_XR = (size_t)M * 1536, Z_GY = (size_t)M * 2560, Z_SA = (size_t)M * 3584, Z_SR = (size_t)M * 4608;

constexpr int LDS_BYTES = 139264;

DI unsigned pk2(float lo, float hi) { f32x2_t v = {lo, hi}; bf16x2_t b = __builtin_convertvector(v, bf16x2_t); return __builtin_bit_cast(unsigned, b); }
DI float bflo(unsigned u) { return __uint_as_float(u << 16); }
DI float bfhi(unsigned u) { return __uint_as_float(u & 0xffff0000u); }
DI float sigm(float x) { return __builtin_amdgcn_rcpf(1.f + __builtin_amdgcn_exp2f(-LOG2E * x)); }
DI float gelu_t(float x) { const float u = 0.7978845608028654f * (x + 0.044715f * x * x * x); return x * sigm(2.f * u); }
DI void unpack8(const u32x4 w, float (&v)[8]) { v[0] = bflo(w.x); v[1] = bfhi(w.x); v[2] = bflo(w.y); v[3] = bfhi(w.y); v[4] = bflo(w.z); v[5] = bfhi(w.z); v[6] = bflo(w.w); v[7] = bfhi(w.w); }
DI u32x4 pack8(const float (&v)[8]) { u32x4 w; w.x = pk2(v[0], v[1]); w.y = pk2(v[2], v[3]); w.z = pk2(v[4], v[5]); w.w = pk2(v[6], v[7]); return w; }
DI float shx(float v, int mask, int lane) { return __int_as_float(__builtin_amdgcn_ds_bpermute((lane ^ mask) << 2, __float_as_int(v))); }
DI float wave_sum(float v, int lane) {
#pragma unroll
    for (int o = 1; o < 64; o <<= 1) v += shx(v, o, lane);
    return v;
}
DI int get_tid(int wid_s) { int l; asm volatile("v_mbcnt_lo_u32_b32 %0, -1, 0\n\tv_mbcnt_hi_u32_b32 %0, -1, %0" : "=v"(l)); return wid_s * 64 + l; }
#define LDS_WAIT() asm volatile("s_waitcnt lgkmcnt(0)" ::: "memory")

namespace pg8 {
constexpr int BM = 256, BK = 64, HALF = 128, HTB = HALF * BK * 2, NXCD = 8, WGM = 8;
DI int lds_byte(int r, int c) { const int st = (r >> 4) * 2 + (c >> 5), rr = r & 15, cc = c & 31, ob = rr * 64 + cc * 2; return st * 1024 + (ob ^ (((ob >> 9) & 1) << 5)); }
DI void stage_rc(int b, int& R, int& C) { const int st = b / 1024, sb = b % 1024, swz = sb ^ (((sb >> 9) & 1) << 5); R = (st >> 1) * 16 + swz / 64; C = (st & 1) * 32 + (swz % 64) / 2; }
DI int perm32(int rho) { const int n = rho >> 4, i = rho & 15; return 8 * (i >> 2) + 4 * n + (i & 3); }
struct Unit { int pm, pn, g; };

struct TileOrder {
    int nM, nN, nwg, G, c; const char* Ab; const char* Bb; size_t atile, btile;
    DI void init(int Mr, int N, int G_, int c_, const void* A, int lda, const void* Bt, int K) { nM = Mr / BM; nN = N / BM; nwg = nM * nN; G = G_; c = c_; Ab = (const char*)A; Bb = (const char*)Bt; atile = (size_t)BM * lda * 2; btile = (size_t)BM * K * 2; }
    DI bool next(int i, Unit& u) const {
        const int L = i * G + c; if (L >= nwg) return false;
        int wgid = L; { const int q = nwg / NXCD, r = nwg % NXCD, xcd = wgid % NXCD, off = wgid / NXCD; wgid = (xcd < r ? xcd * (q + 1) : r * (q + 1) + (xcd - r) * q) + off; }
        const int nig = WGM * nN, gid = wgid / nig, fm = gid * WGM, gsz = (nM - fm) < WGM ? (nM - fm) : WGM;
        u.pm = fm + ((wgid % nig) % gsz); u.pn = (wgid % nig) / gsz; u.g = 0; return true;
    }
    DI const char* A(const Unit& u) const { return Ab + (size_t)u.pm * atile; }
    DI const char* B(const Unit& u) const { return Bb + (size_t)u.pn * btile; }
};
struct GateOrder {
    int G, c; const char* Ab; const char* Bb;
    DI bool next(int i, Unit& u) const {
        const int L = i * G + c; if (L >= 1024) return false;
        const int id = (L & 7) * 128 + (L >> 3); u.g = id >> 7; u.pm = (id & 127) >> 1; u.pn = id & 1; return true;
    }
    DI const char* A(const Unit& u) const { const int dir = u.g >> 2, blk = u.g & 3; return Ab + (((size_t)dir * M + (size_t)u.pm * 256) * 1024 + blk * 256) * 2; }
    DI const char* B(const Unit& u) const { return Bb + ((size_t)u.g * 512 + u.pn * 256) * 256 * 2; }
};

template <class Epi, class Sched>
DI void gemm_phase(LAS unsigned char* lds, const int wid_s, const int K, const int lda, const Sched& S, const Epi& E) {
    int tid_ = get_tid(wid_s);
    const int tid = tid_, wid = __builtin_amdgcn_readfirstlane(tid >> 6), lane = tid & 63, wr = wid >> 2, wc = wid & 3, fr = lane & 15, fq = lane >> 4;
    const int nt = K / BK;
    unsigned voffA[2], voffB[2];
#pragma unroll
    for (int i = 0; i < 2; ++i) { int R, C; stage_rc(tid * 16 + i * 8192, R, C); const int Rb = (R & ~31) + perm32(R & 31);
        voffA[i] = (unsigned)(R * lda + C) * 2u; voffB[i] = (unsigned)(Rb * K + C) * 2u; }
    const size_t kstep = (size_t)(BK * 2);
    const size_t hstepA = (size_t)HALF * lda * 2, hstepB = (size_t)HALF * K * 2;
    const unsigned ldsw = (unsigned)wid * 1024u;
    const int aoff = lds_byte(wr * 64 + fr, fq * 8), boff = lds_byte(wc * 32 + fr, fq * 8);
#define PG8_SA(b, h) (((b) * 2 + (h)) * HTB)
#define PG8_SB(b, h) ((4 + (b) * 2 + (h)) * HTB)
#define PG8_STAGE(bufoff, gbase, voff) do { _Pragma("unroll") for (int _i = 0; _i < 2; ++_i) \
        __builtin_amdgcn_global_load_lds((const unsigned*)((const char*)(gbase) + (voff)[_i]), (LAS unsigned*)(lds + (bufoff) + ldsw + _i * 8192), 16, 0, 0); } while (0)
#define PG8_LDA(dst, b, h) do { _Pragma("unroll") for (int m = 0; m < 4; ++m) _Pragma("unroll") for (int k = 0; k < 2; ++k) dst[m][k] = *(const LAS bf16x8*)(lds + PG8_SA(b, h) + aoff + m * 2048 + k * 1024); } while (0)
#define PG8_LDB(dst, b, h) do { _Pragma("unroll") for (int n = 0; n < 2; ++n) _Pragma("unroll") for (int k = 0; k < 2; ++k) dst[n][k] = *(const LAS bf16x8*)(lds + PG8_SB(b, h) + boff + n * 2048 + k * 1024); } while (0)
#define PG8_MMA(ai, bj, At, Bt) do { __builtin_amdgcn_s_setprio(1); _Pragma("unroll") for (int m = 0; m < 4; ++m) _Pragma("unroll") for (int n = 0; n < 2; ++n) _Pragma("unroll") for (int k = 0; k < 2; ++k) \
        acc[ai][bj][m][n] = __builtin_amdgcn_mfma_f32_16x16x32_bf16(Bt[n][k], At[m][k], acc[ai][bj][m][n], 0, 0, 0); __builtin_amdgcn_s_setprio(0); } while (0)
#define PG8_WAIT_V(n) asm volatile("s_waitcnt vmcnt(" #n ")" ::: "memory")
#define PG8_WAIT_L(n) asm volatile("s_waitcnt lgkmcnt(" #n ")" ::: "memory")
#define PG8_BAR __builtin_amdgcn_s_barrier()
#define PG8_SCHED __builtin_amdgcn_sched_barrier(0)
    PG8_SCHED;
    Unit cur, nxt; int ui = 0;
    if (!S.next(0, cur)) return;
    f32x4 acc[2][2][4][2];
#pragma unroll
    for (int a = 0; a < 2; ++a)
#pragma unroll
        for (int b = 0; b < 2; ++b)
#pragma unroll
            for (int m = 0; m < 4; ++m)
#pragma unroll
                for (int n = 0; n < 2; ++n) acc[a][b][m][n] = (f32x4){0.f, 0.f, 0.f, 0.f};
    bf16x8 At[4][2], B0[2][2], B1[2][2];
    const char* cA = S.A(cur); const char* cB = S.B(cur);
    PG8_STAGE(PG8_SB(0, 0), cB, voffB); PG8_STAGE(PG8_SB(0, 1), cB + hstepB, voffB); PG8_STAGE(PG8_SA(0, 0), cA, voffA); PG8_STAGE(PG8_SA(0, 1), cA + hstepA, voffA);
    if (wr == 1) PG8_BAR;
    PG8_WAIT_V(2); PG8_BAR;
    PG8_STAGE(PG8_SB(1, 0), cB + kstep, voffB); PG8_STAGE(PG8_SA(1, 0), cA + kstep, voffA); PG8_STAGE(PG8_SB(1, 1), cB + hstepB + kstep, voffB);
    PG8_WAIT_V(6); PG8_BAR;
    for (;;) {
        const bool has_next = S.next(ui + 1, nxt);
        const char* nA = has_next ? S.A(nxt) : cA; const char* nB = has_next ? S.B(nxt) : cB;
        for (int t = 0; t < nt; t += 2) {
            const bool last = (t == nt - 2);
            const char* a1 = cA + (size_t)(t + 1) * kstep;
            const char* a2 = last ? nA : cA + (size_t)(t + 2) * kstep; const char* b2 = last ? nB : cB + (size_t)(t + 2) * kstep;
            const char* a3 = a2 + kstep; const char* b3 = b2 + kstep;
            PG8_LDB(B0, 0, 0); PG8_LDB(B1, 0, 1); PG8_SCHED; PG8_LDA(At, 0, 0); PG8_STAGE(PG8_SA(1, 1), a1 + hstepA, voffA);
            PG8_WAIT_V(8); PG8_WAIT_L(0); PG8_BAR; PG8_MMA(0, 0, At, B0); PG8_MMA(0, 1, At, B1); PG8_BAR; PG8_SCHED;
            PG8_LDA(At, 0, 1); PG8_STAGE(PG8_SB(0, 0), b2, voffB); PG8_STAGE(PG8_SB(0, 1), b2 + hstepB, voffB); PG8_STAGE(PG8_SA(0, 0), a2, voffA);
            PG8_WAIT_V(8); PG8_WAIT_L(0); PG8_BAR; PG8_MMA(1, 0, At, B0); PG8_MMA(1, 1, At, B1); PG8_BAR; PG8_SCHED;
            PG8_LDB(B0, 1, 0); PG8_LDB(B1, 1, 1); PG8_SCHED; PG8_LDA(At, 1, 0); PG8_STAGE(PG8_SA(0, 1), a2 + hstepA, voffA);
            PG8_WAIT_V(8); PG8_WAIT_L(0); PG8_BAR; PG8_MMA(0, 0, At, B0); PG8_MMA(0, 1, At, B1); PG8_BAR; PG8_SCHED;
            PG8_LDA(At, 1, 1); PG8_STAGE(PG8_SB(1, 0), b3, voffB); PG8_STAGE(PG8_SB(1, 1), b3 + hstepB, voffB); PG8_STAGE(PG8_SA(1, 0), a3, voffA);
            PG8_WAIT_V(8); PG8_WAIT_L(0); PG8_BAR; PG8_MMA(1, 0, At, B0); PG8_MMA(1, 1, At, B1); PG8_BAR; PG8_SCHED;
        }
        if (wr == 0) PG8_BAR;
        if constexpr (!Epi::AFTER_DRAIN) E(acc, cur, wr, wc, fr, fq);
        if (!has_next) break;
#pragma unroll
        for (int a = 0; a < 2; ++a)
#pragma unroll
            for (int b = 0; b < 2; ++b)
#pragma unroll
                for (int m = 0; m < 4; ++m)
#pragma unroll
                    for (int n = 0; n < 2; ++n) acc[a][b][m][n] = (f32x4){0.f, 0.f, 0.f, 0.f};
        cur = nxt; cA = nA; cB = nB; ++ui;
        if (wr == 1) PG8_BAR;
    }
    PG8_WAIT_V(0);
    PG8_BAR;
    PG8_SCHED;
    if constexpr (Epi::AFTER_DRAIN) E.fused(acc, cur, wr, wc, fr, fq, lds, tid);
#undef PG8_SA
#undef PG8_SB
#undef PG8_STAGE
#undef PG8_LDA
#undef PG8_LDB
#undef PG8_MMA
#undef PG8_WAIT_V
#undef PG8_WAIT_L
#undef PG8_BAR
#undef PG8_SCHED
}
}
using pg8::Unit;
typedef f32x4 AccT[2][2][4][2];
#define EPI_ARGS const f32x4 (&acc)[2][2][4][2], const Unit& u, int wr, int wc, int fr, int fq
#define EPI_FOR_ROWS _Pragma("unroll") for (int ai = 0; ai < 2; ++ai) _Pragma("unroll") for (int m = 0; m < 4; ++m)
#define EPI_ROW (u.pm * 256 + ai * 128 + wr * 64 + m * 16 + fr)
#define EPI_V8(bj) { acc[ai][bj][m][0][0], acc[ai][bj][m][0][1], acc[ai][bj][m][0][2], acc[ai][bj][m][0][3], acc[ai][bj][m][1][0], acc[ai][bj][m][1][1], acc[ai][bj][m][1][2], acc[ai][bj][m][1][3] }

struct EpiIn {
    static constexpr bool AFTER_DRAIN = false;
    bf16* Z; const float* rope;
    DI void operator()(EPI_ARGS) const {
        const int pn = u.pn; size_t base; int ldc, colt, mode;
        if (pn < 4) { base = Z_Q; ldc = 1024; colt = pn * 256; mode = 0; }
        else if (pn == 4) { base = Z_K; ldc = 256; colt = 0; mode = 0; }
        else if (pn == 5) { base = Z_V; ldc = 256; colt = 0; mode = 1; }
        else { const int arr = (pn - 6) >> 2; base = (size_t)M * (1536 + 1024 * arr); ldc = 1024; colt = ((pn - 6) & 3) * 256; mode = arr <= 1 ? 1 : 3; }
        const float qs = pn < 4 ? QSCALE : 1.f;
        const bool rope_w = (mode == 0) && (wc == 0);
        EPI_FOR_ROWS {
            const int row = EPI_ROW;
            bf16* rowp = Z + base + (size_t)row * ldc + colt + wc * 32 + 8 * fq;
            f32x4 cs[4];
            if (rope_w) { const f32x4* rp = (const f32x4*)(rope + ((row & (SEQ - 1)) * 16 + 8 * (fq & 1)) * 2);
#pragma unroll
                for (int i = 0; i < 4; ++i) cs[i] = rp[i]; }
#pragma unroll
            for (int bj = 0; bj < 2; ++bj) {
                float v[8] = EPI_V8(bj);
                if (mode == 0) {
                    if (rope_w) {
#pragma unroll
                        for (int e = 0; e < 8; ++e) { const float pr = shx(v[e], 32, fq * 16 + fr); const float cc = cs[e >> 1][(e & 1) * 2], ss = cs[e >> 1][(e & 1) * 2 + 1];
                            v[e] = v[e] * cc + (fq < 2 ? -pr * ss : pr * ss); }
                    }
#pragma unroll
                    for (int e = 0; e < 8; ++e) v[e] *= qs;
                } else if (mode == 2) {
#pragma unroll
                    for (int e = 0; e < 8; ++e) v[e] = gelu_t(v[e]);
                } else if (mode == 3) {
#pragma unroll
                    for (int e = 0; e < 8; ++e) v[e] = sigm(v[e]);
                }
                *(u32x4*)(rowp + bj * 128) = pack8(v);
            }
        }
    }
};
struct EpiGate {
    static constexpr bool AFTER_DRAIN = false;
    const bf16* XFB; bf16* LA; bf16* U; const float* b_a; const float* b_x; const float* lam;
    DI void operator()(EPI_ARGS) const {
        const int dir = u.g >> 2, blk = u.g & 3;
        const int ch0 = blk * 256 + u.pn * 128 + wc * 32 + 8 * fq;
        float ba[8], bx[8], cl[8];
#pragma unroll
        for (int e = 0; e < 8; ++e) { ba[e] = -LOG2E * b_a[dir * 1024 + ch0 + e]; bx[e] = -LOG2E * b_x[dir * 1024 + ch0 + e];
            const float l = lam[dir * 1024 + ch0 + e]; cl[e] = -8.f * __builtin_amdgcn_logf(1.f + __builtin_amdgcn_exp2f(-LOG2E * l)); }
        u32x4 xw[2][4];
        EPI_FOR_ROWS xw[ai][m] = *(const u32x4*)(XFB + ((size_t)dir * M + EPI_ROW) * 1024 + ch0);
        EPI_FOR_ROWS {
            const int row = EPI_ROW;
            const size_t off = ((size_t)dir * M + row) * 1024 + ch0;
            float x[8]; unpack8(xw[ai][m], x);
            const float va[8] = EPI_V8(0); const float vx[8] = EPI_V8(1);
            float la[8], uu[8];
#pragma unroll
            for (int e = 0; e < 8; ++e) {
                const float ea = 1.f + __builtin_amdgcn_exp2f(fminf(-LOG2E * va[e] + ba[e], 60.f)), ex = 1.f + __builtin_amdgcn_exp2f(fminf(-LOG2E * vx[e] + bx[e], 60.f));
                const float r = __builtin_amdgcn_rcpf(ea * ex);
                la[e] = (r * ex) * cl[e]; uu[e] = x[e] * (r * ea); }
            *(u32x4*)(LA + off) = pack8(la); *(u32x4*)(U + off) = pack8(uu);
            __builtin_amdgcn_sched_barrier(0);
        }
    }
};
enum { EP_PA = 0, EP_PR, EP_PLE1, EP_PLE2 };
template <int MODE> struct EpiX {
    static constexpr bool AFTER_DRAIN = false;
    float* F;
    float* TR;
    const bf16* S;
    bf16* O;
    struct RowIn { f32x4 t[2][2]; f32x4 r[2][2]; u32x4 s[2]; };
    DI void load(RowIn& in, size_t off0) const {
#pragma unroll
        for (int bj = 0; bj < 2; ++bj) { const size_t off = off0 + bj * 128;
            if constexpr (MODE == EP_PA || MODE == EP_PR) in.s[bj] = *(const u32x4*)(S + off);
            if constexpr (MODE == EP_PR || MODE == EP_PLE2) { in.t[bj][0] = *(const f32x4*)(F + off); in.t[bj][1] = *(const f32x4*)(F + off + 4); }
            if constexpr (MODE == EP_PLE2) { in.r[bj][0] = *(const f32x4*)(TR + off); in.r[bj][1] = *(const f32x4*)(TR + off + 4); } }
    }
    DI void operator()(EPI_ARGS) const {
        const size_t base = (size_t)(u.pm * 256 + wr * 64 + fr) * 1024 + u.pn * 256 + wc * 32 + 8 * fq;
        RowIn buf[2];
        if constexpr (MODE != EP_PLE1) load(buf[0], base);
#pragma unroll
        for (int it = 0; it < 8; ++it) {
            const int ai = it >> 2, m = it & 3;
            const size_t off0 = base + (size_t)(ai * 128 + m * 16) * 1024;
            if constexpr (MODE != EP_PLE1) { if (it + 1 < 8) load(buf[(it + 1) & 1], base + (size_t)(((it + 1) >> 2) * 128 + ((it + 1) & 3) * 16) * 1024); }
            const RowIn& in = buf[it & 1];
#pragma unroll
            for (int bj = 0; bj < 2; ++bj) {
                const size_t off = off0 + bj * 128;
                float v[8] = EPI_V8(bj);
                if constexpr (MODE == EP_PA) { float sg[8]; unpack8(in.s[bj], sg);
                    *(f32x4*)(F + off) = (f32x4){v[0] * sg[0], v[1] * sg[1], v[2] * sg[2], v[3] * sg[3]}; *(f32x4*)(F + off + 4) = (f32x4){v[4] * sg[4], v[5] * sg[5], v[6] * sg[6], v[7] * sg[7]}; }
                if constexpr (MODE == EP_PR) { float sg[8]; unpack8(in.s[bj], sg); const f32x4 t0 = in.t[bj][0], t1 = in.t[bj][1];
                    float r[8] = {t0[0] + v[0] * sg[0], t0[1] + v[1] * sg[1], t0[2] + v[2] * sg[2], t0[3] + v[3] * sg[3], t1[0] + v[4] * sg[4], t1[1] + v[5] * sg[5], t1[2] + v[6] * sg[6], t1[3] + v[7] * sg[7]};
                    *(u32x4*)(O + off) = pack8(r); }
                if constexpr (MODE == EP_PLE1) { *(f32x4*)(F + off) = (f32x4){v[0], v[1], v[2], v[3]}; *(f32x4*)(F + off + 4) = (f32x4){v[4], v[5], v[6], v[7]}; }
                if constexpr (MODE == EP_PLE2) { const f32x4 p0 = in.t[bj][0], p1 = in.t[bj][1], t0 = in.r[bj][0], t1 = in.r[bj][1];
                    *(f32x4*)(TR + off) = (f32x4){DN_ALPHA * t0[0] + sigm(v[0]) * p0[0], DN_ALPHA * t0[1] + sigm(v[1]) * p0[1], DN_ALPHA * t0[2] + sigm(v[2]) * p0[2], DN_ALPHA * t0[3] + sigm(v[3]) * p0[3]};
                    *(f32x4*)(TR + off + 4) = (f32x4){DN_ALPHA * t1[0] + sigm(v[4]) * p1[0], DN_ALPHA * t1[1] + sigm(v[5]) * p1[1], DN_ALPHA * t1[2] + sigm(v[6]) * p1[2], DN_ALPHA * t1[3] + sigm(v[7]) * p1[3]}; }
            }
            if constexpr (MODE != EP_PLE1) __builtin_amdgcn_sched_barrier(0);
        }
    }
};
struct EpiLn {
    static constexpr bool AFTER_DRAIN = true;
    float* trunk; bf16* HB; const float* g; const float* bt; unsigned long long* X; unsigned* cnt; float scale;
    DI void operator()(EPI_ARGS) const {}
    DI void fused(f32x4 (&acc)[2][2][4][2], const Unit& u, int wr, int wc, int fr, int fq, LAS unsigned char* lds, int tid) const {
        LAS f32x2_t* P = (LAS f32x2_t*)lds;
        LAS f32x2_t* Sst = (LAS f32x2_t*)(lds + 8192);
        const int lane = fq * 16 + fr;
        const int col0 = u.pn * 256 + wc * 32 + 8 * fq;
        const float* tbase = trunk + (size_t)(u.pm * 256 + wr * 64 + fr) * 1024 + col0;
        f32x4 tb[2][2][2];
#pragma unroll
        for (int bj = 0; bj < 2; ++bj)
#pragma unroll
            for (int n = 0; n < 2; ++n) tb[0][bj][n] = *(const f32x4*)(tbase + bj * 128 + 4 * n);
#pragma unroll
        for (int it = 0; it < 8; ++it) {
            const int ai = it >> 2, m = it & 3; float s1 = 0.f, s2 = 0.f;
            if (it + 1 < 8) { const float* tp = tbase + (size_t)(((it + 1) >> 2) * 128 + ((it + 1) & 3) * 16) * 1024;
#pragma unroll
                for (int bj = 0; bj < 2; ++bj)
#pragma unroll
                    for (int n = 0; n < 2; ++n) tb[(it + 1) & 1][bj][n] = *(const f32x4*)(tp + bj * 128 + 4 * n); }
#pragma unroll
            for (int bj = 0; bj < 2; ++bj)
#pragma unroll
                for (int n = 0; n < 2; ++n) { const f32x4 y = acc[ai][bj][m][n] + scale * tb[it & 1][bj][n]; acc[ai][bj][m][n] = y;
                    s1 += (y[0] + y[1]) + (y[2] + y[3]); s2 += (y[0] * y[0] + y[1] * y[1]) + (y[2] * y[2] + y[3] * y[3]); }
            s1 += shx(s1, 16, lane); s2 += shx(s2, 16, lane); s1 += shx(s1, 32, lane); s2 += shx(s2, 32, lane);
            if (fq == 0) P[(ai * 128 + wr * 64 + m * 16 + fr) * 4 + wc] = (f32x2_t){s1, s2};
            __builtin_amdgcn_sched_barrier(0);
        }
        LDS_WAIT(); __builtin_amdgcn_s_barrier(); asm volatile("" ::: "memory");
        unsigned long long* slot = X + ((size_t)u.pm * 256 + (tid & 255)) * 4;
        if (tid < 256) { const f32x2_t a = P[tid * 4 + 0], b = P[tid * 4 + 1], c2 = P[tid * 4 + 2], d = P[tid * 4 + 3];
            const float t1 = (a.x + b.x) + (c2.x + d.x), t2 = (a.y + b.y) + (c2.y + d.y);
            __hip_atomic_store(slot + u.pn, ((unsigned long long)__float_as_uint(t2) << 32) | __float_as_uint(t1), __ATOMIC_RELAXED, __HIP_MEMORY_SCOPE_AGENT); }
        asm volatile("s_waitcnt vmcnt(0)" ::: "memory"); __builtin_amdgcn_s_barrier(); asm volatile("" ::: "memory");
        if (tid == 0) {
            __hip_atomic_fetch_add(cnt + u.pm * 16, 1u, __ATOMIC_RELAXED, __HIP_MEMORY_SCOPE_AGENT);
            unsigned sp = 0; while (__hip_atomic_load(cnt + u.pm * 16, __ATOMIC_RELAXED, __HIP_MEMORY_SCOPE_AGENT) < 4u) { __builtin_amdgcn_s_sleep(1); if (++sp > (1u << 22)) break; }
            __builtin_amdgcn_fence(__ATOMIC_ACQUIRE, "agent"); asm volatile("s_waitcnt vmcnt(0)" ::: "memory");
        }
        __builtin_amdgcn_s_barrier(); asm volatile("" ::: "memory");
        if (tid < 256) { float t1 = 0.f, t2 = 0.f;
#pragma unroll
            for (int j = 0; j < 4; ++j) { const unsigned long long v = __hip_atomic_load(slot + j, __ATOMIC_RELAXED, __HIP_MEMORY_SCOPE_AGENT); t1 += __uint_as_float((unsigned)v); t2 += __uint_as_float((unsigned)(v >> 32)); }
            const float mean = t1 * (1.f / D), var = fmaxf(t2 * (1.f / D) - mean * mean, 0.f);
            Sst[tid] = (f32x2_t){mean, __builtin_amdgcn_rsqf(var + LN_EPS)}; }
        LDS_WAIT(); __builtin_amdgcn_s_barrier(); asm volatile("" ::: "memory");
        f32x4 gg[2][2], bb[2][2];
#pragma unroll
        for (int bj = 0; bj < 2; ++bj)
#pragma unroll
            for (int n = 0; n < 2; ++n) { gg[bj][n] = *(const f32x4*)(g + col0 + bj * 128 + 4 * n); bb[bj][n] = *(const f32x4*)(bt + col0 + bj * 128 + 4 * n); }
        EPI_FOR_ROWS {
            const int row = EPI_ROW; const f32x2_t st = Sst[ai * 128 + wr * 64 + m * 16 + fr];
#pragma unroll
            for (int bj = 0; bj < 2; ++bj) { const size_t off = (size_t)row * 1024 + col0 + bj * 128;
                const f32x4 o0 = (acc[ai][bj][m][0] - st.x) * st.y * gg[bj][0] + bb[bj][0], o1 = (acc[ai][bj][m][1] - st.x) * st.y * gg[bj][1] + bb[bj][1];
                *(f32x4*)(trunk + off) = o0; *(f32x4*)(trunk + off + 4) = o1;
                *(u32x4*)(HB + off) = (u32x4){pk2(o0[0], o0[1]), pk2(o0[2], o0[3]), pk2(o1[0], o1[1]), pk2(o1[2], o1[3])}; }
            if (m & 1) __builtin_amdgcn_sched_barrier(0);
        }
    }
};
DI float dpp_ror1(float v) { return __int_as_float(__builtin_amdgcn_update_dpp(0, __float_as_int(v), 0x121, 0xf, 0xf, false)); }
DI float dpp_ror15(float v) { return __int_as_float(__builtin_amdgcn_update_dpp(0, __float_as_int(v), 0x12F, 0xf, 0xf, false)); }
constexpr size_t SIDE_STRIDE = 3 * DFF;
struct EpiUpG {
    static constexpr bool AFTER_DRAIN = false;
    bf16* ACT; float* SIDE; const float* fw; const float* fb; LAS float* xch;
    DI void operator()(EPI_ARGS) const {
        const int ch0 = u.pn * 128 + wc * 32 + 8 * fq;
        float w0[8], w1[8], w2[8], bb[8];
        { const f32x4 a0 = *(const f32x4*)(fw + ch0), a1 = *(const f32x4*)(fw + ch0 + 4), b0 = *(const f32x4*)(fw + DFF + ch0), b1 = *(const f32x4*)(fw + DFF + ch0 + 4),
                      c0 = *(const f32x4*)(fw + 2 * DFF + ch0), c1 = *(const f32x4*)(fw + 2 * DFF + ch0 + 4), d0 = *(const f32x4*)(fb + ch0), d1 = *(const f32x4*)(fb + ch0 + 4);
#pragma unroll
          for (int e = 0; e < 4; ++e) { w0[e] = a0[e]; w0[e + 4] = a1[e]; w1[e] = b0[e]; w1[e + 4] = b1[e]; w2[e] = c0[e]; w2[e + 4] = c1[e]; bb[e] = d0[e]; bb[e + 4] = d1[e]; } }
#pragma unroll
        for (int ai = 0; ai < 2; ++ai) { const int gi = 2 * ai + wr;
            if (fr == 0) { LAS float* p = xch + ((gi * 4 + wc) * 2 + 0) * 32 + 8 * fq; *(LAS f32x4*)p = acc[ai][0][0][0]; *(LAS f32x4*)(p + 4) = acc[ai][0][0][1]; }
            if (fr == 15) { LAS float* p = xch + ((gi * 4 + wc) * 2 + 1) * 32 + 8 * fq; *(LAS f32x4*)p = acc[ai][0][3][0]; *(LAS f32x4*)(p + 4) = acc[ai][0][3][1]; } }
        LDS_WAIT(); __builtin_amdgcn_s_barrier(); asm volatile("" ::: "memory");
        const bool seq_first = (u.pm & 7) == 0, seq_last = (u.pm & 7) == 7;
#pragma unroll
        for (int ai = 0; ai < 2; ++ai) { const int gi = 2 * ai + wr;
            float pf[8], nf[8];
#pragma unroll
            for (int e = 0; e < 8; ++e) { pf[e] = 0.f; nf[e] = 0.f; }
            if (gi > 0) { const LAS float* p = xch + (((gi - 1) * 4 + wc) * 2 + 1) * 32 + 8 * fq; const f32x4 a = *(const LAS f32x4*)p, b = *(const LAS f32x4*)(p + 4);
#pragma unroll
                for (int e = 0; e < 4; ++e) { pf[e] = a[e]; pf[e + 4] = b[e]; } }
            if (gi < 3) { const LAS float* p = xch + (((gi + 1) * 4 + wc) * 2 + 0) * 32 + 8 * fq; const f32x4 a = *(const LAS f32x4*)p, b = *(const LAS f32x4*)(p + 4);
#pragma unroll
                for (int e = 0; e < 4; ++e) { nf[e] = a[e]; nf[e + 4] = b[e]; } }
#pragma unroll
            for (int m = 0; m < 4; ++m) {
                const int row = EPI_ROW;
                float cv[8], o[8];
#pragma unroll
                for (int e = 0; e < 8; ++e) {
                    const float g = acc[ai][0][m][e >> 2][e & 3];
                    const float upn = dpp_ror1(g), dnn = dpp_ror15(g);
                    const float upe = (m > 0) ? dpp_ror1(acc[ai][0][m > 0 ? m - 1 : 0][e >> 2][e & 3]) : pf[e];
                    const float dne = (m < 3) ? dpp_ror15(acc[ai][0][m < 3 ? m + 1 : 3][e >> 2][e & 3]) : nf[e];
                    const float up = (fr == 0) ? upe : upn, dn = (fr == 15) ? dne : dnn;
                    cv[e] = bb[e] + w0[e] * up + w1[e] * g + w2[e] * dn;
                    o[e] = gelu_t(cv[e]) * acc[ai][1][m][e >> 2][e & 3];
                }
                *(u32x4*)(ACT + (size_t)row * DFF + ch0) = pack8(o);
                if (gi == 0 && m == 0 && fr == 0 && !seq_first) { float* sp = SIDE + ((size_t)u.pm * 2 + 0) * SIDE_STRIDE + ch0;
                    *(f32x4*)sp = (f32x4){cv[0], cv[1], cv[2], cv[3]}; *(f32x4*)(sp + 4) = (f32x4){cv[4], cv[5], cv[6], cv[7]};
                    *(f32x4*)(sp + DFF) = acc[ai][1][m][0]; *(f32x4*)(sp + DFF + 4) = acc[ai][1][m][1]; *(f32x4*)(sp + 2 * DFF) = acc[ai][0][m][0]; *(f32x4*)(sp + 2 * DFF + 4) = acc[ai][0][m][1]; }
                if (gi == 3 && m == 3 && fr == 15 && !seq_last) { float* sp = SIDE + ((size_t)u.pm * 2 + 1) * SIDE_STRIDE + ch0;
                    *(f32x4*)sp = (f32x4){cv[0], cv[1], cv[2], cv[3]}; *(f32x4*)(sp + 4) = (f32x4){cv[4], cv[5], cv[6], cv[7]};
                    *(f32x4*)(sp + DFF) = acc[ai][1][m][0]; *(f32x4*)(sp + DFF + 4) = acc[ai][1][m][1]; *(f32x4*)(sp + 2 * DFF) = acc[ai][0][m][0]; *(f32x4*)(sp + 2 * DFF + 4) = acc[ai][0][m][1]; }
                __builtin_amdgcn_sched_barrier(0);
            }
        }
    }
};
DI void geglu_fix(const int wid_s, bf16* ACT, const float* SIDE, const float* fw, const float* fb, int c, int G) {
    const int tid = get_tid(wid_s);
    for (int i = c * 512 + tid; i < 63 * (DFF / 4); i += G * 512) {
        const int pm = i / (DFF / 4), ch = (i % (DFF / 4)) * 4;
        if ((pm & 7) == 7) continue;
        const float* sl = SIDE + ((size_t)pm * 2 + 1) * SIDE_STRIDE + ch;
        const float* sf = SIDE + ((size_t)(pm + 1) * 2 + 0) * SIDE_STRIDE + ch;
        const f32x4 pl = *(const f32x4*)sl, vl = *(const f32x4*)(sl + DFF), gl = *(const f32x4*)(sl + 2 * DFF);
        const f32x4 pf = *(const f32x4*)sf, vf = *(const f32x4*)(sf + DFF), gf = *(const f32x4*)(sf + 2 * DFF);
        const f32x4 w0 = *(const f32x4*)(fw + ch), w2 = *(const f32x4*)(fw + 2 * DFF + ch);
        float ol[4], of[4];
#pragma unroll
        for (int e = 0; e < 4; ++e) { ol[e] = gelu_t(pl[e] + w2[e] * gf[e]) * vl[e]; of[e] = gelu_t(pf[e] + w0[e] * gl[e]) * vf[e]; }
        *(u32x2*)(ACT + (size_t)(pm * 256 + 255) * DFF + ch) = (u32x2){pk2(ol[0], ol[1]), pk2(ol[2], ol[3])};
        *(u32x2*)(ACT + (size_t)(pm * 256 + 256) * DFF + ch) = (u32x2){pk2(of[0], of[1]), pk2(of[2], of[3])};
    }
}
DI void ln_rows(const float* src, float* dstf, bf16* dstb, const float* g, const float* bt, int gw, int NGW, int lane) {
    for (int mrow = gw; mrow < M; mrow += NGW) {
        const f32x4* xr = (const f32x4*)(src + (size_t)mrow * D) + lane;
        f32x4 v[4]; float s = 0.f;
#pragma unroll
        for (int j = 0; j < 4; ++j) { v[j] = xr[64 * j]; s += (v[j].x + v[j].y) + (v[j].z + v[j].w); }
        const float mean = wave_sum(s, lane) * (1.f / D); float s2 = 0.f;
#pragma unroll
        for (int j = 0; j < 4; ++j) { v[j] = v[j] - mean; s2 += (v[j].x * v[j].x + v[j].y * v[j].y) + (v[j].z * v[j].z + v[j].w * v[j].w); }
        const float rstd = __builtin_amdgcn_rsqf(wave_sum(s2, lane) * (1.f / D) + LN_EPS);
        f32x4* of = (f32x4*)(dstf + (size_t)mrow * D) + lane; u32x2* ob = (u32x2*)(dstb + (size_t)mrow * D) + lane;
#pragma unroll
        for (int j = 0; j < 4; ++j) { const f32x4 gg = ((const f32x4*)g)[lane + 64 * j], bb = ((const f32x4*)bt)[lane + 64 * j];
            const f32x4 y = v[j] * rstd * gg + bb; of[64 * j] = y; ob[64 * j] = (u32x2){pk2(y.x, y.y), pk2(y.z, y.w)}; }
    }
}
DI void tr_item(const float* W, int N, bf16* WT, int ldt, int rowmode, int dup, LAS float* scr, int kb, int nb, int lane) {
    const int k0 = 64 * kb, n0 = 32 * nb;
#pragma unroll 8
    for (int i = 0; i < 32; ++i) { const int kk = 2 * i + (lane >> 5); scr[kk * 33 + (lane & 31)] = W[(size_t)(k0 + kk) * N + n0 + (lane & 31)]; }
    LDS_WAIT(); asm volatile("" ::: "memory");
    const int c = lane & 7;
#pragma unroll
    for (int j = 0; j < 4; ++j) { const int n = (lane >> 3) + 8 * j; const LAS float* s = scr + (8 * c) * 33 + n;
        u32x4 o; o.x = pk2(s[0 * 33], s[1 * 33]); o.y = pk2(s[2 * 33], s[3 * 33]); o.z = pk2(s[4 * 33], s[5 * 33]); o.w = pk2(s[6 * 33], s[7 * 33]);
        const int nn = n0 + n; const int row = rowmode == 0 ? nn : ((nn >> 7) * 256 + (rowmode - 1) * 128 + (nn & 127));
        *(u32x4*)(WT + (size_t)row * ldt + k0 + 8 * c) = o; if (dup) *(u32x4*)(WT + (size_t)row * ldt + 1024 + k0 + 8 * c) = o; }
    LDS_WAIT(); asm volatile("" ::: "memory");
}
struct InPtrs { const float* in[26]; };
typedef const __attribute__((address_space(4))) unsigned char* kptr_t;
#define INP(i) (*(const float* const __attribute__((address_space(4)))*)(kp + 8 * (i)))
enum { CJ_IN = 1, CJ_G = 2, CJ_PA = 4, CJ_PR = 8, CJ_O = 16, CJ_UP = 32, CJ_DN = 64, CJ_PLE = 128, CJ_PG = 256, CJ_P = 512, CJ_ALL = 1023 };
DI void convert_layer(kptr_t kp, unsigned char* ws, int l, int mask, LAS unsigned char* lds, int gw, int NGW, int wave, int lane) {
    LAS float* scr = (LAS float*)(lds + wave * 8448);
    bf16* Wb = (bf16*)(ws + WS_W);
    if (mask & CJ_IN) for (int r = gw; r < 16 * 176; r += NGW) tr_item(INP(4) + (size_t)l * D * DIN, DIN, Wb + W_IN, D, 0, 0, scr, r / 176, r % 176, lane);
    if (mask & CJ_G) for (int r = gw; r < 512; r += NGW) { const int x = r >> 8, rr = r & 255, g = rr >> 5, q = rr & 31;
        tr_item(INP(x ? 10 : 8) + ((size_t)l * 8 + g) * 65536, 256, Wb + W_G + (size_t)g * 512 * 256, 256, 1 + x, 0, scr, q / 8, q % 8, lane); }
    if (mask & CJ_PA) for (int r = gw; r < 512; r += NGW) tr_item(INP(13) + (size_t)l * D * D, D, Wb + W_PA, D, 0, 0, scr, r / 32, r % 32, lane);
    if (mask & CJ_PR) for (int r = gw; r < 512; r += NGW) tr_item(INP(14) + (size_t)l * D * D, D, Wb + W_PR, D, 0, 0, scr, r / 32, r % 32, lane);
    if (mask & CJ_O) for (int r = gw; r < 512; r += NGW) tr_item(INP(15) + (size_t)l * D * D, D, Wb + W_O, D, 0, 0, scr, r / 32, r % 32, lane);
    if (mask & CJ_UP) for (int r = gw; r < 16 * 192; r += NGW) { const int kb = r / 192, nb = r % 192, hf = nb >= 96;
        tr_item(INP(18) + (size_t)l * D * 2 * DFF + hf * DFF, 2 * DFF, Wb + W_UP, D, 1 + hf, 0, scr, kb, nb - hf * 96, lane); }
    if (mask & CJ_DN) for (int r = gw; r < 48 * 32; r += NGW) tr_item(INP(21) + (size_t)l * DFF * D, D, Wb + W_DN, DFF, 0, 0, scr, r / 32, r % 32, lane);
    if (mask & CJ_PLE) for (int r = gw; r < 4 * 32; r += NGW) tr_item(INP(22) + (size_t)l * DPLE * D, D, Wb + W_PLE, DPLE, 0, 0, scr, r / 32, r % 32, lane);
    if (mask & CJ_PG) for (int r = gw; r < 512; r += NGW) tr_item(INP(23) + (size_t)l * D * D, D, Wb + W_PG, D, 0, 0, scr, r / 32, r % 32, lane);
    if (mask & CJ_P) {
        const float* P = INP(1) + (size_t)l * M * DPLE; bf16* PB = (bf16*)(ws + WS_PB);
        for (size_t i = (size_t)gw * 64 + lane; i < (size_t)M * DPLE / 8; i += (size_t)NGW * 64) {
            const f32x4 a = ((const f32x4*)P)[2 * i], b = ((const f32x4*)P)[2 * i + 1];
            ((u32x4*)PB)[i] = (u32x4){pk2(a.x, a.y), pk2(a.z, a.w), pk2(b.x, b.y), pk2(b.z, b.w)};
        }
    }
}
DI void rope_table(float* rope, int gtid, int nthr) {
    for (int i = gtid; i < SEQ * 16; i += nthr) {
        const int pos = i >> 4, j = i & 15;
        const float inv = exp2f(-(float)j * (18.931568569324174f / 16.0f));
        const float ang = (float)pos * inv;
        const double rev = (double)ang * 0.15915494309189535; const float fr = (float)(rev - floor(rev));
        rope[2 * i] = __builtin_amdgcn_cosf(fr); rope[2 * i + 1] = __builtin_amdgcn_sinf(fr);
    }
}
DI void conv_phase(const int wid_s, const bf16* xr, bf16* XFB, const float* cw, const float* cb, int c, int G) {
    const int tid = get_tid(wid_s); const int cg8 = (tid & 127) * 8, sub = tid >> 7;
    for (int it = c; it < M / 32; it += G) {
        const int r0 = it * 32 + sub * 8; const int t0 = r0 & (SEQ - 1);
        u32x4 xin[14];
#pragma unroll
        for (int i = 0; i < 14; ++i) { const int t = t0 - 3 + i; xin[i] = (t >= 0 && t < SEQ) ? *(const u32x4*)(xr + (size_t)(r0 - 3 + i) * 1024 + cg8) : (u32x4){0u, 0u, 0u, 0u}; }
#pragma unroll
        for (int dir = 0; dir < 2; ++dir) {
            float w[4][8], b8[8];
#pragma unroll
            for (int k = 0; k < 4; ++k) { const f32x4 w0 = *(const f32x4*)(cw + (dir * 4 + k) * 1024 + cg8), w1 = *(const f32x4*)(cw + (dir * 4 + k) * 1024 + cg8 + 4);
                w[k][0] = w0.x; w[k][1] = w0.y; w[k][2] = w0.z; w[k][3] = w0.w; w[k][4] = w1.x; w[k][5] = w1.y; w[k][6] = w1.z; w[k][7] = w1.w; }
            { const f32x4 w0 = *(const f32x4*)(cb + dir * 1024 + cg8), w1 = *(const f32x4*)(cb + dir * 1024 + cg8 + 4);
                b8[0] = w0.x; b8[1] = w0.y; b8[2] = w0.z; b8[3] = w0.w; b8[4] = w1.x; b8[5] = w1.y; b8[6] = w1.z; b8[7] = w1.w; }
#pragma unroll
            for (int j = 0; j < 8; ++j) {
                float o[8];
#pragma unroll
                for (int e = 0; e < 8; ++e) o[e] = b8[e];
#pragma unroll
                for (int k = 0; k < 4; ++k) { float xv[8]; unpack8(xin[dir ? (j + 3 + k) : (j + 3 - k)], xv);
#pragma unroll
                    for (int e = 0; e < 8; ++e) o[e] += w[k][e] * xv[e]; }
                *(u32x4*)(XFB + ((size_t)dir * M + r0 + j) * 1024 + cg8) = pack8(o);
            }
        }
    }
}
DI void attn_phase(const int wid_s, LAS unsigned char* lds, const bf16* zq, const bf16* zk, const bf16* zv, bf16* att, const float* sink, int c, int G) {
    const int tid = get_tid(wid_s); const int w = wid_s, lane = tid & 63, l32 = lane & 31, h = lane >> 5;
    LAS unsigned char* Ks = lds;
    LAS unsigned char* Vt = lds + 34816;
    for (int L = c; L < 512; L += G) {
        const int it = (L & 7) * 64 + (L >> 3);
        const int pair = it & 1, kvh = (it >> 1) & 1, n = (it >> 2) & 15, b = it >> 6;
        const int hq = kvh * 4 + pair * 2 + (w >> 2);
        const int qrl = (w & 3) * 32 + l32;
        const size_t qrow = (size_t)b * SEQ + n * 128 + qrl;
        bf16x8 qf[8];
#pragma unroll
        for (int c8 = 0; c8 < 8; ++c8) qf[c8] = *(const bf16x8*)(zq + qrow * 1024 + hq * 128 + c8 * 16 + h * 8);
        float mrun = sink[hq] * LOG2E, lrun = 1.f;
        f32x16 o[4];
#pragma unroll
        for (int dd = 0; dd < 4; ++dd)
#pragma unroll
            for (int i = 0; i < 16; ++i) o[dd][i] = 0.f;
        for (int kc = 0; kc < 3; ++kc) {
            const int kb = n - 1 + kc; if (kb < 0 || kb > 15) continue;
            __syncthreads();
            const size_t krow0 = (size_t)b * SEQ + kb * 128;
#pragma unroll
            for (int i = 0; i < 4; ++i) { const int piece = tid + i * 512; const int r = piece >> 4, cc = piece & 15;
                const u32x4 kv = *(const u32x4*)(zk + (krow0 + r) * 256 + kvh * 128 + cc * 8);
                *(LAS u32x4*)(Ks + r * 272 + cc * 16) = kv; }
#pragma unroll
            for (int i = 0; i < 4; ++i) { const int piece = tid + i * 512; const int r = piece & 127, cc = piece >> 7;
                const u32x4 vv = *(const u32x4*)(zv + (krow0 + r) * 256 + kvh * 128 + cc * 8);
#pragma unroll
                for (int e = 0; e < 8; ++e) { const unsigned wv = vv[e >> 1]; *(LAS unsigned short*)(Vt + (cc * 8 + e) * 264 + r * 2) = (unsigned short)((e & 1) ? (wv >> 16) : (wv & 0xffffu)); } }
            __syncthreads();
            f32x16 s[4];
#pragma unroll
            for (int j = 0; j < 4; ++j) {
#pragma unroll
                for (int i = 0; i < 16; ++i) s[j][i] = 0.f;
#pragma unroll
                for (int c8 = 0; c8 < 8; ++c8) { const bf16x8 kf = *(const LAS bf16x8*)(Ks + (j * 32 + l32) * 272 + c8 * 32 + h * 16);
                    s[j] = __builtin_amdgcn_mfma_f32_32x32x16_bf16(kf, qf[c8], s[j], 0, 0, 0); }
            }
            if (kc != 1) {
                int hb = (kc == 0) ? (4 * h - qrl) : (qrl - 4 * h); asm volatile("" : "+v"(hb));
#pragma unroll
                for (int j = 0; j < 4; ++j)
#pragma unroll
                    for (int i = 0; i < 16; ++i) { const int ko = j * 32 + (i & 3) + 8 * (i >> 2); const int dlt = (kc == 0) ? (hb + ko) : (hb - ko); const unsigned t = (unsigned)(dlt >> 31);
                        s[j][i] = __uint_as_float((__float_as_uint(s[j][i]) & ~t) | (0xF149F2CAu & t)); }
            }
            float mx = -3e38f;
#pragma unroll
            for (int j = 0; j < 4; ++j)
#pragma unroll
                for (int i = 0; i < 16; ++i) mx = fmaxf(mx, s[j][i]);
            mx = fmaxf(mx, shx(mx, 32, lane));
            const float mnew = fmaxf(mrun, mx); const float alpha = __builtin_amdgcn_exp2f(mrun - mnew); mrun = mnew;
            float psum = 0.f;
#pragma unroll
            for (int j = 0; j < 4; ++j)
#pragma unroll
                for (int i = 0; i < 16; ++i) { const float p = __builtin_amdgcn_exp2f(s[j][i] - mnew); s[j][i] = p; psum += p; }
            psum += shx(psum, 32, lane);
            lrun = lrun * alpha + psum;
#pragma unroll
            for (int dd = 0; dd < 4; ++dd)
#pragma unroll
                for (int i = 0; i < 16; ++i) o[dd][i] *= alpha;
#pragma unroll
            for (int j = 0; j < 4; ++j)
#pragma unroll
                for (int s2 = 0; s2 < 2; ++s2) {
                    u32x4 pw; pw.x = pk2(s[j][8 * s2 + 0], s[j][8 * s2 + 1]); pw.y = pk2(s[j][8 * s2 + 2], s[j][8 * s2 + 3]); pw.z = pk2(s[j][8 * s2 + 4], s[j][8 * s2 + 5]); pw.w = pk2(s[j][8 * s2 + 6], s[j][8 * s2 + 7]);
                    const bf16x8 pf = __builtin_bit_cast(bf16x8, pw);
#pragma unroll
                    for (int dd = 0; dd < 4; ++dd) { const LAS unsigned char* vp = Vt + (dd * 32 + l32) * 264 + (j * 32 + 16 * s2 + 4 * h) * 2;
                        const u32x2 lo = *(const LAS u32x2*)vp, hi = *(const LAS u32x2*)(vp + 16);
                        const u32x4 vw = {lo.x, lo.y, hi.x, hi.y};
                        o[dd] = __builtin_amdgcn_mfma_f32_32x32x16_bf16(__builtin_bit_cast(bf16x8, vw), pf, o[dd], 0, 0, 0); }
                }
        }
        const float inv = __builtin_amdgcn_rcpf(lrun);
        bf16* op = att + qrow * 1024 + hq * 128;
#pragma unroll
        for (int dd = 0; dd < 4; ++dd)
#pragma unroll
            for (int i4 = 0; i4 < 4; ++i4) { const int d0 = dd * 32 + 8 * i4 + 4 * h;
                *(u32x2*)(op + d0) = (u32x2){pk2(o[dd][4 * i4] * inv, o[dd][4 * i4 + 1] * inv), pk2(o[dd][4 * i4 + 2] * inv, o[dd][4 * i4 + 3] * inv)}; }
    }
}
DI void scan_step8(const u32x4 lw, const u32x4 uw, const bool start, float (&H)[8], float (&P)[8]) {
    float la[8], ux[8]; unpack8(lw, la); unpack8(uw, ux);
#pragma unroll
    for (int e = 0; e < 8; ++e) { const float a = __builtin_amdgcn_exp2f(la[e]); const float mlt = start ? 1.f : __builtin_amdgcn_sqrtf(fmaxf(1.f - a * a, 0.f)); H[e] = a * H[e] + ux[e] * mlt; P[e] *= a; }
}
DI void scan_phase(const int wid_s, LAS unsigned char* lds, const bf16* LA, const bf16* U, const bf16* yr, bf16* HG, int c, int G) {
    const int tid = get_tid(wid_s); const int q = tid & 3, seg = tid >> 2;
    LAS float* sP = (LAS float*)lds;
    LAS float* sH = sP + 2 * 128 * 32;
    LAS float* sC = sH + 2 * 128 * 32;
    for (int L = c; L < 256; L += G) {
        const int it = (L & 7) * 32 + (L >> 3);
        const int b = it >> 5, ch = (it & 31) * 32 + q * 8;
        const size_t r0 = (size_t)b * SEQ + seg * 16;
        const bf16* laf = LA + r0 * 1024 + ch; const bf16* uxf = U + r0 * 1024 + ch;
        const bf16* lab = laf + (size_t)M * 1024; const bf16* uxb = uxf + (size_t)M * 1024;
        float Hf[8], Pf[8], Hb[8], Pb[8];
#pragma unroll
        for (int e = 0; e < 8; ++e) { Hf[e] = 0.f; Pf[e] = 1.f; Hb[e] = 0.f; Pb[e] = 1.f; }
#pragma unroll 1
        for (int j0 = 0; j0 < 16; j0 += 4) {
            u32x4 lf[4], uf[4], lb[4], ub[4];
#pragma unroll
            for (int j = 0; j < 4; ++j) { lf[j] = *(const u32x4*)(laf + (size_t)(j0 + j) * 1024); uf[j] = *(const u32x4*)(uxf + (size_t)(j0 + j) * 1024);
                lb[j] = *(const u32x4*)(lab + (size_t)(15 - j0 - j) * 1024); ub[j] = *(const u32x4*)(uxb + (size_t)(15 - j0 - j) * 1024); }
#pragma unroll
            for (int j = 0; j < 4; ++j) { scan_step8(lf[j], uf[j], (seg == 0) && (j0 + j == 0), Hf, Pf); scan_step8(lb[j], ub[j], (seg == 127) && (j0 + j == 0), Hb, Pb); }
        }
        __syncthreads();
#pragma unroll
        for (int e = 0; e < 8; ++e) { sP[(0 * 128 + seg) * 32 + q * 8 + e] = Pf[e]; sH[(0 * 128 + seg) * 32 + q * 8 + e] = Hf[e]; sP[(1 * 128 + seg) * 32 + q * 8 + e] = Pb[e]; sH[(1 * 128 + seg) * 32 + q * 8 + e] = Hb[e]; }
        __syncthreads();
        if (tid < 64) { const int dir = tid >> 5, cc = tid & 31; float C = 0.f;
            for (int s2 = 0; s2 < 128; ++s2) { const int sg = dir ? 127 - s2 : s2; sC[(dir * 128 + sg) * 32 + cc] = C; C = sP[(dir * 128 + sg) * 32 + cc] * C + sH[(dir * 128 + sg) * 32 + cc]; } }
        __syncthreads();
#pragma unroll
        for (int e = 0; e < 8; ++e) { Hf[e] = sC[(0 * 128 + seg) * 32 + q * 8 + e]; Hb[e] = sC[(1 * 128 + seg) * 32 + q * 8 + e]; }
        unsigned hfp[16][4];
#pragma unroll
        for (int j0 = 0; j0 < 16; j0 += 4) {
            u32x4 lf[4], uf[4];
#pragma unroll
            for (int j = 0; j < 4; ++j) { lf[j] = *(const u32x4*)(laf + (size_t)(j0 + j) * 1024); uf[j] = *(const u32x4*)(uxf + (size_t)(j0 + j) * 1024); }
#pragma unroll
            for (int j = 0; j < 4; ++j) { scan_step8(lf[j], uf[j], (seg == 0) && (j0 + j == 0), Hf, Pf);
                hfp[j0 + j][0] = pk2(Hf[0], Hf[1]); hfp[j0 + j][1] = pk2(Hf[2], Hf[3]); hfp[j0 + j][2] = pk2(Hf[4], Hf[5]); hfp[j0 + j][3] = pk2(Hf[6], Hf[7]); }
            __builtin_amdgcn_sched_barrier(0);
        }
        const bf16* yp = yr + r0 * 1024 + ch; bf16* hp = HG + r0 * 1024 + ch;
#pragma unroll
        for (int j0 = 0; j0 < 16; j0 += 4) {
            u32x4 lb[4], ub[4], yv[4];
#pragma unroll
            for (int j = 0; j < 4; ++j) { const int tt = 15 - j0 - j; lb[j] = *(const u32x4*)(lab + (size_t)tt * 1024); ub[j] = *(const u32x4*)(uxb + (size_t)tt * 1024); yv[j] = *(const u32x4*)(yp + (size_t)tt * 1024); }
#pragma unroll
            for (int j = 0; j < 4; ++j) { const int tt = 15 - j0 - j; scan_step8(lb[j], ub[j], (seg == 127) && (j0 + j == 0), Hb, Pb);
                float y[8], o[8]; unpack8(yv[j], y);
                const float hf[8] = {bflo(hfp[tt][0]), bfhi(hfp[tt][0]), bflo(hfp[tt][1]), bfhi(hfp[tt][1]), bflo(hfp[tt][2]), bfhi(hfp[tt][2]), bflo(hfp[tt][3]), bfhi(hfp[tt][3])};
#pragma unroll
                for (int e = 0; e < 8; ++e) o[e] = (hf[e] + Hb[e]) * gelu_t(y[e]);
                *(u32x4*)(hp + (size_t)tt * 1024) = pack8(o); }
            __builtin_amdgcn_sched_barrier(0);
        }
    }
}
#define XB_TMO      128
#define XB_XCNT(j)  (256  + 64 * (j))
#define XB_XSUB(j)  (1280 + 64 * (j))
#define XB_XGEN(j)  (2304 + 64 * (j))
#define XB_TOP      3328
#define XB_TOPGEN   3392
#define XCD_BAR_WORDS 3456
#define XB_SPIN_CAP (1u << 18)

__device__ __forceinline__ unsigned xb_ld(unsigned* p)              { return __hip_atomic_load(p, __ATOMIC_RELAXED, __HIP_MEMORY_SCOPE_AGENT); }
__device__ __forceinline__ unsigned xb_add(unsigned* p, unsigned v) { return __hip_atomic_fetch_add(p, v, __ATOMIC_RELAXED, __HIP_MEMORY_SCOPE_AGENT); }
__device__ __forceinline__ unsigned xb_xcc_id() { return (unsigned)__builtin_amdgcn_s_getreg((3 << 11) | 20) & 0xFu; }
#define XB_SPIN(cond, bar) do { unsigned _sp = 0; while (cond) { __builtin_amdgcn_s_sleep(1); \
    if ((++_sp & 255u) == 0u) { if (xb_ld(&(bar)[XB_TMO])) break; if (_sp > XB_SPIN_CAP) { atomicAdd(&(bar)[XB_TMO], 1u); break; } } } } while (0)

struct XcdBarrier {
    unsigned* bar; unsigned x;
    volatile LAS unsigned* st;
};

__device__ __forceinline__ XcdBarrier xcd_barrier_post(unsigned* bar, volatile LAS unsigned* st, int tid) {
    XcdBarrier b; b.bar = bar; b.x = xb_xcc_id(); b.st = st;
    if (tid == 0) (void)xb_add(&bar[XB_XCNT(b.x)], 1u);
    return b;
}
__device__ __forceinline__ void xcd_barrier_complete(unsigned* bar, unsigned x, unsigned& nloc, unsigned& nx) {
    const unsigned G = gridDim.x * gridDim.y * gridDim.z;
    unsigned sum, cnt, mine, sp = 0u;
    for (;;) {
        sum = 0u; cnt = 0u; mine = 0u;
#pragma unroll
        for (unsigned j = 0; j < 16; ++j) { const unsigned c = xb_ld(&bar[XB_XCNT(j)]); sum += c; cnt += (c > 0u) ? 1u : 0u; mine = (j == x) ? c : mine; }
        if (sum == G) break;
        __builtin_amdgcn_s_sleep(1);
        if ((++sp & 255u) == 0u) { if (xb_ld(&bar[XB_TMO])) break; if (sp > XB_SPIN_CAP) { atomicAdd(&bar[XB_TMO], 1u); break; } }
    }
    nloc = mine > 0u ? mine : 1u; nx = cnt > 0u ? cnt : 1u;
}

__device__ __forceinline__ void xcd_barrier(const XcdBarrier& b, int tid) {
    asm volatile("s_waitcnt vmcnt(0)" ::: "memory");
    __syncthreads();
    if (tid == 0) {
        unsigned* bar = b.bar;
        __builtin_amdgcn_s_waitcnt(0);
        unsigned nloc = b.st[0], nx = b.st[1];
        if (nloc == 0u) { xcd_barrier_complete(bar, b.x, nloc, nx); b.st[0] = nloc; b.st[1] = nx; }
        const unsigned old = xb_add(&bar[XB_XSUB(b.x)], 1u);
        const unsigned gen = old / nloc;
        if (old + 1u == (gen + 1u) * nloc) {
            __builtin_amdgcn_fence(__ATOMIC_RELEASE, "agent");
            asm volatile("s_waitcnt vmcnt(0)" ::: "memory");
            const unsigned og = xb_add(&bar[XB_TOP], 1u);
            const unsigned tg = og / nx;
            if (og + 1u == (tg + 1u) * nx) xb_add(&bar[XB_TOPGEN], 1u);
            else XB_SPIN(xb_ld(&bar[XB_TOPGEN]) == tg, bar);
            __builtin_amdgcn_fence(__ATOMIC_ACQUIRE, "agent");
            xb_add(&bar[XB_XGEN(b.x)], 1u);
            asm volatile("s_waitcnt vmcnt(0)" ::: "memory");
        } else {
            XB_SPIN(xb_ld(&bar[XB_XGEN(b.x)]) == gen, bar);
            __builtin_amdgcn_fence(__ATOMIC_ACQUIRE, "agent");
            asm volatile("s_waitcnt vmcnt(0)" ::: "memory");
        }
    }
    __syncthreads();
}

struct Args { InPtrs I; float* out; unsigned char* ws; int ph_lo, ph_hi; };
#ifndef ONLY
#define ONLY -1
#endif
#define CASE_ON(n) if constexpr (ONLY < 0 || ONLY == (n))
#ifndef PROBE_K
#define PROBE_K -1
#endif
constexpr int PH_PER_LAYER = 9 + (PROBE_K >= 0 ? 1 : 0), N_PHASES = 1 + DEPTH * PH_PER_LAYER;

__global__ void __launch_bounds__(512, 2) fwd_kernel(Args args) {
    extern __shared__ __attribute__((aligned(16))) unsigned char lds_raw[];
    LAS unsigned char* lds = (LAS unsigned char*)lds_raw;
    cg::grid_group grid = cg::this_grid();
    const int wid_s = __builtin_amdgcn_readfirstlane((int)threadIdx.x >> 6);
    XcdBarrier bar;
    {
        const int tid0 = get_tid(wid_s);
        unsigned* barw = (unsigned*)(args.ws + WS_BAR);
        volatile LAS unsigned* st = (volatile LAS unsigned*)(lds + 131072 + 64);
        if (blockIdx.x == 0) { for (int i = tid0; i < XCD_BAR_WORDS; i += 512) __hip_atomic_store(barw + i, 0u, __ATOMIC_RELAXED, __HIP_MEMORY_SCOPE_AGENT);
            unsigned* cw = (unsigned*)(args.ws + WS_CNT); for (int i = tid0; i < CNT_WORDS; i += 512) __hip_atomic_store(cw + i, 0u, __ATOMIC_RELAXED, __HIP_MEMORY_SCOPE_AGENT); }
        if (tid0 < 2) st[tid0] = 0u;
        __syncthreads();
        grid.sync();
        bar = xcd_barrier_post(barw, st, tid0);
    }
    for (int ph = args.ph_lo; ph < args.ph_hi; ++ph) {
        kptr_t kp = (kptr_t)__builtin_amdgcn_kernarg_segment_ptr(); asm volatile("" : "+s"(kp));
        float* trunk = *(float* const __attribute__((address_space(4)))*)(kp + 208);
        unsigned char* ws = *(unsigned char* const __attribute__((address_space(4)))*)(kp + 216);
        const int wave = wid_s;
        int G = gridDim.x, c = blockIdx.x; asm volatile("" : "+s"(G), "+s"(c));
        const int gw = c * 8 + wave, NGW = G * 8;
        float* rope = (float*)(ws + WS_ROPE);
        bf16* Wb = (bf16*)(ws + WS_W); bf16* PB = (bf16*)(ws + WS_PB); bf16* HB = (bf16*)(ws + WS_HB); bf16* Z = (bf16*)(ws + WS_Z);
        bf16* ATT = (bf16*)(ws + WS_ATT); bf16* XFB = (bf16*)(ws + WS_XFB); bf16* UB = (bf16*)(ws + WS_EXTRA); float* T = (float*)(ws + WS_EXTRA);
        bf16* LAb = Z; bf16* HG = XFB; bf16* ACT = Z; float* SIDE = (float*)(ws + WS_ATT);
        if (ph > args.ph_lo) { xcd_barrier(bar, get_tid(wid_s));
#ifdef PROBE_SYNC2
            xcd_barrier(bar, get_tid(wid_s));
#endif
        }
        if (ph == 0) { CASE_ON(100) {
            const int tid = get_tid(wid_s), lane = tid & 63;
            convert_layer(kp, ws, 0, CJ_ALL, lds, gw, NGW, wave, lane);
            ln_rows(INP(0), trunk, HB, INP(2), INP(3), gw, NGW, lane);
            rope_table(rope, c * 512 + tid, G * 512); }
            continue;
        }
        const int l = (ph - 1) / PH_PER_LAYER; int k = (ph - 1) % PH_PER_LAYER; if (PROBE_K >= 0 && k == 9) k = PROBE_K;
        switch (k) {
        case 0: CASE_ON(0) {
            pg8::TileOrder S; S.init(M, DIN, G, c, HB, D, Wb + W_IN, D);
            EpiIn E{Z, rope};
            pg8::gemm_phase(lds, wid_s, D, D, S, E);
        } break;
        case 1: CASE_ON(1) {
            attn_phase(wid_s, lds, Z + Z_Q, Z + Z_K, Z + Z_V, ATT, INP(5) + l * NH, c, G);
            conv_phase(wid_s, Z + Z_XR, XFB, INP(6) + (size_t)l * 2 * 4 * D, INP(7) + (size_t)l * 2 * D, c, G);
            __syncthreads();
            const int lane = get_tid(wid_s) & 63;
            if (l > 0) convert_layer(kp, ws, l, CJ_DN, lds, gw, NGW, wave, lane);
            if (l + 1 < DEPTH) convert_layer(kp, ws, l + 1, CJ_IN, lds, gw, NGW, wave, lane);
        } break;
        case 2: CASE_ON(2) {
            pg8::GateOrder S{G, c, (const char*)XFB, (const char*)(Wb + W_G)};
            EpiGate E{XFB, LAb, UB, INP(9) + (size_t)l * 2 * D, INP(11) + (size_t)l * 2 * D, INP(12) + (size_t)l * 2 * D};
            pg8::gemm_phase(lds, wid_s, 256, 1024, S, E);
        } break;
        case 3: CASE_ON(3) {
            scan_phase(wid_s, lds, LAb, UB, Z + Z_GY, HG, c, G);
            __syncthreads();
            if (l + 1 < DEPTH) convert_layer(kp, ws, l + 1, CJ_G, lds, gw, NGW, wave, get_tid(wid_s) & 63);
        } break;
        case 4: CASE_ON(4) {
            { pg8::TileOrder S; S.init(M, D, G, c, ATT, D, Wb + W_PA, D); EpiX<EP_PA> E{T, nullptr, Z + Z_SA, nullptr}; pg8::gemm_phase(lds, wid_s, D, D, S, E); }
            { pg8::TileOrder S; S.init(M, D, G, c, HG, D, Wb + W_PR, D); EpiX<EP_PR> E{T, nullptr, Z + Z_SR, HB}; pg8::gemm_phase(lds, wid_s, D, D, S, E); }
        } break;
        case 5: CASE_ON(5) {
            pg8::TileOrder S; S.init(M, D, G, c, HB, D, Wb + W_O, D);
            EpiLn E{trunk, HB, INP(16) + (size_t)l * D, INP(17) + (size_t)l * D, (unsigned long long*)(ws + WS_ATT + 16 * MiB), (unsigned*)(ws + WS_CNT) + (2 * l) * 1024, DN_ALPHA};
            pg8::gemm_phase(lds, wid_s, D, D, S, E);
        } break;
        case 6: CASE_ON(6) {
            pg8::TileOrder S; S.init(M, 2 * DFF, G, c, HB, D, Wb + W_UP, D);
            EpiUpG E{ACT, SIDE, INP(19) + (size_t)l * 3 * DFF, INP(20) + (size_t)l * DFF, (LAS float*)(lds + 131072 + 1024)};
            pg8::gemm_phase(lds, wid_s, D, D, S, E);
        } break;
        case 7: CASE_ON(7) {
            geglu_fix(wid_s, ACT, SIDE, INP(19) + (size_t)l * 3 * DFF, INP(20) + (size_t)l * DFF, c, G);
            { pg8::TileOrder S; S.init(M, D, G, c, PB, DPLE, Wb + W_PLE, DPLE); EpiX<EP_PLE1> E{T, nullptr, nullptr, nullptr}; pg8::gemm_phase(lds, wid_s, DPLE, DPLE, S, E); }
            { pg8::TileOrder S; S.init(M, D, G, c, HB, D, Wb + W_PG, D); EpiX<EP_PLE2> E{T, trunk, nullptr, nullptr}; pg8::gemm_phase(lds, wid_s, D, D, S, E); }
            if (l + 1 < DEPTH) convert_layer(kp, ws, l + 1, CJ_PA | CJ_PR | CJ_O, lds, gw, NGW, wave, get_tid(wid_s) & 63);
        } break;
        case 8: CASE_ON(8) {
            pg8::TileOrder S; S.init(M, D, G, c, ACT, DFF, Wb + W_DN, DFF);
            EpiLn E{trunk, HB, INP(24) + (size_t)l * D, INP(25) + (size_t)l * D, (unsigned long long*)(ws + WS_ATT + 16 * MiB), (unsigned*)(ws + WS_CNT) + (2 * l + 1) * 1024, 1.f};
            pg8::gemm_phase(lds, wid_s, DFF, DFF, S, E);
            __syncthreads();
            if (l + 1 < DEPTH) convert_layer(kp, ws, l + 1, CJ_UP | CJ_PLE | CJ_PG | CJ_P, lds, gw, NGW, wave, get_tid(wid_s) & 63);
        } break;
        }
    }
}

extern "C" void kernel_launch(void* const* d_in, const int* in_sizes, int n_in, void* d_out, int out_size, void* d_ws, size_t ws_size, hipStream_t stream) {
    static int grid = 0;
    if (grid == 0) {
        if (n_in != 26 || out_size != M * D || ws_size < WS_END) { fprintf(stderr, "kernel_launch: unexpected sizes n_in %d out %d ws %zu\n", n_in, out_size, ws_size); grid = -1; return; }
        int dev = 0, cus = 0, per_cu = 0;
        hipGetDevice(&dev); hipDeviceGetAttribute(&cus, hipDeviceAttributeMultiprocessorCount, dev);
        if (hipFuncSetAttribute((const void*)fwd_kernel, hipFuncAttributeMaxDynamicSharedMemorySize, LDS_BYTES) != hipSuccess) { fprintf(stderr, "kernel_launch: hipFuncSetAttribute failed\n"); grid = -1; return; }
        hipOccupancyMaxActiveBlocksPerMultiprocessor(&per_cu, (const void*)fwd_kernel, 512, LDS_BYTES);
        (void)hipGetLastError();
        if (per_cu < 1) per_cu = 1;
        grid = cus * 1;
        if (grid > 256) grid = 256;
        if (grid != 256) { fprintf(stderr, "kernel_launch: needs a 256-CU device (one 256x256 unit per workgroup in the fused-LayerNorm phases)\n"); grid = -1; return; }
        fprintf(stderr, "kernel_launch: cus %d per_cu %d grid %d ws %zu\n", cus, per_cu, grid, ws_size);
    }
    if (grid < 0) return;
    Args a{};
    for (int i = 0; i < 26; ++i) a.I.in[i] = (const float*)d_in[i];
    a.out = (float*)d_out; a.ws = (unsigned char*)d_ws; a.ph_lo = 0; a.ph_hi = N_PHASES;
    void* kargs[] = {&a};
    hipError_t e = hipLaunchCooperativeKernel((const void*)fwd_kernel, dim3(grid), dim3(512), kargs, LDS_BYTES, stream);
    if (e != hipSuccess) fprintf(stderr, "kernel_launch: cooperative launch failed: %s\n", hipGetErrorString(e));
}
```

```cpp
#include <hip/hip_runtime.h>
#include <hip/hip_cooperative_groups.h>
#include <cstdio>
#include <cstdint>
namespace cg = cooperative_groups;

#define LAS __attribute__((address_space(3)))
#define DI __device__ __forceinline__
typedef unsigned short bf16;
typedef short bf16x8 __attribute__((ext_vector_type(8)));
typedef float f32x4 __attribute__((ext_vector_type(4)));
typedef float f32x16 __attribute__((ext_vector_type(16)));
typedef unsigned u32x4 __attribute__((ext_vector_type(4)));
typedef unsigned u32x2 __attribute__((ext_vector_type(2)));
typedef __bf16 bf16x2_t __attribute__((ext_vector_type(2)));
typedef float f32x2_t __attribute__((ext_vector_type(2)));

constexpr int BATCH = 8, SEQ = 2048, D = 1024, DEPTH = 4, M = BATCH * SEQ;
constexpr int NH = 8, NKV = 2, HD = 128, DIN = 5632, DFF = 3072, DPLE = 256;
constexpr float LN_EPS = 1e-5f;
constexpr float DN_ALPHA = 1.6817928305074290f;
constexpr float LOG2E = 1.4426950408889634f;
constexpr float QSCALE = 0.08838834764831845f * LOG2E;

constexpr size_t MiB = 1u << 20;
constexpr size_t WS_ROPE = 0;
constexpr size_t WS_BAR = 512 * 1024;
constexpr size_t WS_CNT = 512 * 1024 + 65536;
constexpr int CNT_WORDS = 8 * 64 * 16;
constexpr size_t WS_W = 1 * MiB;
constexpr size_t W_IN = 0, W_G = W_IN + (size_t)DIN * D, W_PA = W_G + 8 * 512 * 256, W_PR = W_PA + (size_t)D * D, W_O = W_PR + (size_t)D * 2 * D,
                 W_UP = W_O + (size_t)D * D, W_DN = W_UP + (size_t)2 * DFF * D, W_PLE = W_DN + (size_t)D * DFF, W_PG = W_PLE + (size_t)D * DPLE, W_END = W_PG + (size_t)D * D;
static_assert(W_END * 2 <= 42 * MiB, "weights");
constexpr size_t WS_PB = WS_W + 42 * MiB;
constexpr size_t WS_HB = WS_PB + 8 * MiB;
constexpr size_t WS_Z = WS_HB + 32 * MiB;
constexpr size_t WS_ATT = WS_Z + 176 * MiB;
constexpr size_t WS_XFB = WS_ATT + 32 * MiB;
constexpr size_t WS_EXTRA = WS_XFB + 64 * MiB;
constexpr size_t WS_END = WS_EXTRA + 64 * MiB;
static_assert(WS_END <= 440 * MiB, "ws");
constexpr size_t Z_Q = 0, Z_K = (size_t)M * 1024, Z_V = (size_t)M * 1280, Z_XR = (size_t)M * 1536, Z_GY = (size_t)M * 2560, Z_SA = (size_t)M * 3584, Z_SR = (size_t)M * 4608;

constexpr int LDS_BYTES = 139264;

DI unsigned pk2(float lo, float hi) { f32x2_t v = {lo, hi}; bf16x2_t b = __builtin_convertvector(v, bf16x2_t); return __builtin_bit_cast(unsigned, b); }
DI float bflo(unsigned u) { return __uint_as_float(u << 16); }
DI float bfhi(unsigned u) { return __uint_as_float(u & 0xffff0000u); }
DI float sigm(float x) { return __builtin_amdgcn_rcpf(1.f + __builtin_amdgcn_exp2f(-LOG2E * x)); }
DI float gelu_t(float x) { const float u = 0.7978845608028654f * (x + 0.044715f * x * x * x); return x * sigm(2.f * u); }
DI void unpack8(const u32x4 w, float (&v)[8]) { v[0] = bflo(w.x); v[1] = bfhi(w.x); v[2] = bflo(w.y); v[3] = bfhi(w.y); v[4] = bflo(w.z); v[5] = bfhi(w.z); v[6] = bflo(w.w); v[7] = bfhi(w.w); }
DI u32x4 pack8(const float (&v)[8]) { u32x4 w; w.x = pk2(v[0], v[1]); w.y = pk2(v[2], v[3]); w.z = pk2(v[4], v[5]); w.w = pk2(v[6], v[7]); return w; }
DI float shx(float v, int mask, int lane) { return __int_as_float(__builtin_amdgcn_ds_bpermute((lane ^ mask) << 2, __float_as_int(v))); }
DI float wave_sum(float v, int lane) {
#pragma unroll
    for (int o = 1; o < 64; o <<= 1) v += shx(v, o, lane);
    return v;
}
DI int get_tid(int wid_s) { int l; asm volatile("v_mbcnt_lo_u32_b32 %0, -1, 0\n\tv_mbcnt_hi_u32_b32 %0, -1, %0" : "=v"(l)); return wid_s * 64 + l; }
#define LDS_WAIT() asm volatile("s_waitcnt lgkmcnt(0)" ::: "memory")

namespace pg8 {
constexpr int BM = 256, BK = 64, HALF = 128, HTB = HALF * BK * 2, NXCD = 8, WGM = 8;
DI int lds_byte(int r, int c) { const int st = (r >> 4) * 2 + (c >> 5), rr = r & 15, cc = c & 31, ob = rr * 64 + cc * 2; return st * 1024 + (ob ^ (((ob >> 9) & 1) << 5)); }
DI void stage_rc(int b, int& R, int& C) { const int st = b / 1024, sb = b % 1024, swz = sb ^ (((sb >> 9) & 1) << 5); R = (st >> 1) * 16 + swz / 64; C = (st & 1) * 32 + (swz % 64) / 2; }
DI int perm32(int rho) { const int n = rho >> 4, i = rho & 15; return 8 * (i >> 2) + 4 * n + (i & 3); }
struct Unit { int pm, pn, g; };

struct TileOrder {
    int nM, nN, nwg, G, c; const char* Ab; const char* Bb; size_t atile, btile;
    DI void init(int Mr, int N, int G_, int c_, const void* A, int lda, const void* Bt, int K) { nM = Mr / BM; nN = N / BM; nwg = nM * nN; G = G_; c = c_; Ab = (const char*)A; Bb = (const char*)Bt; atile = (size_t)BM * lda * 2; btile = (size_t)BM * K * 2; }
    DI bool next(int i, Unit& u) const {
        const int L = i * G + c; if (L >= nwg) return false;
        int wgid = L; { const int q = nwg / NXCD, r = nwg % NXCD, xcd = wgid % NXCD, off = wgid / NXCD; wgid = (xcd < r ? xcd * (q + 1) : r * (q + 1) + (xcd - r) * q) + off; }
        const int nig = WGM * nN, gid = wgid / nig, fm = gid * WGM, gsz = (nM - fm) < WGM ? (nM - fm) : WGM;
        u.pm = fm + ((wgid % nig) % gsz); u.pn = (wgid % nig) / gsz; u.g = 0; return true;
    }
    DI const char* A(const Unit& u) const { return Ab + (size_t)u.pm * atile; }
    DI const char* B(const Unit& u) const { return Bb + (size_t)u.pn * btile; }
};
struct GateOrder {
    int G, c; const char* Ab; const char* Bb;
    DI bool next(int i, Unit& u) const {
        const int L = i * G + c; if (L >= 1024) return false;
        const int id = (L & 7) * 128 + (L >> 3); u.g = id >> 7; u.pm = (id & 127) >> 1; u.pn = id & 1; return true;
    }
    DI const char* A(const Unit& u) const { const int dir = u.g >> 2, blk = u.g & 3; return Ab + (((size_t)dir * M + (size_t)u.pm * 256) * 1024 + blk * 256) * 2; }
    DI const char* B(const Unit& u) const { return Bb + ((size_t)u.g * 512 + u.pn * 256) * 256 * 2; }
};

template <class Epi, class Sched>
DI void gemm_phase(LAS unsigned char* lds, const int wid_s, const int K, const int lda, const Sched& S, const Epi& E) {
    int tid_ = get_tid(wid_s);
    const int tid = tid_, wid = __builtin_amdgcn_readfirstlane(tid >> 6), lane = tid & 63, wr = wid >> 2, wc = wid & 3, fr = lane & 15, fq = lane >> 4;
    const int nt = K / BK;
    unsigned voffA[2], voffB[2];
#pragma unroll
    for (int i = 0; i < 2; ++i) { int R, C; stage_rc(tid * 16 + i * 8192, R, C); const int Rb = (R & ~31) + perm32(R & 31);
        voffA[i] = (unsigned)(R * lda + C) * 2u; voffB[i] = (unsigned)(Rb * K + C) * 2u; }
    const size_t kstep = (size_t)(BK * 2);
    const size_t hstepA = (size_t)HALF * lda * 2, hstepB = (size_t)HALF * K * 2;
    const unsigned ldsw = (unsigned)wid * 1024u;
    const int aoff = lds_byte(wr * 64 + fr, fq * 8), boff = lds_byte(wc * 32 + fr, fq * 8);
#define PG8_SA(b, h) (((b) * 2 + (h)) * HTB)
#define PG8_SB(b, h) ((4 + (b) * 2 + (h)) * HTB)
#define PG8_STAGE(bufoff, gbase, voff) do { _Pragma("unroll") for (int _i = 0; _i < 2; ++_i) \
        __builtin_amdgcn_global_load_lds((const unsigned*)((const char*)(gbase) + (voff)[_i]), (LAS unsigned*)(lds + (bufoff) + ldsw + _i * 8192), 16, 0, 0); } while (0)
#define PG8_LDA(dst, b, h) do { _Pragma("unroll") for (int m = 0; m < 4; ++m) _Pragma("unroll") for (int k = 0; k < 2; ++k) dst[m][k] = *(const LAS bf16x8*)(lds + PG8_SA(b, h) + aoff + m * 2048 + k * 1024); } while (0)
#define PG8_LDB(dst, b, h) do { _Pragma("unroll") for (int n = 0; n < 2; ++n) _Pragma("unroll") for (int k = 0; k < 2; ++k) dst[n][k] = *(const LAS bf16x8*)(lds + PG8_SB(b, h) + boff + n * 2048 + k * 1024); } while (0)
#define PG8_MMA(ai, bj, At, Bt) do { __builtin_amdgcn_s_setprio(1); _Pragma("unroll") for (int m = 0; m < 4; ++m) _Pragma("unroll") for (int n = 0; n < 2; ++n) _Pragma("unroll") for (int k = 0; k < 2; ++k) \
        acc[ai][bj][m][n] = __builtin_amdgcn_mfma_f32_16x16x32_bf16(Bt[n][k], At[m][k], acc[ai][bj][m][n], 0, 0, 0); __builtin_amdgcn_s_setprio(0); } while (0)
#define PG8_WAIT_V(n) asm volatile("s_waitcnt vmcnt(" #n ")" ::: "memory")
#define PG8_WAIT_L(n) asm volatile("s_waitcnt lgkmcnt(" #n ")" ::: "memory")
#define PG8_BAR __builtin_amdgcn_s_barrier()
#define PG8_SCHED __builtin_amdgcn_sched_barrier(0)
    PG8_SCHED;
    Unit cur, nxt; int ui = 0;
    if (!S.next(0, cur)) return;
    f32x4 acc[2][2][4][2];
#pragma unroll
    for (int a = 0; a < 2; ++a)
#pragma unroll
        for (int b = 0; b < 2; ++b)
#pragma unroll
            for (int m = 0; m < 4; ++m)
#pragma unroll
                for (int n = 0; n < 2; ++n) acc[a][b][m][n] = (f32x4){0.f, 0.f, 0.f, 0.f};
    bf16x8 At[4][2], B0[2][2], B1[2][2];
    const char* cA = S.A(cur); const char* cB = S.B(cur);
    PG8_STAGE(PG8_SB(0, 0), cB, voffB); PG8_STAGE(PG8_SB(0, 1), cB + hstepB, voffB); PG8_STAGE(PG8_SA(0, 0), cA, voffA); PG8_STAGE(PG8_SA(0, 1), cA + hstepA, voffA);
    if (wr == 1) PG8_BAR;
    PG8_WAIT_V(2); PG8_BAR;
    PG8_STAGE(PG8_SB(1, 0), cB + kstep, voffB); PG8_STAGE(PG8_SA(1, 0), cA + kstep, voffA); PG8_STAGE(PG8_SB(1, 1), cB + hstepB + kstep, voffB);
    PG8_WAIT_V(6); PG8_BAR;
    for (;;) {
        const bool has_next = S.next(ui + 1, nxt);
        const char* nA = has_next ? S.A(nxt) : cA; const char* nB = has_next ? S.B(nxt) : cB;
#pragma unroll 1
        for (int t = 0; t < nt; t += 2) {
            const bool last = (t == nt - 2);
            const char* a1 = cA + (size_t)(t + 1) * kstep;
            const char* a2 = last ? nA : cA + (size_t)(t + 2) * kstep; const char* b2 = last ? nB : cB + (size_t)(t + 2) * kstep;
            const char* a3 = a2 + kstep; const char* b3 = b2 + kstep;
            PG8_LDB(B0, 0, 0); PG8_LDB(B1, 0, 1); PG8_SCHED; PG8_LDA(At, 0, 0); PG8_STAGE(PG8_SA(1, 1), a1 + hstepA, voffA);
            PG8_WAIT_V(8); PG8_WAIT_L(0); PG8_BAR; PG8_MMA(0, 0, At, B0); PG8_MMA(0, 1, At, B1); PG8_BAR; PG8_SCHED;
            PG8_LDA(At, 0, 1); PG8_STAGE(PG8_SB(0, 0), b2, voffB); PG8_STAGE(PG8_SB(0, 1), b2 + hstepB, voffB); PG8_STAGE(PG8_SA(0, 0), a2, voffA);
            PG8_WAIT_V(8); PG8_WAIT_L(0); PG8_BAR; PG8_MMA(1, 0, At, B0); PG8_MMA(1, 1, At, B1); PG8_BAR; PG8_SCHED;
            PG8_LDB(B0, 1, 0); PG8_LDB(B1, 1, 1); PG8_SCHED; PG8_LDA(At, 1, 0); PG8_STAGE(PG8_SA(0, 1), a2 + hstepA, voffA);
            PG8_WAIT_V(8); PG8_WAIT_L(0); PG8_BAR; PG8_MMA(0, 0, At, B0); PG8_MMA(0, 1, At, B1); PG8_BAR; PG8_SCHED;
            PG8_LDA(At, 1, 1); PG8_STAGE(PG8_SB(1, 0), b3, voffB); PG8_STAGE(PG8_SB(1, 1), b3 + hstepB, voffB); PG8_STAGE(PG8_SA(1, 0), a3, voffA);
            PG8_WAIT_V(8); PG8_WAIT_L(0); PG8_BAR; PG8_MMA(1, 0, At, B0); PG8_MMA(1, 1, At, B1); PG8_BAR; PG8_SCHED;
        }
        if (wr == 0) PG8_BAR;
        if constexpr (!Epi::AFTER_DRAIN) E(acc, cur, wr, wc, fr, fq);
        if (!has_next) break;
#pragma unroll
        for (int a = 0; a < 2; ++a)
#pragma unroll
            for (int b = 0; b < 2; ++b)
#pragma unroll
                for (int m = 0; m < 4; ++m)
#pragma unroll
                    for (int n = 0; n < 2; ++n) acc[a][b][m][n] = (f32x4){0.f, 0.f, 0.f, 0.f};
        cur = nxt; cA = nA; cB = nB; ++ui;
        if (wr == 1) PG8_BAR;
    }
    PG8_WAIT_V(0);
    PG8_BAR;
    PG8_SCHED;
    if constexpr (Epi::AFTER_DRAIN) E.fused(acc, cur, wr, wc, fr, fq, lds, tid);
#undef PG8_SA
#undef PG8_SB
#undef PG8_STAGE
#undef PG8_LDA
#undef PG8_LDB
#undef PG8_MMA
#undef PG8_WAIT_V
#undef PG8_WAIT_L
#undef PG8_BAR
#undef PG8_SCHED
}
}
using pg8::Unit;
typedef f32x4 AccT[2][2][4][2];
#define EPI_ARGS const f32x4 (&acc)[2][2][4][2], const Unit& u, int wr, int wc, int fr, int fq
#define EPI_FOR_ROWS _Pragma("unroll") for (int ai = 0; ai < 2; ++ai) _Pragma("unroll") for (int m = 0; m < 4; ++m)
#define EPI_ROW (u.pm * 256 + ai * 128 + wr * 64 + m * 16 + fr)
#define EPI_V8(bj) { acc[ai][bj][m][0][0], acc[ai][bj][m][0][1], acc[ai][bj][m][0][2], acc[ai][bj][m][0][3], acc[ai][bj][m][1][0], acc[ai][bj][m][1][1], acc[ai][bj][m][1][2], acc[ai][bj][m][1][3] }

struct EpiIn {
    static constexpr bool AFTER_DRAIN = false;
    bf16* Z; const float* rope; int lite;
    DI void operator()(EPI_ARGS) const {
        if (lite == 2) return;
        const int pn = u.pn; size_t base; int ldc, colt, mode;
        if (pn < 4) { base = Z_Q; ldc = 1024; colt = pn * 256; mode = 0; }
        else if (pn == 4) { base = Z_K; ldc = 256; colt = 0; mode = 0; }
        else if (pn == 5) { base = Z_V; ldc = 256; colt = 0; mode = 1; }
        else { const int arr = (pn - 6) >> 2; base = (size_t)M * (1536 + 1024 * arr); ldc = 1024; colt = ((pn - 6) & 3) * 256; mode = arr <= 1 ? 1 : 3; }
        if (lite == 1) mode = 1;
        const float qs = pn < 4 ? QSCALE : 1.f;
        const bool rope_w = (mode == 0) && (wc == 0);
        EPI_FOR_ROWS {
            const int row = EPI_ROW;
            bf16* rowp = Z + base + (size_t)row * ldc + colt + wc * 32 + 8 * fq;
            f32x4 cs[4];
            if (rope_w) { const f32x4* rp = (const f32x4*)(rope + ((row & (SEQ - 1)) * 16 + 8 * (fq & 1)) * 2);
#pragma unroll
                for (int i = 0; i < 4; ++i) cs[i] = rp[i]; }
#pragma unroll
            for (int bj = 0; bj < 2; ++bj) {
                float v[8] = EPI_V8(bj);
                if (mode == 0) {
                    if (rope_w) {
#pragma unroll
                        for (int e = 0; e < 8; ++e) { const float pr = shx(v[e], 32, fq * 16 + fr); const float cc = cs[e >> 1][(e & 1) * 2], ss = cs[e >> 1][(e & 1) * 2 + 1];
                            v[e] = v[e] * cc + (fq < 2 ? -pr * ss : pr * ss); }
                    }
#pragma unroll
                    for (int e = 0; e < 8; ++e) v[e] *= qs;
                } else if (mode == 2) {
#pragma unroll
                    for (int e = 0; e < 8; ++e) v[e] = gelu_t(v[e]);
                } else if (mode == 3) {
#pragma unroll
                    for (int e = 0; e < 8; ++e) v[e] = sigm(v[e]);
                }
                *(u32x4*)(rowp + bj * 128) = pack8(v);
            }
        }
    }
};
struct EpiGate {
    static constexpr bool AFTER_DRAIN = false;
    const bf16* XFB; bf16* LA; bf16* U; const float* b_a; const float* b_x; const float* lam;
    DI void operator()(EPI_ARGS) const {
        const int dir = u.g >> 2, blk = u.g & 3;
        const int ch0 = blk * 256 + u.pn * 128 + wc * 32 + 8 * fq;
        float ba[8], bx[8], cl[8];
#pragma unroll
        for (int e = 0; e < 8; ++e) { ba[e] = -LOG2E * b_a[dir * 1024 + ch0 + e]; bx[e] = -LOG2E * b_x[dir * 1024 + ch0 + e];
            const float l = lam[dir * 1024 + ch0 + e]; cl[e] = -8.f * __builtin_amdgcn_logf(1.f + __builtin_amdgcn_exp2f(-LOG2E * l)); }
        u32x4 xw[2][4];
        EPI_FOR_ROWS xw[ai][m] = *(const u32x4*)(XFB + ((size_t)dir * M + EPI_ROW) * 1024 + ch0);
        EPI_FOR_ROWS {
            const int row = EPI_ROW;
            const size_t off = ((size_t)dir * M + row) * 1024 + ch0;
            float x[8]; unpack8(xw[ai][m], x);
            const float va[8] = EPI_V8(0); const float vx[8] = EPI_V8(1);
            float la[8], uu[8];
#pragma unroll
            for (int e = 0; e < 8; ++e) {
                const float ea = 1.f + __builtin_amdgcn_exp2f(fminf(-LOG2E * va[e] + ba[e], 60.f)), ex = 1.f + __builtin_amdgcn_exp2f(fminf(-LOG2E * vx[e] + bx[e], 60.f));
                const float r = __builtin_amdgcn_rcpf(ea * ex);
                la[e] = (r * ex) * cl[e]; uu[e] = x[e] * (r * ea); }
            *(u32x4*)(LA + off) = pack8(la); *(u32x4*)(U + off) = pack8(uu);
            __builtin_amdgcn_sched_barrier(0);
        }
    }
};
enum { EP_PA = 0, EP_PR, EP_PLE1, EP_PLE2 };
template <int MODE> struct EpiX {
    static constexpr bool AFTER_DRAIN = false;
    bf16* Tb;
    float* TR;
    const bf16* S;
    bf16* O;
    struct RowIn { u32x4 t[2]; f32x4 r[2][2]; u32x4 s[2]; };
    DI void load(RowIn& in, size_t off0) const {
#pragma unroll
        for (int bj = 0; bj < 2; ++bj) { const size_t off = off0 + bj * 128;
            if constexpr (MODE == EP_PA || MODE == EP_PR) in.s[bj] = *(const u32x4*)(S + off);
            if constexpr (MODE == EP_PR || MODE == EP_PLE2) in.t[bj] = *(const u32x4*)(Tb + off);
            if constexpr (MODE == EP_PLE2) { in.r[bj][0] = *(const f32x4*)(TR + off); in.r[bj][1] = *(const f32x4*)(TR + off + 4); } }
    }
    DI void operator()(EPI_ARGS) const {
        const size_t base = (size_t)(u.pm * 256 + wr * 64 + fr) * 1024 + u.pn * 256 + wc * 32 + 8 * fq;
        RowIn buf[2];
        if constexpr (MODE == EP_PR || MODE == EP_PLE2 || MODE == EP_PA) load(buf[0], base);
#pragma unroll
        for (int it = 0; it < 8; ++it) {
            const int ai = it >> 2, m = it & 3;
            const size_t off0 = base + (size_t)(ai * 128 + m * 16) * 1024;
            if constexpr (MODE != EP_PLE1) { if (it + 1 < 8) load(buf[(it + 1) & 1], base + (size_t)(((it + 1) >> 2) * 128 + ((it + 1) & 3) * 16) * 1024); }
            const RowIn& in = buf[it & 1];
#pragma unroll
            for (int bj = 0; bj < 2; ++bj) {
                const size_t off = off0 + bj * 128;
                float v[8] = EPI_V8(bj);
                if constexpr (MODE == EP_PA) { float sg[8]; unpack8(in.s[bj], sg);
#pragma unroll
                    for (int e = 0; e < 8; ++e) v[e] *= sg[e];
                    *(u32x4*)(Tb + off) = pack8(v); }
                if constexpr (MODE == EP_PR) { float sg[8], t[8]; unpack8(in.s[bj], sg); unpack8(in.t[bj], t);
#pragma unroll
                    for (int e = 0; e < 8; ++e) v[e] = t[e] + v[e] * sg[e];
                    *(u32x4*)(O + off) = pack8(v); }
                if constexpr (MODE == EP_PLE1) { *(u32x4*)(Tb + off) = pack8(v); }
                if constexpr (MODE == EP_PLE2) { float p[8]; unpack8(in.t[bj], p); const f32x4 t0 = in.r[bj][0], t1 = in.r[bj][1];
                    *(f32x4*)(TR + off) = (f32x4){DN_ALPHA * t0[0] + sigm(v[0]) * p[0], DN_ALPHA * t0[1] + sigm(v[1]) * p[1], DN_ALPHA * t0[2] + sigm(v[2]) * p[2], DN_ALPHA * t0[3] + sigm(v[3]) * p[3]};
                    *(f32x4*)(TR + off + 4) = (f32x4){DN_ALPHA * t1[0] + sigm(v[4]) * p[4], DN_ALPHA * t1[1] + sigm(v[5]) * p[5], DN_ALPHA * t1[2] + sigm(v[6]) * p[6], DN_ALPHA * t1[3] + sigm(v[7]) * p[7]}; }
            }
            if constexpr (MODE != EP_PLE1) __builtin_amdgcn_sched_barrier(0);
        }
    }
};
struct EpiLn {
    static constexpr bool AFTER_DRAIN = true;
    float* trunk; bf16* HB; const float* g; const float* bt; unsigned long long* X; unsigned* cnt; float scale;
    DI void operator()(EPI_ARGS) const {}
    DI void fused(f32x4 (&acc)[2][2][4][2], const Unit& u, int wr, int wc, int fr, int fq, LAS unsigned char* lds, int tid) const {
        LAS f32x2_t* P = (LAS f32x2_t*)lds;
        LAS f32x2_t* Sst = (LAS f32x2_t*)(lds + 8192);
        const int lane = fq * 16 + fr;
        const int col0 = u.pn * 256 + wc * 32 + 8 * fq;
        const float* tbase = trunk + (size_t)(u.pm * 256 + wr * 64 + fr) * 1024 + col0;
        f32x4 tb[2][2][2];
#pragma unroll
        for (int bj = 0; bj < 2; ++bj)
#pragma unroll
            for (int n = 0; n < 2; ++n) tb[0][bj][n] = *(const f32x4*)(tbase + bj * 128 + 4 * n);
#pragma unroll
        for (int it = 0; it < 8; ++it) {
            const int ai = it >> 2, m = it & 3; float s1 = 0.f, s2 = 0.f;
            if (it + 1 < 8) { const float* tp = tbase + (size_t)(((it + 1) >> 2) * 128 + ((it + 1) & 3) * 16) * 1024;
#pragma unroll
                for (int bj = 0; bj < 2; ++bj)
#pragma unroll
                    for (int n = 0; n < 2; ++n) tb[(it + 1) & 1][bj][n] = *(const f32x4*)(tp + bj * 128 + 4 * n); }
#pragma unroll
            for (int bj = 0; bj < 2; ++bj)
#pragma unroll
                for (int n = 0; n < 2; ++n) { const f32x4 y = acc[ai][bj][m][n] + scale * tb[it & 1][bj][n]; acc[ai][bj][m][n] = y;
                    s1 += (y[0] + y[1]) + (y[2] + y[3]); s2 += (y[0] * y[0] + y[1] * y[1]) + (y[2] * y[2] + y[3] * y[3]); }
            s1 += shx(s1, 16, lane); s2 += shx(s2, 16, lane); s1 += shx(s1, 32, lane); s2 += shx(s2, 32, lane);
            if (fq == 0) P[(ai * 128 + wr * 64 + m * 16 + fr) * 4 + wc] = (f32x2_t){s1, s2};
            __builtin_amdgcn_sched_barrier(0);
        }
        LDS_WAIT(); __builtin_amdgcn_s_barrier(); asm volatile("" ::: "memory");
        unsigned long long* slot = X + ((size_t)u.pm * 256 + (tid & 255)) * 4;
        if (tid < 256) { const f32x2_t a = P[tid * 4 + 0], b = P[tid * 4 + 1], c2 = P[tid * 4 + 2], d = P[tid * 4 + 3];
            const float t1 = (a.x + b.x) + (c2.x + d.x), t2 = (a.y + b.y) + (c2.y + d.y);
            __hip_atomic_store(slot + u.pn, ((unsigned long long)__float_as_uint(t2) << 32) | __float_as_uint(t1), __ATOMIC_RELAXED, __HIP_MEMORY_SCOPE_AGENT); }
        asm volatile("s_waitcnt vmcnt(0)" ::: "memory"); __builtin_amdgcn_s_barrier(); asm volatile("" ::: "memory");
        if (tid == 0) {
            __hip_atomic_fetch_add(cnt + u.pm * 16, 1u, __ATOMIC_RELAXED, __HIP_MEMORY_SCOPE_AGENT);
            unsigned sp = 0; while (__hip_atomic_load(cnt + u.pm * 16, __ATOMIC_RELAXED, __HIP_MEMORY_SCOPE_AGENT) < 4u) { __builtin_amdgcn_s_sleep(1); if (++sp > (1u << 22)) break; }
            __builtin_amdgcn_fence(__ATOMIC_ACQUIRE, "agent"); asm volatile("s_waitcnt vmcnt(0)" ::: "memory");
        }
        __builtin_amdgcn_s_barrier(); asm volatile("" ::: "memory");
        if (tid < 256) { float t1 = 0.f, t2 = 0.f;
#pragma unroll
            for (int j = 0; j < 4; ++j) { const unsigned long long v = __hip_atomic_load(slot + j, __ATOMIC_RELAXED, __HIP_MEMORY_SCOPE_AGENT); t1 += __uint_as_float((unsigned)v); t2 += __uint_as_float((unsigned)(v >> 32)); }
            const float mean = t1 * (1.f / D), var = fmaxf(t2 * (1.f / D) - mean * mean, 0.f);
            Sst[tid] = (f32x2_t){mean, __builtin_amdgcn_rsqf(var + LN_EPS)}; }
        LDS_WAIT(); __builtin_amdgcn_s_barrier(); asm volatile("" ::: "memory");
        f32x4 gg[2][2], bb[2][2];
#pragma unroll
        for (int bj = 0; bj < 2; ++bj)
#pragma unroll
            for (int n = 0; n < 2; ++n) { gg[bj][n] = *(const f32x4*)(g + col0 + bj * 128 + 4 * n); bb[bj][n] = *(const f32x4*)(bt + col0 + bj * 128 + 4 * n); }
        EPI_FOR_ROWS {
            const int row = EPI_ROW; const f32x2_t st = Sst[ai * 128 + wr * 64 + m * 16 + fr];
#pragma unroll
            for (int bj = 0; bj < 2; ++bj) { const size_t off = (size_t)row * 1024 + col0 + bj * 128;
                const f32x4 o0 = (acc[ai][bj][m][0] - st.x) * st.y * gg[bj][0] + bb[bj][0], o1 = (acc[ai][bj][m][1] - st.x) * st.y * gg[bj][1] + bb[bj][1];
                *(f32x4*)(trunk + off) = o0; *(f32x4*)(trunk + off + 4) = o1;
                *(u32x4*)(HB + off) = (u32x4){pk2(o0[0], o0[1]), pk2(o0[2], o0[3]), pk2(o1[0], o1[1]), pk2(o1[2], o1[3])}; }
            if (m & 1) __builtin_amdgcn_sched_barrier(0);
        }
    }
};
DI float dpp_ror1(float v) { return __int_as_float(__builtin_amdgcn_update_dpp(0, __float_as_int(v), 0x121, 0xf, 0xf, false)); }
DI float dpp_ror15(float v) { return __int_as_float(__builtin_amdgcn_update_dpp(0, __float_as_int(v), 0x12F, 0xf, 0xf, false)); }
constexpr size_t SIDE_STRIDE = 3 * DFF;
struct EpiUpG {
    static constexpr bool AFTER_DRAIN = false;
    bf16* ACT; float* SIDE; const float* fw; const float* fb; LAS float* xch;
    DI void operator()(EPI_ARGS) const {
        const int ch0 = u.pn * 128 + wc * 32 + 8 * fq;
        float w0[8], w1[8], w2[8], bb[8];
        { const f32x4 a0 = *(const f32x4*)(fw + ch0), a1 = *(const f32x4*)(fw + ch0 + 4), b0 = *(const f32x4*)(fw + DFF + ch0), b1 = *(const f32x4*)(fw + DFF + ch0 + 4),
                      c0 = *(const f32x4*)(fw + 2 * DFF + ch0), c1 = *(const f32x4*)(fw + 2 * DFF + ch0 + 4), d0 = *(const f32x4*)(fb + ch0), d1 = *(const f32x4*)(fb + ch0 + 4);
#pragma unroll
          for (int e = 0; e < 4; ++e) { w0[e] = a0[e]; w0[e + 4] = a1[e]; w1[e] = b0[e]; w1[e + 4] = b1[e]; w2[e] = c0[e]; w2[e + 4] = c1[e]; bb[e] = d0[e]; bb[e + 4] = d1[e]; } }
#pragma unroll
        for (int ai = 0; ai < 2; ++ai) { const int gi = 2 * ai + wr;
            if (fr == 0) { LAS float* p = xch + ((gi * 4 + wc) * 2 + 0) * 32 + 8 * fq; *(LAS f32x4*)p = acc[ai][0][0][0]; *(LAS f32x4*)(p + 4) = acc[ai][0][0][1]; }
            if (fr == 15) { LAS float* p = xch + ((gi * 4 + wc) * 2 + 1) * 32 + 8 * fq; *(LAS f32x4*)p = acc[ai][0][3][0]; *(LAS f32x4*)(p + 4) = acc[ai][0][3][1]; } }
        LDS_WAIT(); __builtin_amdgcn_s_barrier(); asm volatile("" ::: "memory");
        const bool seq_first = (u.pm & 7) == 0, seq_last = (u.pm & 7) == 7;
#pragma unroll
        for (int ai = 0; ai < 2; ++ai) { const int gi = 2 * ai + wr;
            float pf[8], nf[8];
#pragma unroll
            for (int e = 0; e < 8; ++e) { pf[e] = 0.f; nf[e] = 0.f; }
            if (gi > 0) { const LAS float* p = xch + (((gi - 1) * 4 + wc) * 2 + 1) * 32 + 8 * fq; const f32x4 a = *(const LAS f32x4*)p, b = *(const LAS f32x4*)(p + 4);
#pragma unroll
                for (int e = 0; e < 4; ++e) { pf[e] = a[e]; pf[e + 4] = b[e]; } }
            if (gi < 3) { const LAS float* p = xch + (((gi + 1) * 4 + wc) * 2 + 0) * 32 + 8 * fq; const f32x4 a = *(const LAS f32x4*)p, b = *(const LAS f32x4*)(p + 4);
#pragma unroll
                for (int e = 0; e < 4; ++e) { nf[e] = a[e]; nf[e + 4] = b[e]; } }
#pragma unroll
            for (int m = 0; m < 4; ++m) {
                const int row = EPI_ROW;
                float cv[8], o[8];
#pragma unroll
                for (int e = 0; e < 8; ++e) {
                    const float g = acc[ai][0][m][e >> 2][e & 3];
                    const float upn = dpp_ror1(g), dnn = dpp_ror15(g);
                    const float upe = (m > 0) ? dpp_ror1(acc[ai][0][m > 0 ? m - 1 : 0][e >> 2][e & 3]) : pf[e];
                    const float dne = (m < 3) ? dpp_ror15(acc[ai][0][m < 3 ? m + 1 : 3][e >> 2][e & 3]) : nf[e];
                    const float up = (fr == 0) ? upe : upn, dn = (fr == 15) ? dne : dnn;
                    cv[e] = bb[e] + w0[e] * up + w1[e] * g + w2[e] * dn;
                    o[e] = gelu_t(cv[e]) * acc[ai][1][m][e >> 2][e & 3];
                }
                *(u32x4*)(ACT + (size_t)row * DFF + ch0) = pack8(o);
                if (gi == 0 && m == 0 && fr == 0 && !seq_first) { float* sp = SIDE + ((size_t)u.pm * 2 + 0) * SIDE_STRIDE + ch0;
                    *(f32x4*)sp = (f32x4){cv[0], cv[1], cv[2], cv[3]}; *(f32x4*)(sp + 4) = (f32x4){cv[4], cv[5], cv[6], cv[7]};
                    *(f32x4*)(sp + DFF) = acc[ai][1][m][0]; *(f32x4*)(sp + DFF + 4) = acc[ai][1][m][1]; *(f32x4*)(sp + 2 * DFF) = acc[ai][0][m][0]; *(f32x4*)(sp + 2 * DFF + 4) = acc[ai][0][m][1]; }
                if (gi == 3 && m == 3 && fr == 15 && !seq_last) { float* sp = SIDE + ((size_t)u.pm * 2 + 1) * SIDE_STRIDE + ch0;
                    *(f32x4*)sp = (f32x4){cv[0], cv[1], cv[2], cv[3]}; *(f32x4*)(sp + 4) = (f32x4){cv[4], cv[5], cv[6], cv[7]};
                    *(f32x4*)(sp + DFF) = acc[ai][1][m][0]; *(f32x4*)(sp + DFF + 4) = acc[ai][1][m][1]; *(f32x4*)(sp + 2 * DFF) = acc[ai][0][m][0]; *(f32x4*)(sp + 2 * DFF + 4) = acc[ai][0][m][1]; }
                __builtin_amdgcn_sched_barrier(0);
            }
        }
    }
};
DI void geglu_fix(const int wid_s, bf16* ACT, const float* SIDE, const float* fw, const float* fb, int c, int G) {
    const int tid = get_tid(wid_s);
    for (int i = c * 512 + tid; i < 63 * (DFF / 4); i += G * 512) {
        const int pm = i / (DFF / 4), ch = (i % (DFF / 4)) * 4;
        if ((pm & 7) == 7) continue;
        const float* sl = SIDE + ((size_t)pm * 2 + 1) * SIDE_STRIDE + ch;
        const float* sf = SIDE + ((size_t)(pm + 1) * 2 + 0) * SIDE_STRIDE + ch;
        const f32x4 pl = *(const f32x4*)sl, vl = *(const f32x4*)(sl + DFF), gl = *(const f32x4*)(sl + 2 * DFF);
        const f32x4 pf = *(const f32x4*)sf, vf = *(const f32x4*)(sf + DFF), gf = *(const f32x4*)(sf + 2 * DFF);
        const f32x4 w0 = *(const f32x4*)(fw + ch), w2 = *(const f32x4*)(fw + 2 * DFF + ch);
        float ol[4], of[4];
#pragma unroll
        for (int e = 0; e < 4; ++e) { ol[e] = gelu_t(pl[e] + w2[e] * gf[e]) * vl[e]; of[e] = gelu_t(pf[e] + w0[e] * gl[e]) * vf[e]; }
        *(u32x2*)(ACT + (size_t)(pm * 256 + 255) * DFF + ch) = (u32x2){pk2(ol[0], ol[1]), pk2(ol[2], ol[3])};
        *(u32x2*)(ACT + (size_t)(pm * 256 + 256) * DFF + ch) = (u32x2){pk2(of[0], of[1]), pk2(of[2], of[3])};
    }
}
DI void ln_rows(const float* src, float* dstf, bf16* dstb, const float* g, const float* bt, int gw, int NGW, int lane) {
    for (int mrow = gw; mrow < M; mrow += NGW) {
        const f32x4* xr = (const f32x4*)(src + (size_t)mrow * D) + lane;
        f32x4 v[4]; float s = 0.f;
#pragma unroll
        for (int j = 0; j < 4; ++j) { v[j] = xr[64 * j]; s += (v[j].x + v[j].y) + (v[j].z + v[j].w); }
        const float mean = wave_sum(s, lane) * (1.f / D); float s2 = 0.f;
#pragma unroll
        for (int j = 0; j < 4; ++j) { v[j] = v[j] - mean; s2 += (v[j].x * v[j].x + v[j].y * v[j].y) + (v[j].z * v[j].z + v[j].w * v[j].w); }
        const float rstd = __builtin_amdgcn_rsqf(wave_sum(s2, lane) * (1.f / D) + LN_EPS);
        f32x4* of = (f32x4*)(dstf + (size_t)mrow * D) + lane; u32x2* ob = (u32x2*)(dstb + (size_t)mrow * D) + lane;
#pragma unroll
        for (int j = 0; j < 4; ++j) { const f32x4 gg = ((const f32x4*)g)[lane + 64 * j], bb = ((const f32x4*)bt)[lane + 64 * j];
            const f32x4 y = v[j] * rstd * gg + bb; of[64 * j] = y; ob[64 * j] = (u32x2){pk2(y.x, y.y), pk2(y.z, y.w)}; }
    }
}
DI void tr_item(const float* W, int N, bf16* WT, int ldt, int rowmode, int dup, LAS float* scr, int kb, int nb, int lane) {
    const int k0 = 64 * kb, n0 = 32 * nb;
#pragma unroll 8
    for (int i = 0; i < 32; ++i) { const int kk = 2 * i + (lane >> 5); scr[kk * 33 + (lane & 31)] = W[(size_t)(k0 + kk) * N + n0 + (lane & 31)]; }
    LDS_WAIT(); asm volatile("" ::: "memory");
    const int c = lane & 7;
#pragma unroll
    for (int j = 0; j < 4; ++j) { const int n = (lane >> 3) + 8 * j; const LAS float* s = scr + (8 * c) * 33 + n;
        u32x4 o; o.x = pk2(s[0 * 33], s[1 * 33]); o.y = pk2(s[2 * 33], s[3 * 33]); o.z = pk2(s[4 * 33], s[5 * 33]); o.w = pk2(s[6 * 33], s[7 * 33]);
        const int nn = n0 + n; const int row = rowmode == 0 ? nn : ((nn >> 7) * 256 + (rowmode - 1) * 128 + (nn & 127));
        *(u32x4*)(WT + (size_t)row * ldt + k0 + 8 * c) = o; if (dup) *(u32x4*)(WT + (size_t)row * ldt + 1024 + k0 + 8 * c) = o; }
    LDS_WAIT(); asm volatile("" ::: "memory");
}
struct InPtrs { const float* in[26]; };
typedef const __attribute__((address_space(4))) unsigned char* kptr_t;
#define INP(i) (*(const float* const __attribute__((address_space(4)))*)(kp + 8 * (i)))
enum { CJ_IN = 1, CJ_G = 2, CJ_PA = 4, CJ_PR = 8, CJ_O = 16, CJ_UP = 32, CJ_DN = 64, CJ_PLE = 128, CJ_PG = 256, CJ_P = 512, CJ_ALL = 1023 };
DI void convert_layer(kptr_t kp, unsigned char* ws, int l, int mask, LAS unsigned char* lds, int gw, int NGW, int wave, int lane) {
    LAS float* scr = (LAS float*)(lds + wave * 8448);
    bf16* Wb = (bf16*)(ws + WS_W);
    if (mask & CJ_IN) for (int r = gw; r < 16 * 176; r += NGW) tr_item(INP(4) + (size_t)l * D * DIN, DIN, Wb + W_IN, D, 0, 0, scr, r / 176, r % 176, lane);
    if (mask & CJ_G) for (int r = gw; r < 512; r += NGW) { const int x = r >> 8, rr = r & 255, g = rr >> 5, q = rr & 31;
        tr_item(INP(x ? 10 : 8) + ((size_t)l * 8 + g) * 65536, 256, Wb + W_G + (size_t)g * 512 * 256, 256, 1 + x, 0, scr, q / 8, q % 8, lane); }
    if (mask & CJ_PA) for (int r = gw; r < 512; r += NGW) tr_item(INP(13) + (size_t)l * D * D, D, Wb + W_PA, D, 0, 0, scr, r / 32, r % 32, lane);
    if (mask & CJ_PR) for (int r = gw; r < 512; r += NGW) tr_item(INP(14) + (size_t)l * D * D, D, Wb + W_PR, D, 0, 0, scr, r / 32, r % 32, lane);
    if (mask & CJ_O) for (int r = gw; r < 512; r += NGW) tr_item(INP(15) + (size_t)l * D * D, D, Wb + W_O, D, 0, 0, scr, r / 32, r % 32, lane);
    if (mask & CJ_UP) for (int r = gw; r < 16 * 192; r += NGW) { const int kb = r / 192, nb = r % 192, hf = nb >= 96;
        tr_item(INP(18) + (size_t)l * D * 2 * DFF + hf * DFF, 2 * DFF, Wb + W_UP, D, 1 + hf, 0, scr, kb, nb - hf * 96, lane); }
    if (mask & CJ_DN) for (int r = gw; r < 48 * 32; r += NGW) tr_item(INP(21) + (size_t)l * DFF * D, D, Wb + W_DN, DFF, 0, 0, scr, r / 32, r % 32, lane);
    if (mask & CJ_PLE) for (int r = gw; r < 4 * 32; r += NGW) tr_item(INP(22) + (size_t)l * DPLE * D, D, Wb + W_PLE, DPLE, 0, 0, scr, r / 32, r % 32, lane);
    if (mask & CJ_PG) for (int r = gw; r < 512; r += NGW) tr_item(INP(23) + (size_t)l * D * D, D, Wb + W_PG, D, 0, 0, scr, r / 32, r % 32, lane);
    if (mask & CJ_P) {
        const float* P = INP(1) + (size_t)l * M * DPLE; bf16* PB = (bf16*)(ws + WS_PB);
        for (size_t i = (size_t)gw * 64 + lane; i < (size_t)M * DPLE / 8; i += (size_t)NGW * 64) {
            const f32x4 a = ((const f32x4*)P)[2 * i], b = ((const f32x4*)P)[2 * i + 1];
            ((u32x4*)PB)[i] = (u32x4){pk2(a.x, a.y), pk2(a.z, a.w), pk2(b.x, b.y), pk2(b.z, b.w)};
        }
    }
}
DI void rope_table(float* rope, int gtid, int nthr) {
    for (int i = gtid; i < SEQ * 16; i += nthr) {
        const int pos = i >> 4, j = i & 15;
        const float inv = exp2f(-(float)j * (18.931568569324174f / 16.0f));
        const float ang = (float)pos * inv;
        const double rev = (double)ang * 0.15915494309189535; const float fr = (float)(rev - floor(rev));
        rope[2 * i] = __builtin_amdgcn_cosf(fr); rope[2 * i + 1] = __builtin_amdgcn_sinf(fr);
    }
}
DI void conv_phase(const int wid_s, const bf16* xr, bf16* XFB, const float* cw, const float* cb, int c, int G) {
    const int tid = get_tid(wid_s); const int cg8 = (tid & 127) * 8, sub = tid >> 7;
    for (int it = c; it < M / 32; it += G) {
        const int r0 = it * 32 + sub * 8; const int t0 = r0 & (SEQ - 1);
        u32x4 xin[14];
#pragma unroll
        for (int i = 0; i < 14; ++i) { const int t = t0 - 3 + i; xin[i] = (t >= 0 && t < SEQ) ? *(const u32x4*)(xr + (size_t)(r0 - 3 + i) * 1024 + cg8) : (u32x4){0u, 0u, 0u, 0u}; }
#pragma unroll
        for (int dir = 0; dir < 2; ++dir) {
            float w[4][8], b8[8];
#pragma unroll
            for (int k = 0; k < 4; ++k) { const f32x4 w0 = *(const f32x4*)(cw + (dir * 4 + k) * 1024 + cg8), w1 = *(const f32x4*)(cw + (dir * 4 + k) * 1024 + cg8 + 4);
                w[k][0] = w0.x; w[k][1] = w0.y; w[k][2] = w0.z; w[k][3] = w0.w; w[k][4] = w1.x; w[k][5] = w1.y; w[k][6] = w1.z; w[k][7] = w1.w; }
            { const f32x4 w0 = *(const f32x4*)(cb + dir * 1024 + cg8), w1 = *(const f32x4*)(cb + dir * 1024 + cg8 + 4);
                b8[0] = w0.x; b8[1] = w0.y; b8[2] = w0.z; b8[3] = w0.w; b8[4] = w1.x; b8[5] = w1.y; b8[6] = w1.z; b8[7] = w1.w; }
#pragma unroll
            for (int j = 0; j < 8; ++j) {
                float o[8];
#pragma unroll
                for (int e = 0; e < 8; ++e) o[e] = b8[e];
#pragma unroll
                for (int k = 0; k < 4; ++k) { float xv[8]; unpack8(xin[dir ? (j + 3 + k) : (j + 3 - k)], xv);
#pragma unroll
                    for (int e = 0; e < 8; ++e) o[e] += w[k][e] * xv[e]; }
                *(u32x4*)(XFB + ((size_t)dir * M + r0 + j) * 1024 + cg8) = pack8(o);
            }
        }
    }
}
DI void attn_phase(const int wid_s, LAS unsigned char* lds, const bf16* zq, const bf16* zk, const bf16* zv, bf16* att, const float* sink, int c, int G) {
    const int tid = get_tid(wid_s); const int w = wid_s, lane = tid & 63, l32 = lane & 31, h = lane >> 5;
    LAS unsigned char* Ks = lds;
    LAS unsigned char* Vt = lds + 34816;
    for (int L = c; L < 512; L += G) {
        const int it = (L & 7) * 64 + (L >> 3);
        const int pair = it & 1, kvh = (it >> 1) & 1, n = (it >> 2) & 15, b = it >> 6;
        const int hq = kvh * 4 + pair * 2 + (w >> 2);
        const int qrl = (w & 3) * 32 + l32;
        const size_t qrow = (size_t)b * SEQ + n * 128 + qrl;
        bf16x8 qf[8];
#pragma unroll
        for (int c8 = 0; c8 < 8; ++c8) qf[c8] = *(const bf16x8*)(zq + qrow * 1024 + hq * 128 + c8 * 16 + h * 8);
        float mrun = sink[hq] * LOG2E, lrun = 1.f;
        f32x16 o[4];
#pragma unroll
        for (int dd = 0; dd < 4; ++dd)
#pragma unroll
            for (int i = 0; i < 16; ++i) o[dd][i] = 0.f;
        for (int kc = 0; kc < 3; ++kc) {
            const int kb = n - 1 + kc; if (kb < 0 || kb > 15) continue;
            __syncthreads();
            const size_t krow0 = (size_t)b * SEQ + kb * 128;
#pragma unroll
            for (int i = 0; i < 4; ++i) { const int piece = tid + i * 512; const int r = piece >> 4, cc = piece & 15;
                const u32x4 kv = *(const u32x4*)(zk + (krow0 + r) * 256 + kvh * 128 + cc * 8);
                *(LAS u32x4*)(Ks + r * 272 + cc * 16) = kv; }
#pragma unroll
            for (int i = 0; i < 4; ++i) { const int piece = tid + i * 512; const int r = piece & 127, cc = piece >> 7;
                const u32x4 vv = *(const u32x4*)(zv + (krow0 + r) * 256 + kvh * 128 + cc * 8);
#pragma unroll
                for (int e = 0; e < 8; ++e) { const unsigned wv = vv[e >> 1]; *(LAS unsigned short*)(Vt + (cc * 8 + e) * 264 + r * 2) = (unsigned short)((e & 1) ? (wv >> 16) : (wv & 0xffffu)); } }
            __syncthreads();
            f32x16 s[4];
#pragma unroll
            for (int j = 0; j < 4; ++j) {
#pragma unroll
                for (int i = 0; i < 16; ++i) s[j][i] = 0.f;
#pragma unroll
                for (int c8 = 0; c8 < 8; ++c8) { const bf16x8 kf = *(const LAS bf16x8*)(Ks + (j * 32 + l32) * 272 + c8 * 32 + h * 16);
                    s[j] = __builtin_amdgcn_mfma_f32_32x32x16_bf16(kf, qf[c8], s[j], 0, 0, 0); }
            }
            if (kc != 1) {
                int hb = (kc == 0) ? (4 * h - qrl) : (qrl - 4 * h); asm volatile("" : "+v"(hb));
#pragma unroll
                for (int j = 0; j < 4; ++j)
#pragma unroll
                    for (int i = 0; i < 16; ++i) { const int ko = j * 32 + (i & 3) + 8 * (i >> 2); const int dlt = (kc == 0) ? (hb + ko) : (hb - ko); const unsigned t = (unsigned)(dlt >> 31);
                        s[j][i] = __uint_as_float((__float_as_uint(s[j][i]) & ~t) | (0xF149F2CAu & t)); }
            }
            float mx = -3e38f;
#pragma unroll
            for (int j = 0; j < 4; ++j)
#pragma unroll
                for (int i = 0; i < 16; ++i) mx = fmaxf(mx, s[j][i]);
            mx = fmaxf(mx, shx(mx, 32, lane));
            const float mnew = fmaxf(mrun, mx); const float alpha = __builtin_amdgcn_exp2f(mrun - mnew); mrun = mnew;
            float psum = 0.f;
#pragma unroll
            for (int j = 0; j < 4; ++j)
#pragma unroll
                for (int i = 0; i < 16; ++i) { const float p = __builtin_amdgcn_exp2f(s[j][i] - mnew); s[j][i] = p; psum += p; }
            psum += shx(psum, 32, lane);
            lrun = lrun * alpha + psum;
#pragma unroll
            for (int dd = 0; dd < 4; ++dd)
#pragma unroll
                for (int i = 0; i < 16; ++i) o[dd][i] *= alpha;
#pragma unroll
            for (int j = 0; j < 4; ++j)
#pragma unroll
                for (int s2 = 0; s2 < 2; ++s2) {
                    u32x4 pw; pw.x = pk2(s[j][8 * s2 + 0], s[j][8 * s2 + 1]); pw.y = pk2(s[j][8 * s2 + 2], s[j][8 * s2 + 3]); pw.z = pk2(s[j][8 * s2 + 4], s[j][8 * s2 + 5]); pw.w = pk2(s[j][8 * s2 + 6], s[j][8 * s2 + 7]);
                    const bf16x8 pf = __builtin_bit_cast(bf16x8, pw);
#pragma unroll
                    for (int dd = 0; dd < 4; ++dd) { const LAS unsigned char* vp = Vt + (dd * 32 + l32) * 264 + (j * 32 + 16 * s2 + 4 * h) * 2;
                        const u32x2 lo = *(const LAS u32x2*)vp, hi = *(const LAS u32x2*)(vp + 16);
                        const u32x4 vw = {lo.x, lo.y, hi.x, hi.y};
                        o[dd] = __builtin_amdgcn_mfma_f32_32x32x16_bf16(__builtin_bit_cast(bf16x8, vw), pf, o[dd], 0, 0, 0); }
                }
        }
        const float inv = __builtin_amdgcn_rcpf(lrun);
        bf16* op = att + qrow * 1024 + hq * 128;
#pragma unroll
        for (int dd = 0; dd < 4; ++dd)
#pragma unroll
            for (int i4 = 0; i4 < 4; ++i4) { const int d0 = dd * 32 + 8 * i4 + 4 * h;
                *(u32x2*)(op + d0) = (u32x2){pk2(o[dd][4 * i4] * inv, o[dd][4 * i4 + 1] * inv), pk2(o[dd][4 * i4 + 2] * inv, o[dd][4 * i4 + 3] * inv)}; }
    }
}
DI void scan_step8(const u32x4 lw, const u32x4 uw, const bool start, float (&H)[8], float (&P)[8]) {
    float la[8], ux[8]; unpack8(lw, la); unpack8(uw, ux);
#pragma unroll
    for (int e = 0; e < 8; ++e) { const float a = __builtin_amdgcn_exp2f(la[e]); const float mlt = start ? 1.f : __builtin_amdgcn_sqrtf(fmaxf(1.f - a * a, 0.f)); H[e] = a * H[e] + ux[e] * mlt; P[e] *= a; }
}
DI void scan_phase(const int wid_s, LAS unsigned char* lds, const bf16* LA, const bf16* U, const bf16* yr, bf16* HG, int c, int G) {
    const int tid = get_tid(wid_s); const int q = tid & 3, seg = tid >> 2;
    LAS float* sP = (LAS float*)lds;
    LAS float* sH = sP + 2 * 128 * 32;
    LAS float* sC = sH + 2 * 128 * 32;
    for (int L = c; L < 256; L += G) {
        const int it = (L & 7) * 32 + (L >> 3);
        const int b = it >> 5, ch = (it & 31) * 32 + q * 8;
        const size_t r0 = (size_t)b * SEQ + seg * 16;
        const bf16* laf = LA + r0 * 1024 + ch; const bf16* uxf = U + r0 * 1024 + ch;
        const bf16* lab = laf + (size_t)M * 1024; const bf16* uxb = uxf + (size_t)M * 1024;
        float Hf[8], Pf[8], Hb[8], Pb[8];
#pragma unroll
        for (int e = 0; e < 8; ++e) { Hf[e] = 0.f; Pf[e] = 1.f; Hb[e] = 0.f; Pb[e] = 1.f; }
#pragma unroll 1
        for (int j0 = 0; j0 < 16; j0 += 4) {
            u32x4 lf[4], uf[4], lb[4], ub[4];
#pragma unroll
            for (int j = 0; j < 4; ++j) { lf[j] = *(const u32x4*)(laf + (size_t)(j0 + j) * 1024); uf[j] = *(const u32x4*)(uxf + (size_t)(j0 + j) * 1024);
                lb[j] = *(const u32x4*)(lab + (size_t)(15 - j0 - j) * 1024); ub[j] = *(const u32x4*)(uxb + (size_t)(15 - j0 - j) * 1024); }
#pragma unroll
            for (int j = 0; j < 4; ++j) { scan_step8(lf[j], uf[j], (seg == 0) && (j0 + j == 0), Hf, Pf); scan_step8(lb[j], ub[j], (seg == 127) && (j0 + j == 0), Hb, Pb); }
        }
        __syncthreads();
#pragma unroll
        for (int e = 0; e < 8; ++e) { sP[(0 * 128 + seg) * 32 + q * 8 + e] = Pf[e]; sH[(0 * 128 + seg) * 32 + q * 8 + e] = Hf[e]; sP[(1 * 128 + seg) * 32 + q * 8 + e] = Pb[e]; sH[(1 * 128 + seg) * 32 + q * 8 + e] = Hb[e]; }
        __syncthreads();
        if (tid < 64) { const int dir = tid >> 5, cc = tid & 31; float C = 0.f;
            for (int s2 = 0; s2 < 128; ++s2) { const int sg = dir ? 127 - s2 : s2; sC[(dir * 128 + sg) * 32 + cc] = C; C = sP[(dir * 128 + sg) * 32 + cc] * C + sH[(dir * 128 + sg) * 32 + cc]; } }
        __syncthreads();
#pragma unroll
        for (int e = 0; e < 8; ++e) { Hf[e] = sC[(0 * 128 + seg) * 32 + q * 8 + e]; Hb[e] = sC[(1 * 128 + seg) * 32 + q * 8 + e]; }
        unsigned hfp[16][4];
#pragma unroll
        for (int j0 = 0; j0 < 16; j0 += 4) {
            u32x4 lf[4], uf[4];
#pragma unroll
            for (int j = 0; j < 4; ++j) { lf[j] = *(const u32x4*)(laf + (size_t)(j0 + j) * 1024); uf[j] = *(const u32x4*)(uxf + (size_t)(j0 + j) * 1024); }
#pragma unroll
            for (int j = 0; j < 4; ++j) { scan_step8(lf[j], uf[j], (seg == 0) && (j0 + j == 0), Hf, Pf);
                hfp[j0 + j][0] = pk2(Hf[0], Hf[1]); hfp[j0 + j][1] = pk2(Hf[2], Hf[3]); hfp[j0 + j][2] = pk2(Hf[4], Hf[5]); hfp[j0 + j][3] = pk2(Hf[6], Hf[7]); }
            __builtin_amdgcn_sched_barrier(0);
        }
        const bf16* yp = yr + r0 * 1024 + ch; bf16* hp = HG + r0 * 1024 + ch;
#pragma unroll
        for (int j0 = 0; j0 < 16; j0 += 4) {
            u32x4 lb[4], ub[4], yv[4];
#pragma unroll
            for (int j = 0; j < 4; ++j) { const int tt = 15 - j0 - j; lb[j] = *(const u32x4*)(lab + (size_t)tt * 1024); ub[j] = *(const u32x4*)(uxb + (size_t)tt * 1024); yv[j] = *(const u32x4*)(yp + (size_t)tt * 1024); }
#pragma unroll
            for (int j = 0; j < 4; ++j) { const int tt = 15 - j0 - j; scan_step8(lb[j], ub[j], (seg == 127) && (j0 + j == 0), Hb, Pb);
                float y[8], o[8]; unpack8(yv[j], y);
                const float hf[8] = {bflo(hfp[tt][0]), bfhi(hfp[tt][0]), bflo(hfp[tt][1]), bfhi(hfp[tt][1]), bflo(hfp[tt][2]), bfhi(hfp[tt][2]), bflo(hfp[tt][3]), bfhi(hfp[tt][3])};
#pragma unroll
                for (int e = 0; e < 8; ++e) o[e] = (hf[e] + Hb[e]) * gelu_t(y[e]);
                *(u32x4*)(hp + (size_t)tt * 1024) = pack8(o); }
            __builtin_amdgcn_sched_barrier(0);
        }
    }
}
#define XB_TMO      128
#define XB_XCNT(j)  (256  + 64 * (j))
#define XB_XSUB(j)  (1280 + 64 * (j))
#define XB_XGEN(j)  (2304 + 64 * (j))
#define XB_TOP      3328
#define XB_TOPGEN   3392
#define XCD_BAR_WORDS 3456
#define XB_SPIN_CAP (1u << 18)

__device__ __forceinline__ unsigned xb_ld(unsigned* p)              { return __hip_atomic_load(p, __ATOMIC_RELAXED, __HIP_MEMORY_SCOPE_AGENT); }
__device__ __forceinline__ unsigned xb_add(unsigned* p, unsigned v) { return __hip_atomic_fetch_add(p, v, __ATOMIC_RELAXED, __HIP_MEMORY_SCOPE_AGENT); }
__device__ __forceinline__ unsigned xb_xcc_id() { return (unsigned)__builtin_amdgcn_s_getreg((3 << 11) | 20) & 0xFu; }
#define XB_SPIN(cond, bar) do { unsigned _sp = 0; while (cond) { __builtin_amdgcn_s_sleep(1); \
    if ((++_sp & 255u) == 0u) { if (xb_ld(&(bar)[XB_TMO])) break; if (_sp > XB_SPIN_CAP) { atomicAdd(&(bar)[XB_TMO], 1u); break; } } } } while (0)

struct XcdBarrier {
    unsigned* bar; unsigned x;
    volatile LAS unsigned* st;
};

__device__ __forceinline__ XcdBarrier xcd_barrier_post(unsigned* bar, volatile LAS unsigned* st, int tid) {
    XcdBarrier b; b.bar = bar; b.x = xb_xcc_id(); b.st = st;
    if (tid == 0) (void)xb_add(&bar[XB_XCNT(b.x)], 1u);
    return b;
}
__device__ __forceinline__ void xcd_barrier_complete(unsigned* bar, unsigned x, unsigned& nloc, unsigned& nx) {
    const unsigned G = gridDim.x * gridDim.y * gridDim.z;
    unsigned sum, cnt, mine, sp = 0u;
    for (;;) {
        sum = 0u; cnt = 0u; mine = 0u;
#pragma unroll
        for (unsigned j = 0; j < 16; ++j) { const unsigned c = xb_ld(&bar[XB_XCNT(j)]); sum += c; cnt += (c > 0u) ? 1u : 0u; mine = (j == x) ? c : mine; }
        if (sum == G) break;
        __builtin_amdgcn_s_sleep(1);
        if ((++sp & 255u) == 0u) { if (xb_ld(&bar[XB_TMO])) break; if (sp > XB_SPIN_CAP) { atomicAdd(&bar[XB_TMO], 1u); break; } }
    }
    nloc = mine > 0u ? mine : 1u; nx = cnt > 0u ? cnt : 1u;
}

__device__ __forceinline__ void xcd_barrier(const XcdBarrier& b, int tid) {
    asm volatile("s_waitcnt vmcnt(0)" ::: "memory");
    __syncthreads();
    if (tid == 0) {
        unsigned* bar = b.bar;
        __builtin_amdgcn_s_waitcnt(0);
        unsigned nloc = b.st[0], nx = b.st[1];
        if (nloc == 0u) { xcd_barrier_complete(bar, b.x, nloc, nx); b.st[0] = nloc; b.st[1] = nx; }
        const unsigned old = xb_add(&bar[XB_XSUB(b.x)], 1u);
        const unsigned gen = old / nloc;
        if (old + 1u == (gen + 1u) * nloc) {
            __builtin_amdgcn_fence(__ATOMIC_RELEASE, "agent");
            asm volatile("s_waitcnt vmcnt(0)" ::: "memory");
            const unsigned og = xb_add(&bar[XB_TOP], 1u);
            const unsigned tg = og / nx;
            if (og + 1u == (tg + 1u) * nx) xb_add(&bar[XB_TOPGEN], 1u);
            else XB_SPIN(xb_ld(&bar[XB_TOPGEN]) == tg, bar);
            __builtin_amdgcn_fence(__ATOMIC_ACQUIRE, "agent");
            xb_add(&bar[XB_XGEN(b.x)], 1u);
            asm volatile("s_waitcnt vmcnt(0)" ::: "memory");
        } else {
            XB_SPIN(xb_ld(&bar[XB_XGEN(b.x)]) == gen, bar);
            __builtin_amdgcn_fence(__ATOMIC_ACQUIRE, "agent");
            asm volatile("s_waitcnt vmcnt(0)" ::: "memory");
        }
    }
    __syncthreads();
}

struct Args { InPtrs I; float* out; unsigned char* ws; int ph_lo, ph_hi; };
#ifndef ONLY
#define ONLY -1
#endif
#define CASE_ON(n) if constexpr (ONLY < 0 || ONLY == (n))
#ifndef PROBE_K
#define PROBE_K -1
#endif
constexpr int PH_PER_LAYER = 9 + (PROBE_K >= 0 ? 1 : 0), N_PHASES = 1 + DEPTH * PH_PER_LAYER;

__global__ void __launch_bounds__(512, 2) fwd_kernel(Args args) {
    extern __shared__ __attribute__((aligned(16))) unsigned char lds_raw[];
    LAS unsigned char* lds = (LAS unsigned char*)lds_raw;
    cg::grid_group grid = cg::this_grid();
    const int wid_s = __builtin_amdgcn_readfirstlane((int)threadIdx.x >> 6);
    XcdBarrier bar;
    {
        const int tid0 = get_tid(wid_s);
        unsigned* barw = (unsigned*)(args.ws + WS_BAR);
        volatile LAS unsigned* st = (volatile LAS unsigned*)(lds + 131072 + 64);
        if (blockIdx.x == 0) { for (int i = tid0; i < XCD_BAR_WORDS; i += 512) __hip_atomic_store(barw + i, 0u, __ATOMIC_RELAXED, __HIP_MEMORY_SCOPE_AGENT);
            unsigned* cw = (unsigned*)(args.ws + WS_CNT); for (int i = tid0; i < CNT_WORDS; i += 512) __hip_atomic_store(cw + i, 0u, __ATOMIC_RELAXED, __HIP_MEMORY_SCOPE_AGENT); }
        if (tid0 < 2) st[tid0] = 0u;
        __syncthreads();
        grid.sync();
        bar = xcd_barrier_post(barw, st, tid0);
    }
    for (int ph = args.ph_lo; ph < args.ph_hi; ++ph) {
        kptr_t kp = (kptr_t)__builtin_amdgcn_kernarg_segment_ptr(); asm volatile("" : "+s"(kp));
        float* trunk = *(float* const __attribute__((address_space(4)))*)(kp + 208);
        unsigned char* ws = *(unsigned char* const __attribute__((address_space(4)))*)(kp + 216);
        const int wave = wid_s;
        int G = gridDim.x, c = blockIdx.x; asm volatile("" : "+s"(G), "+s"(c));
        const int gw = c * 8 + wave, NGW = G * 8;
        float* rope = (float*)(ws + WS_ROPE);
        bf16* Wb = (bf16*)(ws + WS_W); bf16* PB = (bf16*)(ws + WS_PB); bf16* HB = (bf16*)(ws + WS_HB); bf16* Z = (bf16*)(ws + WS_Z);
        bf16* ATT = (bf16*)(ws + WS_ATT); bf16* XFB = (bf16*)(ws + WS_XFB); bf16* UB = (bf16*)(ws + WS_EXTRA); bf16* T = (bf16*)(ws + WS_EXTRA);
        bf16* LAb = Z; bf16* HG = XFB; bf16* ACT = Z; float* SIDE = (float*)(ws + WS_ATT);
        if (ph > args.ph_lo) { xcd_barrier(bar, get_tid(wid_s));
#ifdef PROBE_SYNC2
            xcd_barrier(bar, get_tid(wid_s));
#endif
        }
        if (ph == 0) { CASE_ON(100) {
            const int tid = get_tid(wid_s), lane = tid & 63;
            convert_layer(kp, ws, 0, CJ_ALL, lds, gw, NGW, wave, lane);
            ln_rows(INP(0), trunk, HB, INP(2), INP(3), gw, NGW, lane);
            rope_table(rope, c * 512 + tid, G * 512); }
            continue;
        }
        const int l = (ph - 1) / PH_PER_LAYER; int k = (ph - 1) % PH_PER_LAYER; if (PROBE_K >= 0 && k == 9) k = PROBE_K;
        switch (k) {
        case 0: CASE_ON(0) {
#ifndef PROBE_LITE
#define PROBE_LITE 0
#endif
            const bool rerun = (ph - 1) % PH_PER_LAYER == 9;
            pg8::TileOrder S; S.init(M, DIN, G, c, HB, D, Wb + W_IN, D);
            EpiIn E{Z, rope, rerun ? PROBE_LITE : 0};
            pg8::gemm_phase(lds, wid_s, D, D, S, E);
            {
                kptr_t kp2 = (kptr_t)__builtin_amdgcn_kernarg_segment_ptr(); int c2 = blockIdx.x, ph2 = ph; asm volatile("" : "+s"(kp2), "+s"(c2), "+s"(ph2));
                const int l2 = (ph2 - 1) / PH_PER_LAYER, k2 = (ph2 - 1) % PH_PER_LAYER;
                unsigned char* ws2 = *(unsigned char* const __attribute__((address_space(4)))*)(kp2 + 216);
                if (l2 > 0 && c2 >= 128 && k2 == 0) { kptr_t kp = kp2; convert_layer(kp, ws2, l2, CJ_ALL & ~CJ_IN, lds, (c2 - 128) * 8 + wid_s, 128 * 8, wid_s, get_tid(wid_s) & 63); }
            }
        } break;
        case 1: CASE_ON(1) {
            attn_phase(wid_s, lds, Z + Z_Q, Z + Z_K, Z + Z_V, ATT, INP(5) + l * NH, c, G);
            conv_phase(wid_s, Z + Z_XR, XFB, INP(6) + (size_t)l * 2 * 4 * D, INP(7) + (size_t)l * 2 * D, c, G);
            __syncthreads();
            if (l + 1 < DEPTH) convert_layer(kp, ws, l + 1, CJ_IN, lds, gw, NGW, wave, get_tid(wid_s) & 63);
        } break;
        case 2: CASE_ON(2) {
            pg8::GateOrder S{G, c, (const char*)XFB, (const char*)(Wb + W_G)};
            EpiGate E{XFB, LAb, UB, INP(9) + (size_t)l * 2 * D, INP(11) + (size_t)l * 2 * D, INP(12) + (size_t)l * 2 * D};
            pg8::gemm_phase(lds, wid_s, 256, 1024, S, E);
        } break;
        case 3: CASE_ON(3) {
            scan_phase(wid_s, lds, LAb, UB, Z + Z_GY, HG, c, G);
        } break;
        case 4: CASE_ON(4) {
            { pg8::TileOrder S; S.init(M, D, G, c, ATT, D, Wb + W_PA, D); EpiX<EP_PA> E{T, nullptr, Z + Z_SA, nullptr}; pg8::gemm_phase(lds, wid_s, D, D, S, E); }
            { pg8::TileOrder S; S.init(M, D, G, c, HG, D, Wb + W_PR, D); EpiX<EP_PR> E{T, nullptr, Z + Z_SR, HB}; pg8::gemm_phase(lds, wid_s, D, D, S, E); }
        } break;
        case 5: CASE_ON(5) {
            pg8::TileOrder S; S.init(M, D, G, c, HB, D, Wb + W_O, D);
            EpiLn E{trunk, HB, INP(16) + (size_t)l * D, INP(17) + (size_t)l * D, (unsigned long long*)(ws + WS_ATT + 16 * MiB), (unsigned*)(ws + WS_CNT) + (2 * l) * 1024, DN_ALPHA};
            pg8::gemm_phase(lds, wid_s, D, D, S, E);
        } break;
        case 6: CASE_ON(6) {
            pg8::TileOrder S; S.init(M, 2 * DFF, G, c, HB, D, Wb + W_UP, D);
            EpiUpG E{ACT, SIDE, INP(19) + (size_t)l * 3 * DFF, INP(20) + (size_t)l * DFF, (LAS float*)(lds + 131072 + 1024)};
            pg8::gemm_phase(lds, wid_s, D, D, S, E);
        } break;
        case 7: CASE_ON(7) {
            geglu_fix(wid_s, ACT, SIDE, INP(19) + (size_t)l * 3 * DFF, INP(20) + (size_t)l * DFF, c, G);
            { pg8::TileOrder S; S.init(M, D, G, c, PB, DPLE, Wb + W_PLE, DPLE); EpiX<EP_PLE1> E{T, nullptr, nullptr, nullptr}; pg8::gemm_phase(lds, wid_s, DPLE, DPLE, S, E); }
            { pg8::TileOrder S; S.init(M, D, G, c, HB, D, Wb + W_PG, D); EpiX<EP_PLE2> E{T, trunk, nullptr, nullptr}; pg8::gemm_phase(lds, wid_s, D, D, S, E); }
        } break;
        case 8: CASE_ON(8) {
            pg8::TileOrder S; S.init(M, D, G, c, ACT, DFF, Wb + W_DN, DFF);
            EpiLn E{trunk, HB, INP(24) + (size_t)l * D, INP(25) + (size_t)l * D, (unsigned long long*)(ws + WS_ATT + 16 * MiB), (unsigned*)(ws + WS_CNT) + (2 * l + 1) * 1024, 1.f};
            pg8::gemm_phase(lds, wid_s, DFF, DFF, S, E);
        } break;
        }
    }
}

extern "C" void kernel_launch(void* const* d_in, const int* in_sizes, int n_in, void* d_out, int out_size, void* d_ws, size_t ws_size, hipStream_t stream) {
    static int grid = 0;
    if (grid == 0) {
        if (n_in != 26 || out_size != M * D || ws_size < WS_END) { fprintf(stderr, "kernel_launch: unexpected sizes n_in %d out %d ws %zu\n", n_in, out_size, ws_size); grid = -1; return; }
        int dev = 0, cus = 0, per_cu = 0;
        hipGetDevice(&dev); hipDeviceGetAttribute(&cus, hipDeviceAttributeMultiprocessorCount, dev);
        if (hipFuncSetAttribute((const void*)fwd_kernel, hipFuncAttributeMaxDynamicSharedMemorySize, LDS_BYTES) != hipSuccess) { fprintf(stderr, "kernel_launch: hipFuncSetAttribute failed\n"); grid = -1; return; }
        hipOccupancyMaxActiveBlocksPerMultiprocessor(&per_cu, (const void*)fwd_kernel, 512, LDS_BYTES);
        (void)hipGetLastError();
        if (per_cu < 1) per_cu = 1;
        grid = cus * 1;
        if (grid > 256) grid = 256;
        if (grid != 256) { fprintf(stderr, "kernel_launch: needs a 256-CU device (one 256x256 unit per workgroup in the fused-LayerNorm phases)\n"); grid = -1; return; }
        fprintf(stderr, "kernel_launch: cus %d per_cu %d grid %d ws %zu\n", cus, per_cu, grid, ws_size);
    }
    if (grid < 0) return;
    Args a{};
    for (int i = 0; i < 26; ++i) a.I.in[i] = (const float*)d_in[i];
    a.out = (float*)d_out; a.ws = (unsigned char*)d_ws; a.ph_lo = 0; a.ph_hi = N_PHASES;
    void* kargs[] = {&a};
    hipError_t e = hipLaunchCooperativeKernel((const void*)fwd_kernel, dim3(grid), dim3(512), kargs, LDS_BYTES, stream);
    if (e != hipSuccess) fprintf(stderr, "kernel_launch: cooperative launch failed: %s\n", hipGetErrorString(e));
}
```

```cpp
#include <hip/hip_runtime.h>
#include <hip/hip_cooperative_groups.h>
#include <cstdio>
#include <cstdint>
namespace cg = cooperative_groups;

#define LAS __attribute__((address_space(3)))
#define DI __device__ __forceinline__
typedef unsigned short bf16;
typedef short bf16x8 __attribute__((ext_vector_type(8)));
typedef float f32x4 __attribute__((ext_vector_type(4)));
typedef float f32x16 __attribute__((ext_vector_type(16)));
typedef unsigned u32x4 __attribute__((ext_vector_type(4)));
typedef unsigned u32x2 __attribute__((ext_vector_type(2)));
typedef __bf16 bf16x2_t __attribute__((ext_vector_type(2)));
typedef float f32x2_t __attribute__((ext_vector_type(2)));

constexpr int BATCH = 8, SEQ = 2048, D = 1024, DEPTH = 4, M = BATCH * SEQ;
constexpr int NH = 8, NKV = 2, HD = 128, DIN = 5632, DFF = 3072, DPLE = 256;
constexpr float LN_EPS = 1e-5f;
constexpr float DN_ALPHA = 1.6817928305074290f;
constexpr float LOG2E = 1.4426950408889634f;
constexpr float QSCALE = 0.08838834764831845f * LOG2E;

constexpr size_t MiB = 1u << 20;
constexpr size_t WS_ROPE = 0;
constexpr size_t WS_BAR = 512 * 1024;
constexpr size_t WS_CNT = 512 * 1024 + 65536;
constexpr int CNT_WORDS = 8 * 64 * 16;
constexpr size_t WS_W = 1 * MiB;
constexpr size_t W_IN = 0, W_G = W_IN + (size_t)DIN * D, W_PA = W_G + 8 * 512 * 256, W_PR = W_PA + (size_t)D * D, W_O = W_PR + (size_t)D * 2 * D,
                 W_UP = W_O + (size_t)D * D, W_DN = W_UP + (size_t)2 * DFF * D, W_PLE = W_DN + (size_t)D * DFF, W_PG = W_PLE + (size_t)D * DPLE, W_END = W_PG + (size_t)D * D;
static_assert(W_END * 2 <= 42 * MiB, "weights");
constexpr size_t WS_PB = WS_W + 42 * MiB;
constexpr size_t WS_HB = WS_PB + 8 * MiB;
constexpr size_t WS_Z = WS_HB + 32 * MiB;
constexpr size_t WS_ATT = WS_Z + 176 * MiB;
constexpr size_t WS_XFB = WS_ATT + 32 * MiB;
constexpr size_t WS_EXTRA = WS_XFB + 64 * MiB;
constexpr size_t WS_END = WS_EXTRA + 64 * MiB;
static_assert(WS_END <= 440 * MiB, "ws");
constexpr size_t Z_Q = 0, Z_K = (size_t)M * 1024, Z_V = (size_t)M * 1280, Z_XR = (size_t)M * 1536, Z_GY = (size_t)M * 2560, Z_SA = (size_t)M * 3584, Z_SR = (size_t)M * 4608;

constexpr int LDS_BYTES = 139264;

DI unsigned pk2(float lo, float hi) { f32x2_t v = {lo, hi}; bf16x2_t b = __builtin_convertvector(v, bf16x2_t); return __builtin_bit_cast(unsigned, b); }
DI float bflo(unsigned u) { return __uint_as_float(u << 16); }
DI float bfhi(unsigned u) { return __uint_as_float(u & 0xffff0000u); }
DI float sigm(float x) { return __builtin_amdgcn_rcpf(1.f + __builtin_amdgcn_exp2f(-LOG2E * x)); }
DI float gelu_t(float x) { const float u = 0.7978845608028654f * (x + 0.044715f * x * x * x); return x * sigm(2.f * u); }
DI void unpack8(const u32x4 w, float (&v)[8]) { v[0] = bflo(w.x); v[1] = bfhi(w.x); v[2] = bflo(w.y); v[3] = bfhi(w.y); v[4] = bflo(w.z); v[5] = bfhi(w.z); v[6] = bflo(w.w); v[7] = bfhi(w.w); }
DI u32x4 pack8(const float (&v)[8]) { u32x4 w; w.x = pk2(v[0], v[1]); w.y = pk2(v[2], v[3]); w.z = pk2(v[4], v[5]); w.w = pk2(v[6], v[7]); return w; }
DI float shx(float v, int mask, int lane) { return __int_as_float(__builtin_amdgcn_ds_bpermute((lane ^ mask) << 2, __float_as_int(v))); }
DI float wave_sum(float v, int lane) {
#pragma unroll
    for (int o = 1; o < 64; o <<= 1) v += shx(v, o, lane);
    return v;
}
DI int get_tid(int wid_s) { int l; asm volatile("v_mbcnt_lo_u32_b32 %0, -1, 0\n\tv_mbcnt_hi_u32_b32 %0, -1, %0" : "=v"(l)); return wid_s * 64 + l; }
#define LDS_WAIT() asm volatile("s_waitcnt lgkmcnt(0)" ::: "memory")

namespace pg8 {
constexpr int BM = 256, BK = 64, HALF = 128, HTB = HALF * BK * 2, NXCD = 8, WGM = 8;
DI int lds_byte(int r, int c) { const int st = (r >> 4) * 2 + (c >> 5), rr = r & 15, cc = c & 31, ob = rr * 64 + cc * 2; return st * 1024 + (ob ^ (((ob >> 9) & 1) << 5)); }
DI void stage_rc(int b, int& R, int& C) { const int st = b / 1024, sb = b % 1024, swz = sb ^ (((sb >> 9) & 1) << 5); R = (st >> 1) * 16 + swz / 64; C = (st & 1) * 32 + (swz % 64) / 2; }
DI int perm32(int rho) { const int n = rho >> 4, i = rho & 15; return 8 * (i >> 2) + 4 * n + (i & 3); }
struct Unit { int pm, pn, g; };

struct TileOrder {
    int nM, nN, nwg, G, c; const char* Ab; const char* Bb; size_t atile, btile;
    DI void init(int Mr, int N, int G_, int c_, const void* A, int lda, const void* Bt, int K) { nM = Mr / BM; nN = N / BM; nwg = nM * nN; G = G_; c = c_; Ab = (const char*)A; Bb = (const char*)Bt; atile = (size_t)BM * lda * 2; btile = (size_t)BM * K * 2; }
    DI bool next(int i, Unit& u) const {
        const int L = i * G + c; if (L >= nwg) return false;
        int wgid = L; { const int q = nwg / NXCD, r = nwg % NXCD, xcd = wgid % NXCD, off = wgid / NXCD; wgid = (xcd < r ? xcd * (q + 1) : r * (q + 1) + (xcd - r) * q) + off; }
        const int nig = WGM * nN, gid = wgid / nig, fm = gid * WGM, gsz = (nM - fm) < WGM ? (nM - fm) : WGM;
        u.pm = fm + ((wgid % nig) % gsz); u.pn = (wgid % nig) / gsz; u.g = 0; return true;
    }
    DI const char* A(const Unit& u) const { return Ab + (size_t)u.pm * atile; }
    DI const char* B(const Unit& u) const { return Bb + (size_t)u.pn * btile; }
};
struct GateOrder {
    int G, c; const char* Ab; const char* Bb;
    DI bool next(int i, Unit& u) const {
        const int L = i * G + c; if (L >= 1024) return false;
        const int id = (L & 7) * 128 + (L >> 3); u.g = id >> 7; u.pm = (id & 127) >> 1; u.pn = id & 1; return true;
    }
    DI const char* A(const Unit& u) const { const int dir = u.g >> 2, blk = u.g & 3; return Ab + (((size_t)dir * M + (size_t)u.pm * 256) * 1024 + blk * 256) * 2; }
    DI const char* B(const Unit& u) const { return Bb + ((size_t)u.g * 512 + u.pn * 256) * 256 * 2; }
};

template <class Epi, class Sched>
DI void gemm_phase(LAS unsigned char* lds, const int wid_s, const int K, const int lda, const Sched& S, const Epi& E) {
    int tid_ = get_tid(wid_s);
    const int tid = tid_, wid = __builtin_amdgcn_readfirstlane(tid >> 6), lane = tid & 63, wr = wid >> 2, wc = wid & 3, fr = lane & 15, fq = lane >> 4;
    const int nt = K / BK;
    unsigned voffA[2], voffB[2];
#pragma unroll
    for (int i = 0; i < 2; ++i) { int R, C; stage_rc(tid * 16 + i * 8192, R, C); const int Rb = (R & ~31) + perm32(R & 31);
        voffA[i] = (unsigned)(R * lda + C) * 2u; voffB[i] = (unsigned)(Rb * K + C) * 2u; }
    const size_t kstep = (size_t)(BK * 2);
    const size_t hstepA = (size_t)HALF * lda * 2, hstepB = (size_t)HALF * K * 2;
    const unsigned ldsw = (unsigned)wid * 1024u;
    const int aoff = lds_byte(wr * 64 + fr, fq * 8), boff = lds_byte(wc * 32 + fr, fq * 8);
#define PG8_SA(b, h) (((b) * 2 + (h)) * HTB)
#define PG8_SB(b, h) ((4 + (b) * 2 + (h)) * HTB)
#define PG8_STAGE(bufoff, gbase, voff) do { _Pragma("unroll") for (int _i = 0; _i < 2; ++_i) \
        __builtin_amdgcn_global_load_lds((const unsigned*)((const char*)(gbase) + (voff)[_i]), (LAS unsigned*)(lds + (bufoff) + ldsw + _i * 8192), 16, 0, 0); } while (0)
#define PG8_LDA(dst, b, h) do { _Pragma("unroll") for (int m = 0; m < 4; ++m) _Pragma("unroll") for (int k = 0; k < 2; ++k) dst[m][k] = *(const LAS bf16x8*)(lds + PG8_SA(b, h) + aoff + m * 2048 + k * 1024); } while (0)
#define PG8_LDB(dst, b, h) do { _Pragma("unroll") for (int n = 0; n < 2; ++n) _Pragma("unroll") for (int k = 0; k < 2; ++k) dst[n][k] = *(const LAS bf16x8*)(lds + PG8_SB(b, h) + boff + n * 2048 + k * 1024); } while (0)
#define PG8_MMA(ai, bj, At, Bt) do { __builtin_amdgcn_s_setprio(1); _Pragma("unroll") for (int m = 0; m < 4; ++m) _Pragma("unroll") for (int n = 0; n < 2; ++n) _Pragma("unroll") for (int k = 0; k < 2; ++k) \
        acc[ai][bj][m][n] = __builtin_amdgcn_mfma_f32_16x16x32_bf16(Bt[n][k], At[m][k], acc[ai][bj][m][n], 0, 0, 0); __builtin_amdgcn_s_setprio(0); } while (0)
#define PG8_WAIT_V(n) asm volatile("s_waitcnt vmcnt(" #n ")" ::: "memory")
#define PG8_WAIT_L(n) asm volatile("s_waitcnt lgkmcnt(" #n ")" ::: "memory")
#define PG8_BAR __builtin_amdgcn_s_barrier()
#define PG8_SCHED __builtin_amdgcn_sched_barrier(0)
    PG8_SCHED;
    Unit cur, nxt; int ui = 0;
    if (!S.next(0, cur)) return;
    f32x4 acc[2][2][4][2];
#pragma unroll
    for (int a = 0; a < 2; ++a)
#pragma unroll
        for (int b = 0; b < 2; ++b)
#pragma unroll
            for (int m = 0; m < 4; ++m)
#pragma unroll
                for (int n = 0; n < 2; ++n) acc[a][b][m][n] = (f32x4){0.f, 0.f, 0.f, 0.f};
    bf16x8 At[4][2], B0[2][2], B1[2][2];
    const char* cA = S.A(cur); const char* cB = S.B(cur);
    PG8_STAGE(PG8_SB(0, 0), cB, voffB); PG8_STAGE(PG8_SB(0, 1), cB + hstepB, voffB); PG8_STAGE(PG8_SA(0, 0), cA, voffA); PG8_STAGE(PG8_SA(0, 1), cA + hstepA, voffA);
    if (wr == 1) PG8_BAR;
    PG8_WAIT_V(2); PG8_BAR;
    PG8_STAGE(PG8_SB(1, 0), cB + kstep, voffB); PG8_STAGE(PG8_SA(1, 0), cA + kstep, voffA); PG8_STAGE(PG8_SB(1, 1), cB + hstepB + kstep, voffB);
    PG8_WAIT_V(6); PG8_BAR;
    for (;;) {
        const bool has_next = S.next(ui + 1, nxt);
        const char* nA = has_next ? S.A(nxt) : cA; const char* nB = has_next ? S.B(nxt) : cB;
#pragma unroll 1
        for (int t = 0; t < nt; t += 2) {
            const bool last = (t == nt - 2);
            const char* a1 = cA + (size_t)(t + 1) * kstep;
            const char* a2 = last ? nA : cA + (size_t)(t + 2) * kstep; const char* b2 = last ? nB : cB + (size_t)(t + 2) * kstep;
            const char* a3 = a2 + kstep; const char* b3 = b2 + kstep;
            PG8_LDB(B0, 0, 0); PG8_LDB(B1, 0, 1); PG8_SCHED; PG8_LDA(At, 0, 0); PG8_STAGE(PG8_SA(1, 1), a1 + hstepA, voffA);
            PG8_WAIT_V(8); PG8_WAIT_L(0); PG8_BAR; PG8_MMA(0, 0, At, B0); PG8_MMA(0, 1, At, B1); PG8_BAR; PG8_SCHED;
            PG8_LDA(At, 0, 1); PG8_STAGE(PG8_SB(0, 0), b2, voffB); PG8_STAGE(PG8_SB(0, 1), b2 + hstepB, voffB); PG8_STAGE(PG8_SA(0, 0), a2, voffA);
            PG8_WAIT_V(8); PG8_WAIT_L(0); PG8_BAR; PG8_MMA(1, 0, At, B0); PG8_MMA(1, 1, At, B1); PG8_BAR; PG8_SCHED;
            PG8_LDB(B0, 1, 0); PG8_LDB(B1, 1, 1); PG8_SCHED; PG8_LDA(At, 1, 0); PG8_STAGE(PG8_SA(0, 1), a2 + hstepA, voffA);
            PG8_WAIT_V(8); PG8_WAIT_L(0); PG8_BAR; PG8_MMA(0, 0, At, B0); PG8_MMA(0, 1, At, B1); PG8_BAR; PG8_SCHED;
            PG8_LDA(At, 1, 1); PG8_STAGE(PG8_SB(1, 0), b3, voffB); PG8_STAGE(PG8_SB(1, 1), b3 + hstepB, voffB); PG8_STAGE(PG8_SA(1, 0), a3, voffA);
            PG8_WAIT_V(8); PG8_WAIT_L(0); PG8_BAR; PG8_MMA(1, 0, At, B0); PG8_MMA(1, 1, At, B1); PG8_BAR; PG8_SCHED;
        }
        if (wr == 0) PG8_BAR;
        if constexpr (!Epi::AFTER_DRAIN) E(acc, cur, wr, wc, fr, fq);
        if (!has_next) break;
#pragma unroll
        for (int a = 0; a < 2; ++a)
#pragma unroll
            for (int b = 0; b < 2; ++b)
#pragma unroll
                for (int m = 0; m < 4; ++m)
#pragma unroll
                    for (int n = 0; n < 2; ++n) acc[a][b][m][n] = (f32x4){0.f, 0.f, 0.f, 0.f};
        cur = nxt; cA = nA; cB = nB; ++ui;
        if (wr == 1) PG8_BAR;
    }
    PG8_WAIT_V(0);
    PG8_BAR;
    PG8_SCHED;
    if constexpr (Epi::AFTER_DRAIN) E.fused(acc, cur, wr, wc, fr, fq, lds, tid);
#undef PG8_SA
#undef PG8_SB
#undef PG8_STAGE
#undef PG8_LDA
#undef PG8_LDB
#undef PG8_MMA
#undef PG8_WAIT_V
#undef PG8_WAIT_L
#undef PG8_BAR
#undef PG8_SCHED
}
}
using pg8::Unit;
typedef f32x4 AccT[2][2][4][2];
#define EPI_ARGS const f32x4 (&acc)[2][2][4][2], const Unit& u, int wr, int wc, int fr, int fq
#define EPI_FOR_ROWS _Pragma("unroll") for (int ai = 0; ai < 2; ++ai) _Pragma("unroll") for (int m = 0; m < 4; ++m)
#define EPI_ROW (u.pm * 256 + ai * 128 + wr * 64 + m * 16 + fr)
#define EPI_V8(bj) { acc[ai][bj][m][0][0], acc[ai][bj][m][0][1], acc[ai][bj][m][0][2], acc[ai][bj][m][0][3], acc[ai][bj][m][1][0], acc[ai][bj][m][1][1], acc[ai][bj][m][1][2], acc[ai][bj][m][1][3] }

struct EpiIn {
    static constexpr bool AFTER_DRAIN = false;
    bf16* Z; const float* rope; int lite;
    template <int MODE> DI void rows(EPI_ARGS, size_t base, int ldc, int colt, float qs) const {
        EPI_FOR_ROWS {
            const int row = EPI_ROW;
            bf16* rowp = Z + base + (size_t)row * ldc + colt + wc * 32 + 8 * fq;
            f32x4 c0, c1;
            if constexpr (MODE == 4) { const f32x4* rp = (const f32x4*)(rope + ((row & (SEQ - 1)) * 16 + 4 * fq) * 2); c0 = rp[0]; c1 = rp[1]; }
#pragma unroll
            for (int bj = 0; bj < 2; ++bj) {
                float v[8] = EPI_V8(bj);
                if constexpr (MODE == 4) {
                    const float cc[4] = {c0[0], c0[2], c1[0], c1[2]}, ss[4] = {c0[1], c0[3], c1[1], c1[3]};
#pragma unroll
                    for (int e = 0; e < 4; ++e) { const float x1 = v[e], x2 = v[e + 4]; v[e] = (x1 * cc[e] - x2 * ss[e]) * qs; v[e + 4] = (x2 * cc[e] + x1 * ss[e]) * qs; }
                } else if constexpr (MODE == 0) {
#pragma unroll
                    for (int e = 0; e < 8; ++e) v[e] *= qs;
                } else if constexpr (MODE == 3) {
#pragma unroll
                    for (int e = 0; e < 8; ++e) v[e] = sigm(v[e]);
                }
                *(u32x4*)(rowp + bj * 128) = pack8(v);
            }
        }
    }
    DI void operator()(EPI_ARGS) const {
        if (lite == 2) return;
        const int pn = u.pn; size_t base; int ldc, colt, mode;
        if (pn < 4) { base = Z_Q; ldc = 1024; colt = pn * 256; mode = 0; }
        else if (pn == 4) { base = Z_K; ldc = 256; colt = 0; mode = 0; }
        else if (pn == 5) { base = Z_V; ldc = 256; colt = 0; mode = 1; }
        else { const int arr = (pn - 6) >> 2; base = (size_t)M * (1536 + 1024 * arr); ldc = 1024; colt = ((pn - 6) & 3) * 256; mode = arr <= 1 ? 1 : 3; }
        if (lite == 1) mode = 1;
        const float qs = pn < 4 ? QSCALE : 1.f;
        if (mode == 0 && wc == 0) rows<4>(acc, u, wr, wc, fr, fq, base, ldc, colt, qs);
        else if (mode == 0) { if (pn < 4) rows<0>(acc, u, wr, wc, fr, fq, base, ldc, colt, qs); else rows<1>(acc, u, wr, wc, fr, fq, base, ldc, colt, qs); }
        else if (mode == 3) rows<3>(acc, u, wr, wc, fr, fq, base, ldc, colt, qs);
        else rows<1>(acc, u, wr, wc, fr, fq, base, ldc, colt, qs);
    }
};
struct EpiGate {
    static constexpr bool AFTER_DRAIN = false;
    const bf16* XFB; bf16* LA; bf16* U; const float* b_a; const float* b_x; const float* lam;
    DI void operator()(EPI_ARGS) const {
        const int dir = u.g >> 2, blk = u.g & 3;
        const int ch0 = blk * 256 + u.pn * 128 + wc * 32 + 8 * fq;
        float ba[8], bx[8], cl[8];
#pragma unroll
        for (int e = 0; e < 8; ++e) { ba[e] = -LOG2E * b_a[dir * 1024 + ch0 + e]; bx[e] = -LOG2E * b_x[dir * 1024 + ch0 + e];
            const float l = lam[dir * 1024 + ch0 + e]; cl[e] = -8.f * __builtin_amdgcn_logf(1.f + __builtin_amdgcn_exp2f(-LOG2E * l)); }
        u32x4 xw[2][4];
        EPI_FOR_ROWS xw[ai][m] = *(const u32x4*)(XFB + ((size_t)dir * M + EPI_ROW) * 1024 + ch0);
        EPI_FOR_ROWS {
            const int row = EPI_ROW;
            const size_t off = ((size_t)dir * M + row) * 1024 + ch0;
            float x[8]; unpack8(xw[ai][m], x);
            const float va[8] = EPI_V8(0); const float vx[8] = EPI_V8(1);
            float la[8], uu[8];
#pragma unroll
            for (int e = 0; e < 8; ++e) {
                const float ea = 1.f + __builtin_amdgcn_exp2f(fminf(-LOG2E * va[e] + ba[e], 60.f)), ex = 1.f + __builtin_amdgcn_exp2f(fminf(-LOG2E * vx[e] + bx[e], 60.f));
                const float r = __builtin_amdgcn_rcpf(ea * ex);
                la[e] = (r * ex) * cl[e]; uu[e] = x[e] * (r * ea); }
            *(u32x4*)(LA + off) = pack8(la); *(u32x4*)(U + off) = pack8(uu);
            __builtin_amdgcn_sched_barrier(0);
        }
    }
};
enum { EP_PA = 0, EP_PR, EP_PLE1, EP_PLE2 };
template <int MODE> struct EpiX {
    static constexpr bool AFTER_DRAIN = false;
    bf16* Tb;
    float* TR;
    const bf16* S;
    bf16* O;
    struct RowIn { u32x4 t[2]; f32x4 r[2][2]; u32x4 s[2]; };
    DI void load(RowIn& in, size_t off0) const {
#pragma unroll
        for (int bj = 0; bj < 2; ++bj) { const size_t off = off0 + bj * 128;
            if constexpr (MODE == EP_PA || MODE == EP_PR) in.s[bj] = *(const u32x4*)(S + off);
            if constexpr (MODE == EP_PR || MODE == EP_PLE2) in.t[bj] = *(const u32x4*)(Tb + off);
            if constexpr (MODE == EP_PLE2) { in.r[bj][0] = *(const f32x4*)(TR + off); in.r[bj][1] = *(const f32x4*)(TR + off + 4); } }
    }
    DI void operator()(EPI_ARGS) const {
        const size_t base = (size_t)(u.pm * 256 + wr * 64 + fr) * 1024 + u.pn * 256 + wc * 32 + 8 * fq;
        RowIn buf[2];
        if constexpr (MODE == EP_PR || MODE == EP_PLE2 || MODE == EP_PA) load(buf[0], base);
#pragma unroll
        for (int it = 0; it < 8; ++it) {
            const int ai = it >> 2, m = it & 3;
            const size_t off0 = base + (size_t)(ai * 128 + m * 16) * 1024;
            if constexpr (MODE != EP_PLE1) { if (it + 1 < 8) load(buf[(it + 1) & 1], base + (size_t)(((it + 1) >> 2) * 128 + ((it + 1) & 3) * 16) * 1024); }
            const RowIn& in = buf[it & 1];
#pragma unroll
            for (int bj = 0; bj < 2; ++bj) {
                const size_t off = off0 + bj * 128;
                float v[8] = EPI_V8(bj);
                if constexpr (MODE == EP_PA) { float sg[8]; unpack8(in.s[bj], sg);
#pragma unroll
                    for (int e = 0; e < 8; ++e) v[e] *= sg[e];
                    *(u32x4*)(Tb + off) = pack8(v); }
                if constexpr (MODE == EP_PR) { float sg[8], t[8]; unpack8(in.s[bj], sg); unpack8(in.t[bj], t);
#pragma unroll
                    for (int e = 0; e < 8; ++e) v[e] = t[e] + v[e] * sg[e];
                    *(u32x4*)(O + off) = pack8(v); }
                if constexpr (MODE == EP_PLE1) { *(u32x4*)(Tb + off) = pack8(v); }
                if constexpr (MODE == EP_PLE2) { float p[8]; unpack8(in.t[bj], p); const f32x4 t0 = in.r[bj][0], t1 = in.r[bj][1];
                    *(f32x4*)(TR + off) = (f32x4){DN_ALPHA * t0[0] + sigm(v[0]) * p[0], DN_ALPHA * t0[1] + sigm(v[1]) * p[1], DN_ALPHA * t0[2] + sigm(v[2]) * p[2], DN_ALPHA * t0[3] + sigm(v[3]) * p[3]};
                    *(f32x4*)(TR + off + 4) = (f32x4){DN_ALPHA * t1[0] + sigm(v[4]) * p[4], DN_ALPHA * t1[1] + sigm(v[5]) * p[5], DN_ALPHA * t1[2] + sigm(v[6]) * p[6], DN_ALPHA * t1[3] + sigm(v[7]) * p[7]}; }
            }
            if constexpr (MODE != EP_PLE1) __builtin_amdgcn_sched_barrier(0);
        }
    }
};
struct EpiLn {
    static constexpr bool AFTER_DRAIN = true;
    float* trunk; bf16* HB; const float* g; const float* bt; unsigned long long* X; unsigned* cnt; float scale;
    DI void operator()(EPI_ARGS) const {}
    DI void fused(f32x4 (&acc)[2][2][4][2], const Unit& u, int wr, int wc, int fr, int fq, LAS unsigned char* lds, int tid) const {
        LAS f32x2_t* P = (LAS f32x2_t*)lds;
        LAS f32x2_t* Sst = (LAS f32x2_t*)(lds + 8192);
        const int lane = fq * 16 + fr;
        const int col0 = u.pn * 256 + wc * 32 + 8 * fq;
        const float* tbase = trunk + (size_t)(u.pm * 256 + wr * 64 + fr) * 1024 + col0;
        f32x4 tb[2][2][2];
#pragma unroll
        for (int bj = 0; bj < 2; ++bj)
#pragma unroll
            for (int n = 0; n < 2; ++n) tb[0][bj][n] = *(const f32x4*)(tbase + bj * 128 + 4 * n);
#pragma unroll
        for (int it = 0; it < 8; ++it) {
            const int ai = it >> 2, m = it & 3; float s1 = 0.f, s2 = 0.f;
            if (it + 1 < 8) { const float* tp = tbase + (size_t)(((it + 1) >> 2) * 128 + ((it + 1) & 3) * 16) * 1024;
#pragma unroll
                for (int bj = 0; bj < 2; ++bj)
#pragma unroll
                    for (int n = 0; n < 2; ++n) tb[(it + 1) & 1][bj][n] = *(const f32x4*)(tp + bj * 128 + 4 * n); }
#pragma unroll
            for (int bj = 0; bj < 2; ++bj)
#pragma unroll
                for (int n = 0; n < 2; ++n) { const f32x4 y = acc[ai][bj][m][n] + scale * tb[it & 1][bj][n]; acc[ai][bj][m][n] = y;
                    s1 += (y[0] + y[1]) + (y[2] + y[3]); s2 += (y[0] * y[0] + y[1] * y[1]) + (y[2] * y[2] + y[3] * y[3]); }
            s1 += shx(s1, 16, lane); s2 += shx(s2, 16, lane); s1 += shx(s1, 32, lane); s2 += shx(s2, 32, lane);
            if (fq == 0) P[(ai * 128 + wr * 64 + m * 16 + fr) * 4 + wc] = (f32x2_t){s1, s2};
            __builtin_amdgcn_sched_barrier(0);
        }
        LDS_WAIT(); __builtin_amdgcn_s_barrier(); asm volatile("" ::: "memory");
        unsigned long long* slot = X + ((size_t)u.pm * 256 + (tid & 255)) * 4;
        if (tid < 256) { const f32x2_t a = P[tid * 4 + 0], b = P[tid * 4 + 1], c2 = P[tid * 4 + 2], d = P[tid * 4 + 3];
            const float t1 = (a.x + b.x) + (c2.x + d.x), t2 = (a.y + b.y) + (c2.y + d.y);
            __hip_atomic_store(slot + u.pn, ((unsigned long long)__float_as_uint(t2) << 32) | __float_as_uint(t1), __ATOMIC_RELAXED, __HIP_MEMORY_SCOPE_AGENT); }
        asm volatile("s_waitcnt vmcnt(0)" ::: "memory"); __builtin_amdgcn_s_barrier(); asm volatile("" ::: "memory");
        if (tid == 0) {
            __hip_atomic_fetch_add(cnt + u.pm * 16, 1u, __ATOMIC_RELAXED, __HIP_MEMORY_SCOPE_AGENT);
            unsigned sp = 0; while (__hip_atomic_load(cnt + u.pm * 16, __ATOMIC_RELAXED, __HIP_MEMORY_SCOPE_AGENT) < 4u) { __builtin_amdgcn_s_sleep(1); if (++sp > (1u << 22)) break; }
            __builtin_amdgcn_fence(__ATOMIC_ACQUIRE, "agent"); asm volatile("s_waitcnt vmcnt(0)" ::: "memory");
        }
        __builtin_amdgcn_s_barrier(); asm volatile("" ::: "memory");
        if (tid < 256) { float t1 = 0.f, t2 = 0.f;
#pragma unroll
            for (int j = 0; j < 4; ++j) { const unsigned long long v = __hip_atomic_load(slot + j, __ATOMIC_RELAXED, __HIP_MEMORY_SCOPE_AGENT); t1 += __uint_as_float((unsigned)v); t2 += __uint_as_float((unsigned)(v >> 32)); }
            const float mean = t1 * (1.f / D), var = fmaxf(t2 * (1.f / D) - mean * mean, 0.f);
            Sst[tid] = (f32x2_t){mean, __builtin_amdgcn_rsqf(var + LN_EPS)}; }
        LDS_WAIT(); __builtin_amdgcn_s_barrier(); asm volatile("" ::: "memory");
        f32x4 gg[2][2], bb[2][2];
#pragma unroll
        for (int bj = 0; bj < 2; ++bj)
#pragma unroll
            for (int n = 0; n < 2; ++n) { gg[bj][n] = *(const f32x4*)(g + col0 + bj * 128 + 4 * n); bb[bj][n] = *(const f32x4*)(bt + col0 + bj * 128 + 4 * n); }
        EPI_FOR_ROWS {
            const int row = EPI_ROW; const f32x2_t st = Sst[ai * 128 + wr * 64 + m * 16 + fr];
#pragma unroll
            for (int bj = 0; bj < 2; ++bj) { const size_t off = (size_t)row * 1024 + col0 + bj * 128;
                const f32x4 o0 = (acc[ai][bj][m][0] - st.x) * st.y * gg[bj][0] + bb[bj][0], o1 = (acc[ai][bj][m][1] - st.x) * st.y * gg[bj][1] + bb[bj][1];
                *(f32x4*)(trunk + off) = o0; *(f32x4*)(trunk + off + 4) = o1;
                *(u32x4*)(HB + off) = (u32x4){pk2(o0[0], o0[1]), pk2(o0[2], o0[3]), pk2(o1[0], o1[1]), pk2(o1[2], o1[3])}; }
            if (m & 1) __builtin_amdgcn_sched_barrier(0);
        }
    }
};
DI float dpp_ror1(float v) { return __int_as_float(__builtin_amdgcn_update_dpp(0, __float_as_int(v), 0x121, 0xf, 0xf, false)); }
DI float dpp_ror15(float v) { return __int_as_float(__builtin_amdgcn_update_dpp(0, __float_as_int(v), 0x12F, 0xf, 0xf, false)); }
constexpr size_t SIDE_STRIDE = 3 * DFF;
struct EpiUpG {
    static constexpr bool AFTER_DRAIN = false;
    bf16* ACT; float* SIDE; const float* fw; const float* fb; LAS float* xch;
    DI void operator()(EPI_ARGS) const {
        const int ch0 = u.pn * 128 + wc * 32 + 8 * fq;
        float w0[8], w1[8], w2[8], bb[8];
        { const f32x4 a0 = *(const f32x4*)(fw + ch0), a1 = *(const f32x4*)(fw + ch0 + 4), b0 = *(const f32x4*)(fw + DFF + ch0), b1 = *(const f32x4*)(fw + DFF + ch0 + 4),
                      c0 = *(const f32x4*)(fw + 2 * DFF + ch0), c1 = *(const f32x4*)(fw + 2 * DFF + ch0 + 4), d0 = *(const f32x4*)(fb + ch0), d1 = *(const f32x4*)(fb + ch0 + 4);
#pragma unroll
          for (int e = 0; e < 4; ++e) { w0[e] = a0[e]; w0[e + 4] = a1[e]; w1[e] = b0[e]; w1[e + 4] = b1[e]; w2[e] = c0[e]; w2[e + 4] = c1[e]; bb[e] = d0[e]; bb[e + 4] = d1[e]; } }
#pragma unroll
        for (int ai = 0; ai < 2; ++ai) { const int gi = 2 * ai + wr;
            if (fr == 0) { LAS float* p = xch + ((gi * 4 + wc) * 2 + 0) * 32 + 8 * fq; *(LAS f32x4*)p = acc[ai][0][0][0]; *(LAS f32x4*)(p + 4) = acc[ai][0][0][1]; }
            if (fr == 15) { LAS float* p = xch + ((gi * 4 + wc) * 2 + 1) * 32 + 8 * fq; *(LAS f32x4*)p = acc[ai][0][3][0]; *(LAS f32x4*)(p + 4) = acc[ai][0][3][1]; } }
        LDS_WAIT(); __builtin_amdgcn_s_barrier(); asm volatile("" ::: "memory");
        const bool seq_first = (u.pm & 7) == 0, seq_last = (u.pm & 7) == 7;
#pragma unroll
        for (int ai = 0; ai < 2; ++ai) { const int gi = 2 * ai + wr;
            float pf[8], nf[8];
#pragma unroll
            for (int e = 0; e < 8; ++e) { pf[e] = 0.f; nf[e] = 0.f; }
            if (gi > 0) { const LAS float* p = xch + (((gi - 1) * 4 + wc) * 2 + 1) * 32 + 8 * fq; const f32x4 a = *(const LAS f32x4*)p, b = *(const LAS f32x4*)(p + 4);
#pragma unroll
                for (int e = 0; e < 4; ++e) { pf[e] = a[e]; pf[e + 4] = b[e]; } }
            if (gi < 3) { const LAS float* p = xch + (((gi + 1) * 4 + wc) * 2 + 0) * 32 + 8 * fq; const f32x4 a = *(const LAS f32x4*)p, b = *(const LAS f32x4*)(p + 4);
#pragma unroll
                for (int e = 0; e < 4; ++e) { nf[e] = a[e]; nf[e + 4] = b[e]; } }
#pragma unroll
            for (int m = 0; m < 4; ++m) {
                const int row = EPI_ROW;
                float cv[8], o[8];
#pragma unroll
                for (int e = 0; e < 8; ++e) {
                    const float g = acc[ai][0][m][e >> 2][e & 3];
                    const float upn = dpp_ror1(g), dnn = dpp_ror15(g);
                    const float upe = (m > 0) ? dpp_ror1(acc[ai][0][m > 0 ? m - 1 : 0][e >> 2][e & 3]) : pf[e];
                    const float dne = (m < 3) ? dpp_ror15(acc[ai][0][m < 3 ? m + 1 : 3][e >> 2][e & 3]) : nf[e];
                    const float up = (fr == 0) ? upe : upn, dn = (fr == 15) ? dne : dnn;
                    cv[e] = bb[e] + w0[e] * up + w1[e] * g + w2[e] * dn;
                    o[e] = gelu_t(cv[e]) * acc[ai][1][m][e >> 2][e & 3];
                }
                *(u32x4*)(ACT + (size_t)row * DFF + ch0) = pack8(o);
                if (gi == 0 && m == 0 && fr == 0 && !seq_first) { float* sp = SIDE + ((size_t)u.pm * 2 + 0) * SIDE_STRIDE + ch0;
                    *(f32x4*)sp = (f32x4){cv[0], cv[1], cv[2], cv[3]}; *(f32x4*)(sp + 4) = (f32x4){cv[4], cv[5], cv[6], cv[7]};
                    *(f32x4*)(sp + DFF) = acc[ai][1][m][0]; *(f32x4*)(sp + DFF + 4) = acc[ai][1][m][1]; *(f32x4*)(sp + 2 * DFF) = acc[ai][0][m][0]; *(f32x4*)(sp + 2 * DFF + 4) = acc[ai][0][m][1]; }
                if (gi == 3 && m == 3 && fr == 15 && !seq_last) { float* sp = SIDE + ((size_t)u.pm * 2 + 1) * SIDE_STRIDE + ch0;
                    *(f32x4*)sp = (f32x4){cv[0], cv[1], cv[2], cv[3]}; *(f32x4*)(sp + 4) = (f32x4){cv[4], cv[5], cv[6], cv[7]};
                    *(f32x4*)(sp + DFF) = acc[ai][1][m][0]; *(f32x4*)(sp + DFF + 4) = acc[ai][1][m][1]; *(f32x4*)(sp + 2 * DFF) = acc[ai][0][m][0]; *(f32x4*)(sp + 2 * DFF + 4) = acc[ai][0][m][1]; }
                __builtin_amdgcn_sched_barrier(0);
            }
        }
    }
};
DI void geglu_fix(const int wid_s, bf16* ACT, const float* SIDE, const float* fw, const float* fb, int c, int G) {
    const int tid = get_tid(wid_s);
    for (int i = c * 512 + tid; i < 63 * (DFF / 4); i += G * 512) {
        const int pm = i / (DFF / 4), ch = (i % (DFF / 4)) * 4;
        if ((pm & 7) == 7) continue;
        const float* sl = SIDE + ((size_t)pm * 2 + 1) * SIDE_STRIDE + ch;
        const float* sf = SIDE + ((size_t)(pm + 1) * 2 + 0) * SIDE_STRIDE + ch;
        const f32x4 pl = *(const f32x4*)sl, vl = *(const f32x4*)(sl + DFF), gl = *(const f32x4*)(sl + 2 * DFF);
        const f32x4 pf = *(const f32x4*)sf, vf = *(const f32x4*)(sf + DFF), gf = *(const f32x4*)(sf + 2 * DFF);
        const f32x4 w0 = *(const f32x4*)(fw + ch), w2 = *(const f32x4*)(fw + 2 * DFF + ch);
        float ol[4], of[4];
#pragma unroll
        for (int e = 0; e < 4; ++e) { ol[e] = gelu_t(pl[e] + w2[e] * gf[e]) * vl[e]; of[e] = gelu_t(pf[e] + w0[e] * gl[e]) * vf[e]; }
        *(u32x2*)(ACT + (size_t)(pm * 256 + 255) * DFF + ch) = (u32x2){pk2(ol[0], ol[1]), pk2(ol[2], ol[3])};
        *(u32x2*)(ACT + (size_t)(pm * 256 + 256) * DFF + ch) = (u32x2){pk2(of[0], of[1]), pk2(of[2], of[3])};
    }
}
DI void ln_rows(const float* src, float* dstf, bf16* dstb, const float* g, const float* bt, int gw, int NGW, int lane) {
    for (int mrow = gw; mrow < M; mrow += NGW) {
        const f32x4* xr = (const f32x4*)(src + (size_t)mrow * D) + lane;
        f32x4 v[4]; float s = 0.f;
#pragma unroll
        for (int j = 0; j < 4; ++j) { v[j] = xr[64 * j]; s += (v[j].x + v[j].y) + (v[j].z + v[j].w); }
        const float mean = wave_sum(s, lane) * (1.f / D); float s2 = 0.f;
#pragma unroll
        for (int j = 0; j < 4; ++j) { v[j] = v[j] - mean; s2 += (v[j].x * v[j].x + v[j].y * v[j].y) + (v[j].z * v[j].z + v[j].w * v[j].w); }
        const float rstd = __builtin_amdgcn_rsqf(wave_sum(s2, lane) * (1.f / D) + LN_EPS);
        f32x4* of = (f32x4*)(dstf + (size_t)mrow * D) + lane; u32x2* ob = (u32x2*)(dstb + (size_t)mrow * D) + lane;
#pragma unroll
        for (int j = 0; j < 4; ++j) { const f32x4 gg = ((const f32x4*)g)[lane + 64 * j], bb = ((const f32x4*)bt)[lane + 64 * j];
            const f32x4 y = v[j] * rstd * gg + bb; of[64 * j] = y; ob[64 * j] = (u32x2){pk2(y.x, y.y), pk2(y.z, y.w)}; }
    }
}
DI void tr_item(const float* W, int N, bf16* WT, int ldt, int rowmode, int dup, LAS float* scr, int kb, int nb, int lane) {
    const int k0 = 64 * kb, n0 = 32 * nb;
#pragma unroll 8
    for (int i = 0; i < 32; ++i) { const int kk = 2 * i + (lane >> 5); scr[kk * 33 + (lane & 31)] = W[(size_t)(k0 + kk) * N + n0 + (lane & 31)]; }
    LDS_WAIT(); asm volatile("" ::: "memory");
    const int c = lane & 7;
#pragma unroll
    for (int j = 0; j < 4; ++j) { const int n = (lane >> 3) + 8 * j; const LAS float* s = scr + (8 * c) * 33 + n;
        u32x4 o; o.x = pk2(s[0 * 33], s[1 * 33]); o.y = pk2(s[2 * 33], s[3 * 33]); o.z = pk2(s[4 * 33], s[5 * 33]); o.w = pk2(s[6 * 33], s[7 * 33]);
        const int nn = n0 + n; int row;
        if (rowmode == 0) row = nn;
        else if (rowmode == 3) { const int d = nn & 127; row = (nn < 1280 && d < 32) ? (nn & ~31) + 8 * ((d & 15) >> 2) + 4 * (d >> 4) + (d & 3) : nn; }
        else row = (nn >> 7) * 256 + (rowmode - 1) * 128 + (nn & 127);
        *(u32x4*)(WT + (size_t)row * ldt + k0 + 8 * c) = o; if (dup) *(u32x4*)(WT + (size_t)row * ldt + 1024 + k0 + 8 * c) = o; }
    LDS_WAIT(); asm volatile("" ::: "memory");
}
struct InPtrs { const float* in[26]; };
typedef const __attribute__((address_space(4))) unsigned char* kptr_t;
#define INP(i) (*(const float* const __attribute__((address_space(4)))*)(kp + 8 * (i)))
enum { CJ_IN = 1, CJ_G = 2, CJ_PA = 4, CJ_PR = 8, CJ_O = 16, CJ_UP = 32, CJ_DN = 64, CJ_PLE = 128, CJ_PG = 256, CJ_P = 512, CJ_ALL = 1023 };
DI void convert_layer(kptr_t kp, unsigned char* ws, int l, int mask, LAS unsigned char* lds, int gw, int NGW, int wave, int lane) {
    LAS float* scr = (LAS float*)(lds + wave * 8448);
    bf16* Wb = (bf16*)(ws + WS_W);
    if (mask & CJ_IN) for (int r = gw; r < 16 * 176; r += NGW) tr_item(INP(4) + (size_t)l * D * DIN, DIN, Wb + W_IN, D, 3, 0, scr, r / 176, r % 176, lane);
    if (mask & CJ_G) for (int r = gw; r < 512; r += NGW) { const int x = r >> 8, rr = r & 255, g = rr >> 5, q = rr & 31;
        tr_item(INP(x ? 10 : 8) + ((size_t)l * 8 + g) * 65536, 256, Wb + W_G + (size_t)g * 512 * 256, 256, 1 + x, 0, scr, q / 8, q % 8, lane); }
    if (mask & CJ_PA) for (int r = gw; r < 512; r += NGW) tr_item(INP(13) + (size_t)l * D * D, D, Wb + W_PA, D, 0, 0, scr, r / 32, r % 32, lane);
    if (mask & CJ_PR) for (int r = gw; r < 512; r += NGW) tr_item(INP(14) + (size_t)l * D * D, D, Wb + W_PR, D, 0, 0, scr, r / 32, r % 32, lane);
    if (mask & CJ_O) for (int r = gw; r < 512; r += NGW) tr_item(INP(15) + (size_t)l * D * D, D, Wb + W_O, D, 0, 0, scr, r / 32, r % 32, lane);
    if (mask & CJ_UP) for (int r = gw; r < 16 * 192; r += NGW) { const int kb = r / 192, nb = r % 192, hf = nb >= 96;
        tr_item(INP(18) + (size_t)l * D * 2 * DFF + hf * DFF, 2 * DFF, Wb + W_UP, D, 1 + hf, 0, scr, kb, nb - hf * 96, lane); }
    if (mask & CJ_DN) for (int r = gw; r < 48 * 32; r += NGW) tr_item(INP(21) + (size_t)l * DFF * D, D, Wb + W_DN, DFF, 0, 0, scr, r / 32, r % 32, lane);
    if (mask & CJ_PLE) for (int r = gw; r < 4 * 32; r += NGW) tr_item(INP(22) + (size_t)l * DPLE * D, D, Wb + W_PLE, DPLE, 0, 0, scr, r / 32, r % 32, lane);
    if (mask & CJ_PG) for (int r = gw; r < 512; r += NGW) tr_item(INP(23) + (size_t)l * D * D, D, Wb + W_PG, D, 0, 0, scr, r / 32, r % 32, lane);
    if (mask & CJ_P) {
        const float* P = INP(1) + (size_t)l * M * DPLE; bf16* PB = (bf16*)(ws + WS_PB);
        for (size_t i = (size_t)gw * 64 + lane; i < (size_t)M * DPLE / 8; i += (size_t)NGW * 64) {
            const f32x4 a = ((const f32x4*)P)[2 * i], b = ((const f32x4*)P)[2 * i + 1];
            ((u32x4*)PB)[i] = (u32x4){pk2(a.x, a.y), pk2(a.z, a.w), pk2(b.x, b.y), pk2(b.z, b.w)};
        }
    }
}
DI void rope_table(float* rope, int gtid, int nthr) {
    for (int i = gtid; i < SEQ * 16; i += nthr) {
        const int pos = i >> 4, j = i & 15;
        const float inv = exp2f(-(float)j * (18.931568569324174f / 16.0f));
        const float ang = (float)pos * inv;
        const double rev = (double)ang * 0.15915494309189535; const float fr = (float)(rev - floor(rev));
        rope[2 * i] = __builtin_amdgcn_cosf(fr); rope[2 * i + 1] = __builtin_amdgcn_sinf(fr);
    }
}
DI void conv_phase(const int wid_s, const bf16* xr, bf16* XFB, const float* cw, const float* cb, int c, int G) {
    const int tid = get_tid(wid_s); const int cg8 = (tid & 127) * 8, sub = tid >> 7;
    for (int it = c; it < M / 32; it += G) {
        const int r0 = it * 32 + sub * 8; const int t0 = r0 & (SEQ - 1);
        u32x4 xin[14];
#pragma unroll
        for (int i = 0; i < 14; ++i) { const int t = t0 - 3 + i; xin[i] = (t >= 0 && t < SEQ) ? *(const u32x4*)(xr + (size_t)(r0 - 3 + i) * 1024 + cg8) : (u32x4){0u, 0u, 0u, 0u}; }
#pragma unroll
        for (int dir = 0; dir < 2; ++dir) {
            float w[4][8], b8[8];
#pragma unroll
            for (int k = 0; k < 4; ++k) { const f32x4 w0 = *(const f32x4*)(cw + (dir * 4 + k) * 1024 + cg8), w1 = *(const f32x4*)(cw + (dir * 4 + k) * 1024 + cg8 + 4);
                w[k][0] = w0.x; w[k][1] = w0.y; w[k][2] = w0.z; w[k][3] = w0.w; w[k][4] = w1.x; w[k][5] = w1.y; w[k][6] = w1.z; w[k][7] = w1.w; }
            { const f32x4 w0 = *(const f32x4*)(cb + dir * 1024 + cg8), w1 = *(const f32x4*)(cb + dir * 1024 + cg8 + 4);
                b8[0] = w0.x; b8[1] = w0.y; b8[2] = w0.z; b8[3] = w0.w; b8[4] = w1.x; b8[5] = w1.y; b8[6] = w1.z; b8[7] = w1.w; }
#pragma unroll
            for (int j = 0; j < 8; ++j) {
                float o[8];
#pragma unroll
                for (int e = 0; e < 8; ++e) o[e] = b8[e];
#pragma unroll
                for (int k = 0; k < 4; ++k) { float xv[8]; unpack8(xin[dir ? (j + 3 + k) : (j + 3 - k)], xv);
#pragma unroll
                    for (int e = 0; e < 8; ++e) o[e] += w[k][e] * xv[e]; }
                *(u32x4*)(XFB + ((size_t)dir * M + r0 + j) * 1024 + cg8) = pack8(o);
            }
        }
    }
}
DI void attn_phase(const int wid_s, LAS unsigned char* lds, const bf16* zq, const bf16* zk, const bf16* zv, bf16* att, const float* sink, int c, int G) {
    const int tid = get_tid(wid_s); const int w = wid_s, lane = tid & 63, l32 = lane & 31, h = lane >> 5;
    LAS unsigned char* Ks = lds;
    LAS unsigned char* Vt = lds + 34816;
    for (int L = c; L < 512; L += G) {
        const int it = (L & 7) * 64 + (L >> 3);
        const int pair = it & 1, kvh = (it >> 1) & 1, n = (it >> 2) & 15, b = it >> 6;
        const int hq = kvh * 4 + pair * 2 + (w >> 2);
        const int qrl = (w & 3) * 32 + l32;
        const size_t qrow = (size_t)b * SEQ + n * 128 + qrl;
        bf16x8 qf[8];
#pragma unroll
        for (int c8 = 0; c8 < 8; ++c8) qf[c8] = *(const bf16x8*)(zq + qrow * 1024 + hq * 128 + c8 * 16 + h * 8);
        float mrun = sink[hq] * LOG2E, lrun = 1.f;
        f32x16 o[4];
#pragma unroll
        for (int dd = 0; dd < 4; ++dd)
#pragma unroll
            for (int i = 0; i < 16; ++i) o[dd][i] = 0.f;
        for (int kc = 0; kc < 3; ++kc) {
            const int kb = n - 1 + kc; if (kb < 0 || kb > 15) continue;
            __syncthreads();
            const size_t krow0 = (size_t)b * SEQ + kb * 128;
#pragma unroll
            for (int i = 0; i < 4; ++i) { const int piece = tid + i * 512; const int r = piece >> 4, cc = piece & 15;
                const u32x4 kv = *(const u32x4*)(zk + (krow0 + r) * 256 + kvh * 128 + cc * 8);
                *(LAS u32x4*)(Ks + r * 272 + cc * 16) = kv; }
#pragma unroll
            for (int i = 0; i < 4; ++i) { const int piece = tid + i * 512; const int r = piece & 127, cc = piece >> 7;
                const u32x4 vv = *(const u32x4*)(zv + (krow0 + r) * 256 + kvh * 128 + cc * 8);
#pragma unroll
                for (int e = 0; e < 8; ++e) { const unsigned wv = vv[e >> 1]; *(LAS unsigned short*)(Vt + (cc * 8 + e) * 264 + r * 2) = (unsigned short)((e & 1) ? (wv >> 16) : (wv & 0xffffu)); } }
            __syncthreads();
            f32x16 s[4];
#pragma unroll
            for (int j = 0; j < 4; ++j) {
#pragma unroll
                for (int i = 0; i < 16; ++i) s[j][i] = 0.f;
#pragma unroll
                for (int c8 = 0; c8 < 8; ++c8) { const bf16x8 kf = *(const LAS bf16x8*)(Ks + (j * 32 + l32) * 272 + c8 * 32 + h * 16);
                    s[j] = __builtin_amdgcn_mfma_f32_32x32x16_bf16(kf, qf[c8], s[j], 0, 0, 0); }
            }
            if (kc != 1) {
                int hb = (kc == 0) ? (4 * h - qrl) : (qrl - 4 * h); asm volatile("" : "+v"(hb));
#pragma unroll
                for (int j = 0; j < 4; ++j)
#pragma unroll
                    for (int i = 0; i < 16; ++i) { const int ko = j * 32 + (i & 3) + 8 * (i >> 2); const int dlt = (kc == 0) ? (hb + ko) : (hb - ko); const unsigned t = (unsigned)(dlt >> 31);
                        s[j][i] = __uint_as_float((__float_as_uint(s[j][i]) & ~t) | (0xF149F2CAu & t)); }
            }
            float mx = -3e38f;
#pragma unroll
            for (int j = 0; j < 4; ++j)
#pragma unroll
                for (int i = 0; i < 16; ++i) mx = fmaxf(mx, s[j][i]);
            mx = fmaxf(mx, shx(mx, 32, lane));
            const float mnew = fmaxf(mrun, mx); const float alpha = __builtin_amdgcn_exp2f(mrun - mnew); mrun = mnew;
            float psum = 0.f;
#pragma unroll
            for (int j = 0; j < 4; ++j)
#pragma unroll
                for (int i = 0; i < 16; ++i) { const float p = __builtin_amdgcn_exp2f(s[j][i] - mnew); s[j][i] = p; psum += p; }
            psum += shx(psum, 32, lane);
            lrun = lrun * alpha + psum;
#pragma unroll
            for (int dd = 0; dd < 4; ++dd)
#pragma unroll
                for (int i = 0; i < 16; ++i) o[dd][i] *= alpha;
#pragma unroll
            for (int j = 0; j < 4; ++j)
#pragma unroll
                for (int s2 = 0; s2 < 2; ++s2) {
                    u32x4 pw; pw.x = pk2(s[j][8 * s2 + 0], s[j][8 * s2 + 1]); pw.y = pk2(s[j][8 * s2 + 2], s[j][8 * s2 + 3]); pw.z = pk2(s[j][8 * s2 + 4], s[j][8 * s2 + 5]); pw.w = pk2(s[j][8 * s2 + 6], s[j][8 * s2 + 7]);
                    const bf16x8 pf = __builtin_bit_cast(bf16x8, pw);
#pragma unroll
                    for (int dd = 0; dd < 4; ++dd) { const LAS unsigned char* vp = Vt + (dd * 32 + l32) * 264 + (j * 32 + 16 * s2 + 4 * h) * 2;
                        const u32x2 lo = *(const LAS u32x2*)vp, hi = *(const LAS u32x2*)(vp + 16);
                        const u32x4 vw = {lo.x, lo.y, hi.x, hi.y};
                        o[dd] = __builtin_amdgcn_mfma_f32_32x32x16_bf16(__builtin_bit_cast(bf16x8, vw), pf, o[dd], 0, 0, 0); }
                }
        }
        const float inv = __builtin_amdgcn_rcpf(lrun);
        bf16* op = att + qrow * 1024 + hq * 128;
#pragma unroll
        for (int dd = 0; dd < 4; ++dd)
#pragma unroll
            for (int i4 = 0; i4 < 4; ++i4) { const int d0 = dd * 32 + 8 * i4 + 4 * h;
                *(u32x2*)(op + d0) = (u32x2){pk2(o[dd][4 * i4] * inv, o[dd][4 * i4 + 1] * inv), pk2(o[dd][4 * i4 + 2] * inv, o[dd][4 * i4 + 3] * inv)}; }
    }
}
DI void scan_step8(const u32x4 lw, const u32x4 uw, const bool start, float (&H)[8], float (&P)[8]) {
    float la[8], ux[8]; unpack8(lw, la); unpack8(uw, ux);
#pragma unroll
    for (int e = 0; e < 8; ++e) { const float a = __builtin_amdgcn_exp2f(la[e]); const float mlt = start ? 1.f : __builtin_amdgcn_sqrtf(fmaxf(1.f - a * a, 0.f)); H[e] = a * H[e] + ux[e] * mlt; P[e] *= a; }
}
DI void scan_phase(const int wid_s, LAS unsigned char* lds, const bf16* LA, const bf16* U, const bf16* yr, bf16* HG, int c, int G) {
    const int tid = get_tid(wid_s); const int q = tid & 3, seg = tid >> 2;
    LAS float* sP = (LAS float*)lds;
    LAS float* sH = sP + 2 * 128 * 32;
    LAS float* sC = sH + 2 * 128 * 32;
    for (int L = c; L < 256; L += G) {
        const int it = (L & 7) * 32 + (L >> 3);
        const int b = it >> 5, ch = (it & 31) * 32 + q * 8;
        const size_t r0 = (size_t)b * SEQ + seg * 16;
        const bf16* laf = LA + r0 * 1024 + ch; const bf16* uxf = U + r0 * 1024 + ch;
        const bf16* lab = laf + (size_t)M * 1024; const bf16* uxb = uxf + (size_t)M * 1024;
        float Hf[8], Pf[8], Hb[8], Pb[8];
#pragma unroll
        for (int e = 0; e < 8; ++e) { Hf[e] = 0.f; Pf[e] = 1.f; Hb[e] = 0.f; Pb[e] = 1.f; }
#pragma unroll 1
        for (int j0 = 0; j0 < 16; j0 += 4) {
            u32x4 lf[4], uf[4], lb[4], ub[4];
#pragma unroll
            for (int j = 0; j < 4; ++j) { lf[j] = *(const u32x4*)(laf + (size_t)(j0 + j) * 1024); uf[j] = *(const u32x4*)(uxf + (size_t)(j0 + j) * 1024);
                lb[j] = *(const u32x4*)(lab + (size_t)(15 - j0 - j) * 1024); ub[j] = *(const u32x4*)(uxb + (size_t)(15 - j0 - j) * 1024); }
#pragma unroll
            for (int j = 0; j < 4; ++j) { scan_step8(lf[j], uf[j], (seg == 0) && (j0 + j == 0), Hf, Pf); scan_step8(lb[j], ub[j], (seg == 127) && (j0 + j == 0), Hb, Pb); }
        }
        __syncthreads();
#pragma unroll
        for (int e = 0; e < 8; ++e) { sP[(0 * 128 + seg) * 32 + q * 8 + e] = Pf[e]; sH[(0 * 128 + seg) * 32 + q * 8 + e] = Hf[e]; sP[(1 * 128 + seg) * 32 + q * 8 + e] = Pb[e]; sH[(1 * 128 + seg) * 32 + q * 8 + e] = Hb[e]; }
        __syncthreads();
        if (tid < 64) { const int dir = tid >> 5, cc = tid & 31; float C = 0.f;
            for (int s2 = 0; s2 < 128; ++s2) { const int sg = dir ? 127 - s2 : s2; sC[(dir * 128 + sg) * 32 + cc] = C; C = sP[(dir * 128 + sg) * 32 + cc] * C + sH[(dir * 128 + sg) * 32 + cc]; } }
        __syncthreads();
#pragma unroll
        for (int e = 0; e < 8; ++e) { Hf[e] = sC[(0 * 128 + seg) * 32 + q * 8 + e]; Hb[e] = sC[(1 * 128 + seg) * 32 + q * 8 + e]; }
        unsigned hfp[16][4];
#pragma unroll
        for (int j0 = 0; j0 < 16; j0 += 4) {
            u32x4 lf[4], uf[4];
#pragma unroll
            for (int j = 0; j < 4; ++j) { lf[j] = *(const u32x4*)(laf + (size_t)(j0 + j) * 1024); uf[j] = *(const u32x4*)(uxf + (size_t)(j0 + j) * 1024); }
#pragma unroll
            for (int j = 0; j < 4; ++j) { scan_step8(lf[j], uf[j], (seg == 0) && (j0 + j == 0), Hf, Pf);
                hfp[j0 + j][0] = pk2(Hf[0], Hf[1]); hfp[j0 + j][1] = pk2(Hf[2], Hf[3]); hfp[j0 + j][2] = pk2(Hf[4], Hf[5]); hfp[j0 + j][3] = pk2(Hf[6], Hf[7]); }
            __builtin_amdgcn_sched_barrier(0);
        }
        const bf16* yp = yr + r0 * 1024 + ch; bf16* hp = HG + r0 * 1024 + ch;
#pragma unroll
        for (int j0 = 0; j0 < 16; j0 += 4) {
            u32x4 lb[4], ub[4], yv[4];
#pragma unroll
            for (int j = 0; j < 4; ++j) { const int tt = 15 - j0 - j; lb[j] = *(const u32x4*)(lab + (size_t)tt * 1024); ub[j] = *(const u32x4*)(uxb + (size_t)tt * 1024); yv[j] = *(const u32x4*)(yp + (size_t)tt * 1024); }
#pragma unroll
            for (int j = 0; j < 4; ++j) { const int tt = 15 - j0 - j; scan_step8(lb[j], ub[j], (seg == 127) && (j0 + j == 0), Hb, Pb);
                float y[8], o[8]; unpack8(yv[j], y);
                const float hf[8] = {bflo(hfp[tt][0]), bfhi(hfp[tt][0]), bflo(hfp[tt][1]), bfhi(hfp[tt][1]), bflo(hfp[tt][2]), bfhi(hfp[tt][2]), bflo(hfp[tt][3]), bfhi(hfp[tt][3])};
#pragma unroll
                for (int e = 0; e < 8; ++e) o[e] = (hf[e] + Hb[e]) * gelu_t(y[e]);
                *(u32x4*)(hp + (size_t)tt * 1024) = pack8(o); }
            __builtin_amdgcn_sched_barrier(0);
        }
    }
}
#define XB_TMO      128
#define XB_XCNT(j)  (256  + 64 * (j))
#define XB_XSUB(j)  (1280 + 64 * (j))
#define XB_XGEN(j)  (2304 + 64 * (j))
#define XB_TOP      3328
#define XB_TOPGEN   3392
#define XCD_BAR_WORDS 3456
#define XB_SPIN_CAP (1u << 18)

__device__ __forceinline__ unsigned xb_ld(unsigned* p)              { return __hip_atomic_load(p, __ATOMIC_RELAXED, __HIP_MEMORY_SCOPE_AGENT); }
__device__ __forceinline__ unsigned xb_add(unsigned* p, unsigned v) { return __hip_atomic_fetch_add(p, v, __ATOMIC_RELAXED, __HIP_MEMORY_SCOPE_AGENT); }
__device__ __forceinline__ unsigned xb_xcc_id() { return (unsigned)__builtin_amdgcn_s_getreg((3 << 11) | 20) & 0xFu; }
#define XB_SPIN(cond, bar) do { unsigned _sp = 0; while (cond) { __builtin_amdgcn_s_sleep(1); \
    if ((++_sp & 255u) == 0u) { if (xb_ld(&(bar)[XB_TMO])) break; if (_sp > XB_SPIN_CAP) { atomicAdd(&(bar)[XB_TMO], 1u); break; } } } } while (0)

struct XcdBarrier {
    unsigned* bar; unsigned x;
    volatile LAS unsigned* st;
};

__device__ __forceinline__ XcdBarrier xcd_barrier_post(unsigned* bar, volatile LAS unsigned* st, int tid) {
    XcdBarrier b; b.bar = bar; b.x = xb_xcc_id(); b.st = st;
    if (tid == 0) (void)xb_add(&bar[XB_XCNT(b.x)], 1u);
    return b;
}
__device__ __forceinline__ void xcd_barrier_complete(unsigned* bar, unsigned x, unsigned& nloc, unsigned& nx) {
    const unsigned G = gridDim.x * gridDim.y * gridDim.z;
    unsigned sum, cnt, mine, sp = 0u;
    for (;;) {
        sum = 0u; cnt = 0u; mine = 0u;
#pragma unroll
        for (unsigned j = 0; j < 16; ++j) { const unsigned c = xb_ld(&bar[XB_XCNT(j)]); sum += c; cnt += (c > 0u) ? 1u : 0u; mine = (j == x) ? c : mine; }
        if (sum == G) break;
        __builtin_amdgcn_s_sleep(1);
        if ((++sp & 255u) == 0u) { if (xb_ld(&bar[XB_TMO])) break; if (sp > XB_SPIN_CAP) { atomicAdd(&bar[XB_TMO], 1u); break; } }
    }
    nloc = mine > 0u ? mine : 1u; nx = cnt > 0u ? cnt : 1u;
}

__device__ __forceinline__ void xcd_barrier(const XcdBarrier& b, int tid) {
    asm volatile("s_waitcnt vmcnt(0)" ::: "memory");
    __syncthreads();
    if (tid == 0) {
        unsigned* bar = b.bar;
        __builtin_amdgcn_s_waitcnt(0);
        unsigned nloc = b.st[0], nx = b.st[1];
        if (nloc == 0u) { xcd_barrier_complete(bar, b.x, nloc, nx); b.st[0] = nloc; b.st[1] = nx; }
        const unsigned old = xb_add(&bar[XB_XSUB(b.x)], 1u);
        const unsigned gen = old / nloc;
        if (old + 1u == (gen + 1u) * nloc) {
            __builtin_amdgcn_fence(__ATOMIC_RELEASE, "agent");
            asm volatile("s_waitcnt vmcnt(0)" ::: "memory");
            const unsigned og = xb_add(&bar[XB_TOP], 1u);
            const unsigned tg = og / nx;
            if (og + 1u == (tg + 1u) * nx) xb_add(&bar[XB_TOPGEN], 1u);
            else XB_SPIN(xb_ld(&bar[XB_TOPGEN]) == tg, bar);
            __builtin_amdgcn_fence(__ATOMIC_ACQUIRE, "agent");
            xb_add(&bar[XB_XGEN(b.x)], 1u);
            asm volatile("s_waitcnt vmcnt(0)" ::: "memory");
        } else {
            XB_SPIN(xb_ld(&bar[XB_XGEN(b.x)]) == gen, bar);
            __builtin_amdgcn_fence(__ATOMIC_ACQUIRE, "agent");
            asm volatile("s_waitcnt vmcnt(0)" ::: "memory");
        }
    }
    __syncthreads();
}

struct Args { InPtrs I; float* out; unsigned char* ws; int ph_lo, ph_hi; };
#ifndef ONLY
#define ONLY -1
#endif
#define CASE_ON(n) if constexpr (ONLY < 0 || ONLY == (n))
#ifndef PROBE_K
#define PROBE_K -1
#endif
constexpr int PH_PER_LAYER = 9 + (PROBE_K >= 0 ? 1 : 0), N_PHASES = 1 + DEPTH * PH_PER_LAYER;

__global__ void __launch_bounds__(512, 2) fwd_kernel(Args args) {
    extern __shared__ __attribute__((aligned(16))) unsigned char lds_raw[];
    LAS unsigned char* lds = (LAS unsigned char*)lds_raw;
    cg::grid_group grid = cg::this_grid();
    const int wid_s = __builtin_amdgcn_readfirstlane((int)threadIdx.x >> 6);
    XcdBarrier bar;
    {
        const int tid0 = get_tid(wid_s);
        unsigned* barw = (unsigned*)(args.ws + WS_BAR);
        volatile LAS unsigned* st = (volatile LAS unsigned*)(lds + 131072 + 64);
        if (blockIdx.x == 0) { for (int i = tid0; i < XCD_BAR_WORDS; i += 512) __hip_atomic_store(barw + i, 0u, __ATOMIC_RELAXED, __HIP_MEMORY_SCOPE_AGENT);
            unsigned* cw = (unsigned*)(args.ws + WS_CNT); for (int i = tid0; i < CNT_WORDS; i += 512) __hip_atomic_store(cw + i, 0u, __ATOMIC_RELAXED, __HIP_MEMORY_SCOPE_AGENT); }
        if (tid0 < 2) st[tid0] = 0u;
        __syncthreads();
        grid.sync();
        bar = xcd_barrier_post(barw, st, tid0);
    }
    for (int ph = args.ph_lo; ph < args.ph_hi; ++ph) {
        kptr_t kp = (kptr_t)__builtin_amdgcn_kernarg_segment_ptr(); asm volatile("" : "+s"(kp));
        float* trunk = *(float* const __attribute__((address_space(4)))*)(kp + 208);
        unsigned char* ws = *(unsigned char* const __attribute__((address_space(4)))*)(kp + 216);
        const int wave = wid_s;
        int G = gridDim.x, c = blockIdx.x; asm volatile("" : "+s"(G), "+s"(c));
        const int gw = c * 8 + wave, NGW = G * 8;
        float* rope = (float*)(ws + WS_ROPE);
        bf16* Wb = (bf16*)(ws + WS_W); bf16* PB = (bf16*)(ws + WS_PB); bf16* HB = (bf16*)(ws + WS_HB); bf16* Z = (bf16*)(ws + WS_Z);
        bf16* ATT = (bf16*)(ws + WS_ATT); bf16* XFB = (bf16*)(ws + WS_XFB); bf16* UB = (bf16*)(ws + WS_EXTRA); bf16* T = (bf16*)(ws + WS_EXTRA);
        bf16* LAb = Z; bf16* HG = XFB; bf16* ACT = Z; float* SIDE = (float*)(ws + WS_ATT);
        if (ph > args.ph_lo) { xcd_barrier(bar, get_tid(wid_s));
#ifdef PROBE_SYNC2
            xcd_barrier(bar, get_tid(wid_s));
#endif
        }
        if (ph == 0) { CASE_ON(100) {
            const int tid = get_tid(wid_s), lane = tid & 63;
            convert_layer(kp, ws, 0, CJ_ALL, lds, gw, NGW, wave, lane);
            ln_rows(INP(0), trunk, HB, INP(2), INP(3), gw, NGW, lane);
            rope_table(rope, c * 512 + tid, G * 512); }
            continue;
        }
        const int l = (ph - 1) / PH_PER_LAYER; int k = (ph - 1) % PH_PER_LAYER; if (PROBE_K >= 0 && k == 9) k = PROBE_K;
        switch (k) {
        case 0: CASE_ON(0) {
#ifndef PROBE_LITE
#define PROBE_LITE 0
#endif
            const bool rerun = (ph - 1) % PH_PER_LAYER == 9;
            if (l > 0 && c >= 128 && !rerun) convert_layer(kp, ws, l, CJ_ALL & ~CJ_IN, lds, (c - 128) * 8 + wave, 128 * 8, wave, get_tid(wid_s) & 63);
            __syncthreads();
            pg8::TileOrder S; S.init(M, DIN, G, c, HB, D, Wb + W_IN, D);
            EpiIn E{Z, rope, rerun ? PROBE_LITE : 0};
            pg8::gemm_phase(lds, wid_s, D, D, S, E);
        } break;
        case 1: CASE_ON(1) {
            attn_phase(wid_s, lds, Z + Z_Q, Z + Z_K, Z + Z_V, ATT, INP(5) + l * NH, c, G);
            conv_phase(wid_s, Z + Z_XR, XFB, INP(6) + (size_t)l * 2 * 4 * D, INP(7) + (size_t)l * 2 * D, c, G);
            __syncthreads();
            if (l + 1 < DEPTH) convert_layer(kp, ws, l + 1, CJ_IN, lds, gw, NGW, wave, get_tid(wid_s) & 63);
        } break;
        case 2: CASE_ON(2) {
            pg8::GateOrder S{G, c, (const char*)XFB, (const char*)(Wb + W_G)};
            EpiGate E{XFB, LAb, UB, INP(9) + (size_t)l * 2 * D, INP(11) + (size_t)l * 2 * D, INP(12) + (size_t)l * 2 * D};
            pg8::gemm_phase(lds, wid_s, 256, 1024, S, E);
        } break;
        case 3: CASE_ON(3) {
            scan_phase(wid_s, lds, LAb, UB, Z + Z_GY, HG, c, G);
        } break;
        case 4: CASE_ON(4) {
            { pg8::TileOrder S; S.init(M, D, G, c, ATT, D, Wb + W_PA, D); EpiX<EP_PA> E{T, nullptr, Z + Z_SA, nullptr}; pg8::gemm_phase(lds, wid_s, D, D, S, E); }
            { pg8::TileOrder S; S.init(M, D, G, c, HG, D, Wb + W_PR, D); EpiX<EP_PR> E{T, nullptr, Z + Z_SR, HB}; pg8::gemm_phase(lds, wid_s, D, D, S, E); }
        } break;
        case 5: CASE_ON(5) {
            pg8::TileOrder S; S.init(M, D, G, c, HB, D, Wb + W_O, D);
            EpiLn E{trunk, HB, INP(16) + (size_t)l * D, INP(17) + (size_t)l * D, (unsigned long long*)(ws + WS_ATT + 16 * MiB), (unsigned*)(ws + WS_CNT) + (2 * l) * 1024, DN_ALPHA};
            pg8::gemm_phase(lds, wid_s, D, D, S, E);
        } break;
        case 6: CASE_ON(6) {
            pg8::TileOrder S; S.init(M, 2 * DFF, G, c, HB, D, Wb + W_UP, D);
            EpiUpG E{ACT, SIDE, INP(19) + (size_t)l * 3 * DFF, INP(20) + (size_t)l * DFF, (LAS float*)(lds + 131072 + 1024)};
            pg8::gemm_phase(lds, wid_s, D, D, S, E);
        } break;
        case 7: CASE_ON(7) {
            geglu_fix(wid_s, ACT, SIDE, INP(19) + (size_t)l * 3 * DFF, INP(20) + (size_t)l * DFF, c, G);
            { pg8::TileOrder S; S.init(M, D, G, c, PB, DPLE, Wb + W_PLE, DPLE); EpiX<EP_PLE1> E{T, nullptr, nullptr, nullptr}; pg8::gemm_phase(lds, wid_s, DPLE, DPLE, S, E); }
            { pg8::TileOrder S; S.init(M, D, G, c, HB, D, Wb + W_PG, D); EpiX<EP_PLE2> E{T, trunk, nullptr, nullptr}; pg8::gemm_phase(lds, wid_s, D, D, S, E); }
        } break;
        case 8: CASE_ON(8) {
            pg8::TileOrder S; S.init(M, D, G, c, ACT, DFF, Wb + W_DN, DFF);
            EpiLn E{trunk, HB, INP(24) + (size_t)l * D, INP(25) + (size_t)l * D, (unsigned long long*)(ws + WS_ATT + 16 * MiB), (unsigned*)(ws + WS_CNT) + (2 * l + 1) * 1024, 1.f};
            pg8::gemm_phase(lds, wid_s, DFF, DFF, S, E);
        } break;
        }
    }
}

extern "C" void kernel_launch(void* const* d_in, const int* in_sizes, int n_in, void* d_out, int out_size, void* d_ws, size_t ws_size, hipStream_t stream) {
    static int grid = 0;
    if (grid == 0) {
        if (n_in != 26 || out_size != M * D || ws_size < WS_END) { fprintf(stderr, "kernel_launch: unexpected sizes n_in %d out %d ws %zu\n", n_in, out_size, ws_size); grid = -1; return; }
        int dev = 0, cus = 0, per_cu = 0;
        hipGetDevice(&dev); hipDeviceGetAttribute(&cus, hipDeviceAttributeMultiprocessorCount, dev);
        if (hipFuncSetAttribute((const void*)fwd_kernel, hipFuncAttributeMaxDynamicSharedMemorySize, LDS_BYTES) != hipSuccess) { fprintf(stderr, "kernel_launch: hipFuncSetAttribute failed\n"); grid = -1; return; }
        hipOccupancyMaxActiveBlocksPerMultiprocessor(&per_cu, (const void*)fwd_kernel, 512, LDS_BYTES);
        (void)hipGetLastError();
        if (per_cu < 1) per_cu = 1;
        grid = cus * 1;
        if (grid > 256) grid = 256;
        if (grid != 256) { fprintf(stderr, "kernel_launch: needs a 256-CU device (one 256x256 unit per workgroup in the fused-LayerNorm phases)\n"); grid = -1; return; }
        fprintf(stderr, "kernel_launch: cus %d per_cu %d grid %d ws %zu\n", cus, per_cu, grid, ws_size);
    }
    if (grid < 0) return;
    Args a{};
    for (int i = 0; i < 26; ++i) a.I.in[i] = (const float*)d_in[i];
    a.out = (float*)d_out; a.ws = (unsigned char*)d_ws; a.ph_lo = 0; a.ph_hi = N_PHASES;
    void* kargs[] = {&a};
    hipError_t e = hipLaunchCooperativeKernel((const void*)fwd_kernel, dim3(grid), dim3(512), kargs, LDS_BYTES, stream);
    if (e != hipSuccess) fprintf(stderr, "kernel_launch: cooperative launch failed: %s\n", hipGetErrorString(e));
}
```

```cpp
#include <hip/hip_runtime.h>
#include <hip/hip_cooperative_groups.h>
#include <cstdio>
#include <cstdint>
namespace cg = cooperative_groups;

#define LAS __attribute__((address_space(3)))
#define DI __device__ __forceinline__
typedef unsigned short bf16;
typedef short bf16x8 __attribute__((ext_vector_type(8)));
typedef float f32x4 __attribute__((ext_vector_type(4)));
typedef float f32x16 __attribute__((ext_vector_type(16)));
typedef unsigned u32x4 __attribute__((ext_vector_type(4)));
typedef unsigned u32x2 __attribute__((ext_vector_type(2)));
typedef __bf16 bf16x2_t __attribute__((ext_vector_type(2)));
typedef float f32x2_t __attribute__((ext_vector_type(2)));

constexpr int BATCH = 8, SEQ = 2048, D = 1024, DEPTH = 4, M = BATCH * SEQ;
constexpr int NH = 8, NKV = 2, HD = 128, DIN = 5632, DFF = 3072, DPLE = 256;
constexpr float LN_EPS = 1e-5f;
constexpr float DN_ALPHA = 1.6817928305074290f;
constexpr float LOG2E = 1.4426950408889634f;
constexpr float QSCALE = 0.08838834764831845f * LOG2E;

constexpr size_t MiB = 1u << 20;
constexpr size_t WS_ROPE = 0;
constexpr size_t WS_BAR = 512 * 1024;
constexpr size_t WS_CNT = 512 * 1024 + 65536;
constexpr int CNT_WORDS = 8 * 64 * 16;
constexpr size_t WS_W = 1 * MiB;
constexpr size_t W_IN = 0, W_G = W_IN + (size_t)DIN * D, W_PA = W_G + 8 * 512 * 256, W_PR = W_PA + (size_t)D * D, W_O = W_PR + (size_t)D * 2 * D,
                 W_UP = W_O + (size_t)D * D, W_DN = W_UP + (size_t)2 * DFF * D, W_PLE = W_DN + (size_t)D * DFF, W_PG = W_PLE + (size_t)D * DPLE, W_END = W_PG + (size_t)D * D;
static_assert(W_END * 2 <= 42 * MiB, "weights");
constexpr size_t WS_PB = WS_W + 42 * MiB;
constexpr size_t WS_HB = WS_PB + 8 * MiB;
constexpr size_t WS_Z = WS_HB + 32 * MiB;
constexpr size_t WS_ATT = WS_Z + 176 * MiB;
constexpr size_t WS_XFB = WS_ATT + 32 * MiB;
constexpr size_t WS_EXTRA = WS_XFB + 64 * MiB;
constexpr size_t WS_END = WS_EXTRA + 64 * MiB;
static_assert(WS_END <= 440 * MiB, "ws");
constexpr size_t Z_Q = 0, Z_K = (size_t)M * 1024, Z_V = (size_t)M * 1280, Z_XR = (size_t)M * 1536, Z_GY = (size_t)M * 2560, Z_SA = (size_t)M * 3584, Z_SR = (size_t)M * 4608;

constexpr int LDS_BYTES = 139264;

DI unsigned pk2(float lo, float hi) { f32x2_t v = {lo, hi}; bf16x2_t b = __builtin_convertvector(v, bf16x2_t); return __builtin_bit_cast(unsigned, b); }
DI float bflo(unsigned u) { return __uint_as_float(u << 16); }
DI float bfhi(unsigned u) { return __uint_as_float(u & 0xffff0000u); }
DI float sigm(float x) { return __builtin_amdgcn_rcpf(1.f + __builtin_amdgcn_exp2f(-LOG2E * x)); }
DI float gelu_t(float x) { const float u = 0.7978845608028654f * (x + 0.044715f * x * x * x); return x * sigm(2.f * u); }
DI void unpack8(const u32x4 w, float (&v)[8]) { v[0] = bflo(w.x); v[1] = bfhi(w.x); v[2] = bflo(w.y); v[3] = bfhi(w.y); v[4] = bflo(w.z); v[5] = bfhi(w.z); v[6] = bflo(w.w); v[7] = bfhi(w.w); }
DI u32x4 pack8(const float (&v)[8]) { u32x4 w; w.x = pk2(v[0], v[1]); w.y = pk2(v[2], v[3]); w.z = pk2(v[4], v[5]); w.w = pk2(v[6], v[7]); return w; }
DI float shx(float v, int mask, int lane) { return __int_as_float(__builtin_amdgcn_ds_bpermute((lane ^ mask) << 2, __float_as_int(v))); }
DI float wave_sum(float v, int lane) {
#pragma unroll
    for (int o = 1; o < 64; o <<= 1) v += shx(v, o, lane);
    return v;
}
DI int get_tid(int wid_s) { int l; asm volatile("v_mbcnt_lo_u32_b32 %0, -1, 0\n\tv_mbcnt_hi_u32_b32 %0, -1, %0" : "=v"(l)); return wid_s * 64 + l; }
#define LDS_WAIT() asm volatile("s_waitcnt lgkmcnt(0)" ::: "memory")

namespace pg8 {
constexpr int BM = 256, BK = 64, HALF = 128, HTB = HALF * BK * 2, NXCD = 8, WGM = 8;
DI int lds_byte(int r, int c) { const int st = (r >> 4) * 2 + (c >> 5), rr = r & 15, cc = c & 31, ob = rr * 64 + cc * 2; return st * 1024 + (ob ^ (((ob >> 9) & 1) << 5)); }
DI void stage_rc(int b, int& R, int& C) { const int st = b / 1024, sb = b % 1024, swz = sb ^ (((sb >> 9) & 1) << 5); R = (st >> 1) * 16 + swz / 64; C = (st & 1) * 32 + (swz % 64) / 2; }
DI int perm32(int rho) { const int n = rho >> 4, i = rho & 15; return 8 * (i >> 2) + 4 * n + (i & 3); }
struct Unit { int pm, pn, g; };

struct TileOrder {
    int nM, nN, nwg, G, c; const char* Ab; const char* Bb; size_t atile, btile;
    DI void init(int Mr, int N, int G_, int c_, const void* A, int lda, const void* Bt, int K) { nM = Mr / BM; nN = N / BM; nwg = nM * nN; G = G_; c = c_; Ab = (const char*)A; Bb = (const char*)Bt; atile = (size_t)BM * lda * 2; btile = (size_t)BM * K * 2; }
    DI bool next(int i, Unit& u) const {
        const int L = i * G + c; if (L >= nwg) return false;
        int wgid = L; { const int q = nwg / NXCD, r = nwg % NXCD, xcd = wgid % NXCD, off = wgid / NXCD; wgid = (xcd < r ? xcd * (q + 1) : r * (q + 1) + (xcd - r) * q) + off; }
        const int nig = WGM * nN, gid = wgid / nig, fm = gid * WGM, gsz = (nM - fm) < WGM ? (nM - fm) : WGM;
        u.pm = fm + ((wgid % nig) % gsz); u.pn = (wgid % nig) / gsz; u.g = 0; return true;
    }
    DI const char* A(const Unit& u) const { return Ab + (size_t)u.pm * atile; }
    DI const char* B(const Unit& u) const { return Bb + (size_t)u.pn * btile; }
};
struct GateOrder {
    int G, c; const char* Ab; const char* Bb;
    DI bool next(int i, Unit& u) const {
        const int L = i * G + c; if (L >= 1024) return false;
        const int id = (L & 7) * 128 + (L >> 3); u.g = id >> 7; u.pm = (id & 127) >> 1; u.pn = id & 1; return true;
    }
    DI const char* A(const Unit& u) const { const int dir = u.g >> 2, blk = u.g & 3; return Ab + (((size_t)dir * M + (size_t)u.pm * 256) * 1024 + blk * 256) * 2; }
    DI const char* B(const Unit& u) const { return Bb + ((size_t)u.g * 512 + u.pn * 256) * 256 * 2; }
};

template <class Epi, class Sched>
DI void gemm_phase(LAS unsigned char* lds, const int wid_s, const int K, const int lda, const Sched& S, const Epi& E) {
    int tid_ = get_tid(wid_s);
    const int tid = tid_, wid = __builtin_amdgcn_readfirstlane(tid >> 6), lane = tid & 63, wr = wid >> 2, wc = wid & 3, fr = lane & 15, fq = lane >> 4;
    const int nt = K / BK;
    unsigned voffA[2], voffB[2];
#pragma unroll
    for (int i = 0; i < 2; ++i) { int R, C; stage_rc(tid * 16 + i * 8192, R, C); const int Rb = (R & ~31) + perm32(R & 31);
        voffA[i] = (unsigned)(R * lda + C) * 2u; voffB[i] = (unsigned)(Rb * K + C) * 2u; }
    const size_t kstep = (size_t)(BK * 2);
    const size_t hstepA = (size_t)HALF * lda * 2, hstepB = (size_t)HALF * K * 2;
    const unsigned ldsw = (unsigned)wid * 1024u;
    const int aoff = lds_byte(wr * 64 + fr, fq * 8), boff = lds_byte(wc * 32 + fr, fq * 8);
#define PG8_SA(b, h) (((b) * 2 + (h)) * HTB)
#define PG8_SB(b, h) ((4 + (b) * 2 + (h)) * HTB)
#define PG8_STAGE(bufoff, gbase, voff) do { _Pragma("unroll") for (int _i = 0; _i < 2; ++_i) \
        __builtin_amdgcn_global_load_lds((const unsigned*)((const char*)(gbase) + (voff)[_i]), (LAS unsigned*)(lds + (bufoff) + ldsw + _i * 8192), 16, 0, 0); } while (0)
#define PG8_LDA(dst, b, h) do { _Pragma("unroll") for (int m = 0; m < 4; ++m) _Pragma("unroll") for (int k = 0; k < 2; ++k) dst[m][k] = *(const LAS bf16x8*)(lds + PG8_SA(b, h) + aoff + m * 2048 + k * 1024); } while (0)
#define PG8_LDB(dst, b, h) do { _Pragma("unroll") for (int n = 0; n < 2; ++n) _Pragma("unroll") for (int k = 0; k < 2; ++k) dst[n][k] = *(const LAS bf16x8*)(lds + PG8_SB(b, h) + boff + n * 2048 + k * 1024); } while (0)
#define PG8_MMA(ai, bj, At, Bt) do { __builtin_amdgcn_s_setprio(1); _Pragma("unroll") for (int m = 0; m < 4; ++m) _Pragma("unroll") for (int n = 0; n < 2; ++n) _Pragma("unroll") for (int k = 0; k < 2; ++k) \
        acc[ai][bj][m][n] = __builtin_amdgcn_mfma_f32_16x16x32_bf16(Bt[n][k], At[m][k], acc[ai][bj][m][n], 0, 0, 0); __builtin_amdgcn_s_setprio(0); } while (0)
#define PG8_WAIT_V(n) asm volatile("s_waitcnt vmcnt(" #n ")" ::: "memory")
#define PG8_WAIT_L(n) asm volatile("s_waitcnt lgkmcnt(" #n ")" ::: "memory")
#define PG8_BAR __builtin_amdgcn_s_barrier()
#define PG8_SCHED __builtin_amdgcn_sched_barrier(0)
    PG8_SCHED;
    Unit cur, nxt; int ui = 0;
    if (!S.next(0, cur)) return;
    f32x4 acc[2][2][4][2];
#pragma unroll
    for (int a = 0; a < 2; ++a)
#pragma unroll
        for (int b = 0; b < 2; ++b)
#pragma unroll
            for (int m = 0; m < 4; ++m)
#pragma unroll
                for (int n = 0; n < 2; ++n) acc[a][b][m][n] = (f32x4){0.f, 0.f, 0.f, 0.f};
    bf16x8 At[4][2], B0[2][2], B1[2][2];
    const char* cA = S.A(cur); const char* cB = S.B(cur);
    PG8_STAGE(PG8_SB(0, 0), cB, voffB); PG8_STAGE(PG8_SB(0, 1), cB + hstepB, voffB); PG8_STAGE(PG8_SA(0, 0), cA, voffA); PG8_STAGE(PG8_SA(0, 1), cA + hstepA, voffA);
    if (wr == 1) PG8_BAR;
    PG8_WAIT_V(2); PG8_BAR;
    PG8_STAGE(PG8_SB(1, 0), cB + kstep, voffB); PG8_STAGE(PG8_SA(1, 0), cA + kstep, voffA); PG8_STAGE(PG8_SB(1, 1), cB + hstepB + kstep, voffB);
    PG8_WAIT_V(6); PG8_BAR;
    for (;;) {
        const bool has_next = S.next(ui + 1, nxt);
        const char* nA = has_next ? S.A(nxt) : cA; const char* nB = has_next ? S.B(nxt) : cB;
#pragma unroll 1
        for (int t = 0; t < nt; t += 2) {
            const bool last = (t == nt - 2);
            const char* a1 = cA + (size_t)(t + 1) * kstep;
            const char* a2 = last ? nA : cA + (size_t)(t + 2) * kstep; const char* b2 = last ? nB : cB + (size_t)(t + 2) * kstep;
            const char* a3 = a2 + kstep; const char* b3 = b2 + kstep;
            PG8_LDB(B0, 0, 0); PG8_LDB(B1, 0, 1); PG8_SCHED; PG8_LDA(At, 0, 0); PG8_STAGE(PG8_SA(1, 1), a1 + hstepA, voffA);
            PG8_WAIT_V(8); PG8_WAIT_L(0); PG8_BAR; PG8_MMA(0, 0, At, B0); PG8_MMA(0, 1, At, B1); PG8_BAR; PG8_SCHED;
            PG8_LDA(At, 0, 1); PG8_STAGE(PG8_SB(0, 0), b2, voffB); PG8_STAGE(PG8_SB(0, 1), b2 + hstepB, voffB); PG8_STAGE(PG8_SA(0, 0), a2, voffA);
            PG8_WAIT_V(8); PG8_WAIT_L(0); PG8_BAR; PG8_MMA(1, 0, At, B0); PG8_MMA(1, 1, At, B1); PG8_BAR; PG8_SCHED;
            PG8_LDB(B0, 1, 0); PG8_LDB(B1, 1, 1); PG8_SCHED; PG8_LDA(At, 1, 0); PG8_STAGE(PG8_SA(0, 1), a2 + hstepA, voffA);
            PG8_WAIT_V(8); PG8_WAIT_L(0); PG8_BAR; PG8_MMA(0, 0, At, B0); PG8_MMA(0, 1, At, B1); PG8_BAR; PG8_SCHED;
            PG8_LDA(At, 1, 1); PG8_STAGE(PG8_SB(1, 0), b3, voffB); PG8_STAGE(PG8_SB(1, 1), b3 + hstepB, voffB); PG8_STAGE(PG8_SA(1, 0), a3, voffA);
            PG8_WAIT_V(8); PG8_WAIT_L(0); PG8_BAR; PG8_MMA(1, 0, At, B0); PG8_MMA(1, 1, At, B1); PG8_BAR; PG8_SCHED;
        }
        if (wr == 0) PG8_BAR;
        if constexpr (!Epi::AFTER_DRAIN) E(acc, cur, wr, wc, fr, fq);
        if (!has_next) break;
#pragma unroll
        for (int a = 0; a < 2; ++a)
#pragma unroll
            for (int b = 0; b < 2; ++b)
#pragma unroll
                for (int m = 0; m < 4; ++m)
#pragma unroll
                    for (int n = 0; n < 2; ++n) acc[a][b][m][n] = (f32x4){0.f, 0.f, 0.f, 0.f};
        cur = nxt; cA = nA; cB = nB; ++ui;
        if (wr == 1) PG8_BAR;
    }
    PG8_WAIT_V(0);
    PG8_BAR;
    PG8_SCHED;
    if constexpr (Epi::AFTER_DRAIN) E.fused(acc, cur, wr, wc, fr, fq, lds, tid);
#undef PG8_SA
#undef PG8_SB
#undef PG8_STAGE
#undef PG8_LDA
#undef PG8_LDB
#undef PG8_MMA
#undef PG8_WAIT_V
#undef PG8_WAIT_L
#undef PG8_BAR
#undef PG8_SCHED
}
}
using pg8::Unit;
typedef f32x4 AccT[2][2][4][2];
#define EPI_ARGS const f32x4 (&acc)[2][2][4][2], const Unit& u, int wr, int wc, int fr, int fq
#define EPI_FOR_ROWS _Pragma("unroll") for (int ai = 0; ai < 2; ++ai) _Pragma("unroll") for (int m = 0; m < 4; ++m)
#define EPI_ROW (u.pm * 256 + ai * 128 + wr * 64 + m * 16 + fr)
#define EPI_V8(bj) { acc[ai][bj][m][0][0], acc[ai][bj][m][0][1], acc[ai][bj][m][0][2], acc[ai][bj][m][0][3], acc[ai][bj][m][1][0], acc[ai][bj][m][1][1], acc[ai][bj][m][1][2], acc[ai][bj][m][1][3] }

struct EpiIn {
    static constexpr bool AFTER_DRAIN = false;
    bf16* Z; const float* rope; int lite;
    template <int MODE> DI void rows(EPI_ARGS, size_t base, int ldc, int colt, float qs) const {
        EPI_FOR_ROWS {
            const int row = EPI_ROW;
            bf16* rowp = Z + base + (size_t)row * ldc + colt + wc * 32 + 8 * fq;
            f32x4 c0, c1;
            if constexpr (MODE == 4) { const f32x4* rp = (const f32x4*)(rope + ((row & (SEQ - 1)) * 16 + 4 * fq) * 2); c0 = rp[0]; c1 = rp[1]; }
#pragma unroll
            for (int bj = 0; bj < 2; ++bj) {
                float v[8] = EPI_V8(bj);
                if constexpr (MODE == 4) {
                    const float cc[4] = {c0[0], c0[2], c1[0], c1[2]}, ss[4] = {c0[1], c0[3], c1[1], c1[3]};
#pragma unroll
                    for (int e = 0; e < 4; ++e) { const float x1 = v[e], x2 = v[e + 4]; v[e] = (x1 * cc[e] - x2 * ss[e]) * qs; v[e + 4] = (x2 * cc[e] + x1 * ss[e]) * qs; }
                } else if constexpr (MODE == 0) {
#pragma unroll
                    for (int e = 0; e < 8; ++e) v[e] *= qs;
                } else if constexpr (MODE == 3) {
#pragma unroll
                    for (int e = 0; e < 8; ++e) v[e] = sigm(v[e]);
                }
                *(u32x4*)(rowp + bj * 128) = pack8(v);
            }
        }
    }
    DI void operator()(EPI_ARGS) const {
        if (lite == 2) return;
        const int pn = u.pn; size_t base; int ldc, colt, mode;
        if (pn < 4) { base = Z_Q; ldc = 1024; colt = pn * 256; mode = 0; }
        else if (pn == 4) { base = Z_K; ldc = 256; colt = 0; mode = 0; }
        else if (pn == 5) { base = Z_V; ldc = 256; colt = 0; mode = 1; }
        else { const int arr = (pn - 6) >> 2; base = (size_t)M * (1536 + 1024 * arr); ldc = 1024; colt = ((pn - 6) & 3) * 256; mode = arr <= 1 ? 1 : 3; }
        if (lite == 1) mode = 1;
        const float qs = pn < 4 ? QSCALE : 1.f;
        if (mode == 0 && wc == 0) rows<4>(acc, u, wr, wc, fr, fq, base, ldc, colt, qs);
        else if (mode == 0) { if (pn < 4) rows<0>(acc, u, wr, wc, fr, fq, base, ldc, colt, qs); else rows<1>(acc, u, wr, wc, fr, fq, base, ldc, colt, qs); }
        else if (mode == 3) rows<3>(acc, u, wr, wc, fr, fq, base, ldc, colt, qs);
        else rows<1>(acc, u, wr, wc, fr, fq, base, ldc, colt, qs);
    }
};
struct EpiGate {
    static constexpr bool AFTER_DRAIN = false;
    const bf16* XFB; bf16* LA; bf16* U; const float* b_a; const float* b_x; const float* lam;
    DI void operator()(EPI_ARGS) const {
        const int dir = u.g >> 2, blk = u.g & 3;
        const int ch0 = blk * 256 + u.pn * 128 + wc * 32 + 8 * fq;
        float ba[8], bx[8], cl[8];
#pragma unroll
        for (int e = 0; e < 8; ++e) { ba[e] = -LOG2E * b_a[dir * 1024 + ch0 + e]; bx[e] = -LOG2E * b_x[dir * 1024 + ch0 + e];
            const float l = lam[dir * 1024 + ch0 + e]; cl[e] = -8.f * __builtin_amdgcn_logf(1.f + __builtin_amdgcn_exp2f(-LOG2E * l)); }
        u32x4 xw[2][4];
        EPI_FOR_ROWS xw[ai][m] = *(const u32x4*)(XFB + ((size_t)dir * M + EPI_ROW) * 1024 + ch0);
        EPI_FOR_ROWS {
            const int row = EPI_ROW;
            const size_t off = ((size_t)dir * M + row) * 1024 + ch0;
            float x[8]; unpack8(xw[ai][m], x);
            const float va[8] = EPI_V8(0); const float vx[8] = EPI_V8(1);
            float la[8], uu[8];
#pragma unroll
            for (int e = 0; e < 8; ++e) {
                const float ea = 1.f + __builtin_amdgcn_exp2f(fminf(-LOG2E * va[e] + ba[e], 60.f)), ex = 1.f + __builtin_amdgcn_exp2f(fminf(-LOG2E * vx[e] + bx[e], 60.f));
                const float r = __builtin_amdgcn_rcpf(ea * ex);
                la[e] = (r * ex) * cl[e]; uu[e] = x[e] * (r * ea); }
            *(u32x4*)(LA + off) = pack8(la); *(u32x4*)(U + off) = pack8(uu);
            __builtin_amdgcn_sched_barrier(0);
        }
    }
};
enum { EP_PA = 0, EP_PR, EP_PLE1, EP_PLE2 };
template <int MODE> struct EpiX {
    static constexpr bool AFTER_DRAIN = false;
    bf16* Tb;
    float* TR;
    const bf16* S;
    bf16* O;
    struct RowIn { u32x4 t[2]; f32x4 r[2][2]; u32x4 s[2]; };
    DI void load(RowIn& in, size_t off0) const {
#pragma unroll
        for (int bj = 0; bj < 2; ++bj) { const size_t off = off0 + bj * 128;
            if constexpr (MODE == EP_PA || MODE == EP_PR) in.s[bj] = *(const u32x4*)(S + off);
            if constexpr (MODE == EP_PR || MODE == EP_PLE2) in.t[bj] = *(const u32x4*)(Tb + off);
            if constexpr (MODE == EP_PLE2) { in.r[bj][0] = *(const f32x4*)(TR + off); in.r[bj][1] = *(const f32x4*)(TR + off + 4); } }
    }
    DI void operator()(EPI_ARGS) const {
        const size_t base = (size_t)(u.pm * 256 + wr * 64 + fr) * 1024 + u.pn * 256 + wc * 32 + 8 * fq;
        RowIn buf[2];
        if constexpr (MODE == EP_PR || MODE == EP_PLE2 || MODE == EP_PA) load(buf[0], base);
#pragma unroll
        for (int it = 0; it < 8; ++it) {
            const int ai = it >> 2, m = it & 3;
            const size_t off0 = base + (size_t)(ai * 128 + m * 16) * 1024;
            if constexpr (MODE != EP_PLE1) { if (it + 1 < 8) load(buf[(it + 1) & 1], base + (size_t)(((it + 1) >> 2) * 128 + ((it + 1) & 3) * 16) * 1024); }
            const RowIn& in = buf[it & 1];
#pragma unroll
            for (int bj = 0; bj < 2; ++bj) {
                const size_t off = off0 + bj * 128;
                float v[8] = EPI_V8(bj);
                if constexpr (MODE == EP_PA) { float sg[8]; unpack8(in.s[bj], sg);
#pragma unroll
                    for (int e = 0; e < 8; ++e) v[e] *= sg[e];
                    *(u32x4*)(Tb + off) = pack8(v); }
                if constexpr (MODE == EP_PR) { float sg[8], t[8]; unpack8(in.s[bj], sg); unpack8(in.t[bj], t);
#pragma unroll
                    for (int e = 0; e < 8; ++e) v[e] = t[e] + v[e] * sg[e];
                    *(u32x4*)(O + off) = pack8(v); }
                if constexpr (MODE == EP_PLE1) { *(u32x4*)(Tb + off) = pack8(v); }
                if constexpr (MODE == EP_PLE2) { float p[8]; unpack8(in.t[bj], p); const f32x4 t0 = in.r[bj][0], t1 = in.r[bj][1];
                    *(f32x4*)(TR + off) = (f32x4){DN_ALPHA * t0[0] + sigm(v[0]) * p[0], DN_ALPHA * t0[1] + sigm(v[1]) * p[1], DN_ALPHA * t0[2] + sigm(v[2]) * p[2], DN_ALPHA * t0[3] + sigm(v[3]) * p[3]};
                    *(f32x4*)(TR + off + 4) = (f32x4){DN_ALPHA * t1[0] + sigm(v[4]) * p[4], DN_ALPHA * t1[1] + sigm(v[5]) * p[5], DN_ALPHA * t1[2] + sigm(v[6]) * p[6], DN_ALPHA * t1[3] + sigm(v[7]) * p[7]}; }
            }
            if constexpr (MODE != EP_PLE1) __builtin_amdgcn_sched_barrier(0);
        }
    }
};
struct EpiLn {
    static constexpr bool AFTER_DRAIN = true;
    float* trunk; bf16* HB; const float* g; const float* bt; unsigned long long* X; unsigned* cnt; float scale;
    DI void operator()(EPI_ARGS) const {}
    DI void fused(f32x4 (&acc)[2][2][4][2], const Unit& u, int wr, int wc, int fr, int fq, LAS unsigned char* lds, int tid) const {
        LAS f32x2_t* P = (LAS f32x2_t*)lds;
        LAS f32x2_t* Sst = (LAS f32x2_t*)(lds + 8192);
        const int lane = fq * 16 + fr;
        const int col0 = u.pn * 256 + wc * 32 + 8 * fq;
        const float* tbase = trunk + (size_t)(u.pm * 256 + wr * 64 + fr) * 1024 + col0;
        f32x4 tb[2][2][2];
#pragma unroll
        for (int bj = 0; bj < 2; ++bj)
#pragma unroll
            for (int n = 0; n < 2; ++n) tb[0][bj][n] = *(const f32x4*)(tbase + bj * 128 + 4 * n);
#pragma unroll
        for (int it = 0; it < 8; ++it) {
            const int ai = it >> 2, m = it & 3; float s1 = 0.f, s2 = 0.f;
            if (it + 1 < 8) { const float* tp = tbase + (size_t)(((it + 1) >> 2) * 128 + ((it + 1) & 3) * 16) * 1024;
#pragma unroll
                for (int bj = 0; bj < 2; ++bj)
#pragma unroll
                    for (int n = 0; n < 2; ++n) tb[(it + 1) & 1][bj][n] = *(const f32x4*)(tp + bj * 128 + 4 * n); }
#pragma unroll
            for (int bj = 0; bj < 2; ++bj)
#pragma unroll
                for (int n = 0; n < 2; ++n) { const f32x4 y = acc[ai][bj][m][n] + scale * tb[it & 1][bj][n]; acc[ai][bj][m][n] = y;
                    s1 += (y[0] + y[1]) + (y[2] + y[3]); s2 += (y[0] * y[0] + y[1] * y[1]) + (y[2] * y[2] + y[3] * y[3]); }
            s1 += shx(s1, 16, lane); s2 += shx(s2, 16, lane); s1 += shx(s1, 32, lane); s2 += shx(s2, 32, lane);
            if (fq == 0) P[(ai * 128 + wr * 64 + m * 16 + fr) * 4 + wc] = (f32x2_t){s1, s2};
            __builtin_amdgcn_sched_barrier(0);
        }
        LDS_WAIT(); __builtin_amdgcn_s_barrier(); asm volatile("" ::: "memory");
        unsigned long long* slot = X + ((size_t)u.pm * 256 + (tid & 255)) * 4;
        if (tid < 256) { const f32x2_t a = P[tid * 4 + 0], b = P[tid * 4 + 1], c2 = P[tid * 4 + 2], d = P[tid * 4 + 3];
            const float t1 = (a.x + b.x) + (c2.x + d.x), t2 = (a.y + b.y) + (c2.y + d.y);
            __hip_atomic_store(slot + u.pn, ((unsigned long long)__float_as_uint(t2) << 32) | __float_as_uint(t1), __ATOMIC_RELAXED, __HIP_MEMORY_SCOPE_AGENT); }
        asm volatile("s_waitcnt vmcnt(0)" ::: "memory"); __builtin_amdgcn_s_barrier(); asm volatile("" ::: "memory");
        if (tid == 0) {
            __hip_atomic_fetch_add(cnt + u.pm * 16, 1u, __ATOMIC_RELAXED, __HIP_MEMORY_SCOPE_AGENT);
            unsigned sp = 0; while (__hip_atomic_load(cnt + u.pm * 16, __ATOMIC_RELAXED, __HIP_MEMORY_SCOPE_AGENT) < 4u) { __builtin_amdgcn_s_sleep(1); if (++sp > (1u << 22)) break; }
            __builtin_amdgcn_fence(__ATOMIC_ACQUIRE, "agent"); asm volatile("s_waitcnt vmcnt(0)" ::: "memory");
        }
        __builtin_amdgcn_s_barrier(); asm volatile("" ::: "memory");
        if (tid < 256) { float t1 = 0.f, t2 = 0.f;
#pragma unroll
            for (int j = 0; j < 4; ++j) { const unsigned long long v = __hip_atomic_load(slot + j, __ATOMIC_RELAXED, __HIP_MEMORY_SCOPE_AGENT); t1 += __uint_as_float((unsigned)v); t2 += __uint_as_float((unsigned)(v >> 32)); }
            const float mean = t1 * (1.f / D), var = fmaxf(t2 * (1.f / D) - mean * mean, 0.f);
            Sst[tid] = (f32x2_t){mean, __builtin_amdgcn_rsqf(var + LN_EPS)}; }
        LDS_WAIT(); __builtin_amdgcn_s_barrier(); asm volatile("" ::: "memory");
        f32x4 gg[2][2], bb[2][2];
#pragma unroll
        for (int bj = 0; bj < 2; ++bj)
#pragma unroll
            for (int n = 0; n < 2; ++n) { gg[bj][n] = *(const f32x4*)(g + col0 + bj * 128 + 4 * n); bb[bj][n] = *(const f32x4*)(bt + col0 + bj * 128 + 4 * n); }
        EPI_FOR_ROWS {
            const int row = EPI_ROW; const f32x2_t st = Sst[ai * 128 + wr * 64 + m * 16 + fr];
#pragma unroll
            for (int bj = 0; bj < 2; ++bj) { const size_t off = (size_t)row * 1024 + col0 + bj * 128;
                const f32x4 o0 = (acc[ai][bj][m][0] - st.x) * st.y * gg[bj][0] + bb[bj][0], o1 = (acc[ai][bj][m][1] - st.x) * st.y * gg[bj][1] + bb[bj][1];
                *(f32x4*)(trunk + off) = o0; *(f32x4*)(trunk + off + 4) = o1;
                *(u32x4*)(HB + off) = (u32x4){pk2(o0[0], o0[1]), pk2(o0[2], o0[3]), pk2(o1[0], o1[1]), pk2(o1[2], o1[3])}; }
            if (m & 1) __builtin_amdgcn_sched_barrier(0);
        }
    }
};
DI float dpp_ror1(float v) { return __int_as_float(__builtin_amdgcn_update_dpp(0, __float_as_int(v), 0x121, 0xf, 0xf, false)); }
DI float dpp_ror15(float v) { return __int_as_float(__builtin_amdgcn_update_dpp(0, __float_as_int(v), 0x12F, 0xf, 0xf, false)); }
constexpr size_t SIDE_STRIDE = 3 * DFF;
struct EpiUpG {
    static constexpr bool AFTER_DRAIN = false;
    bf16* ACT; float* SIDE; const float* fw; const float* fb; LAS float* xch;
    DI void operator()(EPI_ARGS) const {
        const int ch0 = u.pn * 128 + wc * 32 + 8 * fq;
        float w0[8], w1[8], w2[8], bb[8];
        { const f32x4 a0 = *(const f32x4*)(fw + ch0), a1 = *(const f32x4*)(fw + ch0 + 4), b0 = *(const f32x4*)(fw + DFF + ch0), b1 = *(const f32x4*)(fw + DFF + ch0 + 4),
                      c0 = *(const f32x4*)(fw + 2 * DFF + ch0), c1 = *(const f32x4*)(fw + 2 * DFF + ch0 + 4), d0 = *(const f32x4*)(fb + ch0), d1 = *(const f32x4*)(fb + ch0 + 4);
#pragma unroll
          for (int e = 0; e < 4; ++e) { w0[e] = a0[e]; w0[e + 4] = a1[e]; w1[e] = b0[e]; w1[e + 4] = b1[e]; w2[e] = c0[e]; w2[e + 4] = c1[e]; bb[e] = d0[e]; bb[e + 4] = d1[e]; } }
#pragma unroll
        for (int ai = 0; ai < 2; ++ai) { const int gi = 2 * ai + wr;
            if (fr == 0) { LAS float* p = xch + ((gi * 4 + wc) * 2 + 0) * 32 + 8 * fq; *(LAS f32x4*)p = acc[ai][0][0][0]; *(LAS f32x4*)(p + 4) = acc[ai][0][0][1]; }
            if (fr == 15) { LAS float* p = xch + ((gi * 4 + wc) * 2 + 1) * 32 + 8 * fq; *(LAS f32x4*)p = acc[ai][0][3][0]; *(LAS f32x4*)(p + 4) = acc[ai][0][3][1]; } }
        LDS_WAIT(); __builtin_amdgcn_s_barrier(); asm volatile("" ::: "memory");
        const bool seq_first = (u.pm & 7) == 0, seq_last = (u.pm & 7) == 7;
#pragma unroll
        for (int ai = 0; ai < 2; ++ai) { const int gi = 2 * ai + wr;
            float pf[8], nf[8];
#pragma unroll
            for (int e = 0; e < 8; ++e) { pf[e] = 0.f; nf[e] = 0.f; }
            if (gi > 0) { const LAS float* p = xch + (((gi - 1) * 4 + wc) * 2 + 1) * 32 + 8 * fq; const f32x4 a = *(const LAS f32x4*)p, b = *(const LAS f32x4*)(p + 4);
#pragma unroll
                for (int e = 0; e < 4; ++e) { pf[e] = a[e]; pf[e + 4] = b[e]; } }
            if (gi < 3) { const LAS float* p = xch + (((gi + 1) * 4 + wc) * 2 + 0) * 32 + 8 * fq; const f32x4 a = *(const LAS f32x4*)p, b = *(const LAS f32x4*)(p + 4);
#pragma unroll
                for (int e = 0; e < 4; ++e) { nf[e] = a[e]; nf[e + 4] = b[e]; } }
#pragma unroll
            for (int m = 0; m < 4; ++m) {
                const int row = EPI_ROW;
                float cv[8], o[8];
#pragma unroll
                for (int e = 0; e < 8; ++e) {
                    const float g = acc[ai][0][m][e >> 2][e & 3];
                    const float upn = dpp_ror1(g), dnn = dpp_ror15(g);
                    const float upe = (m > 0) ? dpp_ror1(acc[ai][0][m > 0 ? m - 1 : 0][e >> 2][e & 3]) : pf[e];
                    const float dne = (m < 3) ? dpp_ror15(acc[ai][0][m < 3 ? m + 1 : 3][e >> 2][e & 3]) : nf[e];
                    const float up = (fr == 0) ? upe : upn, dn = (fr == 15) ? dne : dnn;
                    cv[e] = bb[e] + w0[e] * up + w1[e] * g + w2[e] * dn;
                    o[e] = gelu_t(cv[e]) * acc[ai][1][m][e >> 2][e & 3];
                }
                *(u32x4*)(ACT + (size_t)row * DFF + ch0) = pack8(o);
                if (gi == 0 && m == 0 && fr == 0 && !seq_first) { float* sp = SIDE + ((size_t)u.pm * 2 + 0) * SIDE_STRIDE + ch0;
                    *(f32x4*)sp = (f32x4){cv[0], cv[1], cv[2], cv[3]}; *(f32x4*)(sp + 4) = (f32x4){cv[4], cv[5], cv[6], cv[7]};
                    *(f32x4*)(sp + DFF) = acc[ai][1][m][0]; *(f32x4*)(sp + DFF + 4) = acc[ai][1][m][1]; *(f32x4*)(sp + 2 * DFF) = acc[ai][0][m][0]; *(f32x4*)(sp + 2 * DFF + 4) = acc[ai][0][m][1]; }
                if (gi == 3 && m == 3 && fr == 15 && !seq_last) { float* sp = SIDE + ((size_t)u.pm * 2 + 1) * SIDE_STRIDE + ch0;
                    *(f32x4*)sp = (f32x4){cv[0], cv[1], cv[2], cv[3]}; *(f32x4*)(sp + 4) = (f32x4){cv[4], cv[5], cv[6], cv[7]};
                    *(f32x4*)(sp + DFF) = acc[ai][1][m][0]; *(f32x4*)(sp + DFF + 4) = acc[ai][1][m][1]; *(f32x4*)(sp + 2 * DFF) = acc[ai][0][m][0]; *(f32x4*)(sp + 2 * DFF + 4) = acc[ai][0][m][1]; }
                __builtin_amdgcn_sched_barrier(0);
            }
        }
    }
};
DI void geglu_fix(const int wid_s, bf16* ACT, const float* SIDE, const float* fw, const float* fb, int c, int G) {
    const int tid = get_tid(wid_s);
    for (int i = c * 512 + tid; i < 63 * (DFF / 4); i += G * 512) {
        const int pm = i / (DFF / 4), ch = (i % (DFF / 4)) * 4;
        if ((pm & 7) == 7) continue;
        const float* sl = SIDE + ((size_t)pm * 2 + 1) * SIDE_STRIDE + ch;
        const float* sf = SIDE + ((size_t)(pm + 1) * 2 + 0) * SIDE_STRIDE + ch;
        const f32x4 pl = *(const f32x4*)sl, vl = *(const f32x4*)(sl + DFF), gl = *(const f32x4*)(sl + 2 * DFF);
        const f32x4 pf = *(const f32x4*)sf, vf = *(const f32x4*)(sf + DFF), gf = *(const f32x4*)(sf + 2 * DFF);
        const f32x4 w0 = *(const f32x4*)(fw + ch), w2 = *(const f32x4*)(fw + 2 * DFF + ch);
        float ol[4], of[4];
#pragma unroll
        for (int e = 0; e < 4; ++e) { ol[e] = gelu_t(pl[e] + w2[e] * gf[e]) * vl[e]; of[e] = gelu_t(pf[e] + w0[e] * gl[e]) * vf[e]; }
        *(u32x2*)(ACT + (size_t)(pm * 256 + 255) * DFF + ch) = (u32x2){pk2(ol[0], ol[1]), pk2(ol[2], ol[3])};
        *(u32x2*)(ACT + (size_t)(pm * 256 + 256) * DFF + ch) = (u32x2){pk2(of[0], of[1]), pk2(of[2], of[3])};
    }
}
DI void ln_rows(const float* src, float* dstf, bf16* dstb, const float* g, const float* bt, int gw, int NGW, int lane) {
    for (int mrow = gw; mrow < M; mrow += NGW) {
        const f32x4* xr = (const f32x4*)(src + (size_t)mrow * D) + lane;
        f32x4 v[4]; float s = 0.f;
#pragma unroll
        for (int j = 0; j < 4; ++j) { v[j] = xr[64 * j]; s += (v[j].x + v[j].y) + (v[j].z + v[j].w); }
        const float mean = wave_sum(s, lane) * (1.f / D); float s2 = 0.f;
#pragma unroll
        for (int j = 0; j < 4; ++j) { v[j] = v[j] - mean; s2 += (v[j].x * v[j].x + v[j].y * v[j].y) + (v[j].z * v[j].z + v[j].w * v[j].w); }
        const float rstd = __builtin_amdgcn_rsqf(wave_sum(s2, lane) * (1.f / D) + LN_EPS);
        f32x4* of = (f32x4*)(dstf + (size_t)mrow * D) + lane; u32x2* ob = (u32x2*)(dstb + (size_t)mrow * D) + lane;
#pragma unroll
        for (int j = 0; j < 4; ++j) { const f32x4 gg = ((const f32x4*)g)[lane + 64 * j], bb = ((const f32x4*)bt)[lane + 64 * j];
            const f32x4 y = v[j] * rstd * gg + bb; of[64 * j] = y; ob[64 * j] = (u32x2){pk2(y.x, y.y), pk2(y.z, y.w)}; }
    }
}
DI void tr_item(const float* W, int N, bf16* WT, int ldt, int rowmode, int dup, LAS float* scr, int kb, int nb, int lane) {
    const int k0 = 64 * kb, n0 = 32 * nb;
#pragma unroll 8
    for (int i = 0; i < 32; ++i) { const int kk = 2 * i + (lane >> 5); scr[kk * 33 + (lane & 31)] = W[(size_t)(k0 + kk) * N + n0 + (lane & 31)]; }
    LDS_WAIT(); asm volatile("" ::: "memory");
    const int c = lane & 7;
#pragma unroll
    for (int j = 0; j < 4; ++j) { const int n = (lane >> 3) + 8 * j; const LAS float* s = scr + (8 * c) * 33 + n;
        u32x4 o; o.x = pk2(s[0 * 33], s[1 * 33]); o.y = pk2(s[2 * 33], s[3 * 33]); o.z = pk2(s[4 * 33], s[5 * 33]); o.w = pk2(s[6 * 33], s[7 * 33]);
        const int nn = n0 + n; int row;
        if (rowmode == 0) row = nn;
        else if (rowmode == 3) { const int d = nn & 127; row = (nn < 1280 && d < 32) ? (nn & ~31) + 8 * ((d & 15) >> 2) + 4 * (d >> 4) + (d & 3) : nn; }
        else row = (nn >> 7) * 256 + (rowmode - 1) * 128 + (nn & 127);
        *(u32x4*)(WT + (size_t)row * ldt + k0 + 8 * c) = o; if (dup) *(u32x4*)(WT + (size_t)row * ldt + 1024 + k0 + 8 * c) = o; }
    LDS_WAIT(); asm volatile("" ::: "memory");
}
struct InPtrs { const float* in[26]; };
typedef const __attribute__((address_space(4))) unsigned char* kptr_t;
#define INP(i) (*(const float* const __attribute__((address_space(4)))*)(kp + 8 * (i)))
enum { CJ_IN = 1, CJ_G = 2, CJ_PA = 4, CJ_PR = 8, CJ_O = 16, CJ_UP = 32, CJ_DN = 64, CJ_PLE = 128, CJ_PG = 256, CJ_P = 512, CJ_ALL = 1023 };
DI void convert_layer(kptr_t kp, unsigned char* ws, int l, int mask, LAS unsigned char* lds, int gw, int NGW, int wave, int lane) {
    LAS float* scr = (LAS float*)(lds + wave * 8448);
    bf16* Wb = (bf16*)(ws + WS_W);
    if (mask & CJ_IN) for (int r = gw; r < 16 * 176; r += NGW) tr_item(INP(4) + (size_t)l * D * DIN, DIN, Wb + W_IN, D, 3, 0, scr, r / 176, r % 176, lane);
    if (mask & CJ_G) for (int r = gw; r < 512; r += NGW) { const int x = r >> 8, rr = r & 255, g = rr >> 5, q = rr & 31;
        tr_item(INP(x ? 10 : 8) + ((size_t)l * 8 + g) * 65536, 256, Wb + W_G + (size_t)g * 512 * 256, 256, 1 + x, 0, scr, q / 8, q % 8, lane); }
    if (mask & CJ_PA) for (int r = gw; r < 512; r += NGW) tr_item(INP(13) + (size_t)l * D * D, D, Wb + W_PA, D, 0, 0, scr, r / 32, r % 32, lane);
    if (mask & CJ_PR) for (int r = gw; r < 512; r += NGW) tr_item(INP(14) + (size_t)l * D * D, D, Wb + W_PR, D, 0, 0, scr, r / 32, r % 32, lane);
    if (mask & CJ_O) for (int r = gw; r < 512; r += NGW) tr_item(INP(15) + (size_t)l * D * D, D, Wb + W_O, D, 0, 0, scr, r / 32, r % 32, lane);
    if (mask & CJ_UP) for (int r = gw; r < 16 * 192; r += NGW) { const int kb = r / 192, nb = r % 192, hf = nb >= 96;
        tr_item(INP(18) + (size_t)l * D * 2 * DFF + hf * DFF, 2 * DFF, Wb + W_UP, D, 1 + hf, 0, scr, kb, nb - hf * 96, lane); }
    if (mask & CJ_DN) for (int r = gw; r < 48 * 32; r += NGW) tr_item(INP(21) + (size_t)l * DFF * D, D, Wb + W_DN, DFF, 0, 0, scr, r / 32, r % 32, lane);
    if (mask & CJ_PLE) for (int r = gw; r < 4 * 32; r += NGW) tr_item(INP(22) + (size_t)l * DPLE * D, D, Wb + W_PLE, DPLE, 0, 0, scr, r / 32, r % 32, lane);
    if (mask & CJ_PG) for (int r = gw; r < 512; r += NGW) tr_item(INP(23) + (size_t)l * D * D, D, Wb + W_PG, D, 0, 0, scr, r / 32, r % 32, lane);
    if (mask & CJ_P) {
        const float* P = INP(1) + (size_t)l * M * DPLE; bf16* PB = (bf16*)(ws + WS_PB);
        for (size_t i = (size_t)gw * 64 + lane; i < (size_t)M * DPLE / 8; i += (size_t)NGW * 64) {
            const f32x4 a = ((const f32x4*)P)[2 * i], b = ((const f32x4*)P)[2 * i + 1];
            ((u32x4*)PB)[i] = (u32x4){pk2(a.x, a.y), pk2(a.z, a.w), pk2(b.x, b.y), pk2(b.z, b.w)};
        }
    }
}
DI void rope_table(float* rope, int gtid, int nthr) {
    for (int i = gtid; i < SEQ * 16; i += nthr) {
        const int pos = i >> 4, j = i & 15;
        const float inv = exp2f(-(float)j * (18.931568569324174f / 16.0f));
        const float ang = (float)pos * inv;
        const double rev = (double)ang * 0.15915494309189535; const float fr = (float)(rev - floor(rev));
        rope[2 * i] = __builtin_amdgcn_cosf(fr); rope[2 * i + 1] = __builtin_amdgcn_sinf(fr);
    }
}
DI void conv_phase(const int wid_s, const bf16* xr, bf16* XFB, const float* cw, const float* cb, int c, int G) {
    const int tid = get_tid(wid_s); const int cg8 = (tid & 127) * 8, sub = tid >> 7;
    for (int it = c; it < M / 32; it += G) {
        const int r0 = it * 32 + sub * 8; const int t0 = r0 & (SEQ - 1);
        u32x4 xin[14];
#pragma unroll
        for (int i = 0; i < 14; ++i) { const int t = t0 - 3 + i; xin[i] = (t >= 0 && t < SEQ) ? *(const u32x4*)(xr + (size_t)(r0 - 3 + i) * 1024 + cg8) : (u32x4){0u, 0u, 0u, 0u}; }
#pragma unroll
        for (int dir = 0; dir < 2; ++dir) {
            float w[4][8], b8[8];
#pragma unroll
            for (int k = 0; k < 4; ++k) { const f32x4 w0 = *(const f32x4*)(cw + (dir * 4 + k) * 1024 + cg8), w1 = *(const f32x4*)(cw + (dir * 4 + k) * 1024 + cg8 + 4);
                w[k][0] = w0.x; w[k][1] = w0.y; w[k][2] = w0.z; w[k][3] = w0.w; w[k][4] = w1.x; w[k][5] = w1.y; w[k][6] = w1.z; w[k][7] = w1.w; }
            { const f32x4 w0 = *(const f32x4*)(cb + dir * 1024 + cg8), w1 = *(const f32x4*)(cb + dir * 1024 + cg8 + 4);
                b8[0] = w0.x; b8[1] = w0.y; b8[2] = w0.z; b8[3] = w0.w; b8[4] = w1.x; b8[5] = w1.y; b8[6] = w1.z; b8[7] = w1.w; }
#pragma unroll
            for (int j = 0; j < 8; ++j) {
                float o[8];
#pragma unroll
                for (int e = 0; e < 8; ++e) o[e] = b8[e];
#pragma unroll
                for (int k = 0; k < 4; ++k) { float xv[8]; unpack8(xin[dir ? (j + 3 + k) : (j + 3 - k)], xv);
#pragma unroll
                    for (int e = 0; e < 8; ++e) o[e] += w[k][e] * xv[e]; }
                *(u32x4*)(XFB + ((size_t)dir * M + r0 + j) * 1024 + cg8) = pack8(o);
            }
        }
    }
}
struct AttStep { int L, kc; };
DI bool att_valid(const AttStep& st) { if (st.L >= 512) return false; const int it = (st.L & 7) * 64 + (st.L >> 3); const int n = (it >> 2) & 15; const int kb = n - 1 + st.kc; return kb >= 0 && kb <= 15; }
DI AttStep att_next(AttStep st, int G) { for (int guard = 0; guard < 8; ++guard) { if (++st.kc > 2) { st.kc = 0; st.L += G; } if (st.L >= 512 || att_valid(st)) break; } return st; }
DI void att_fetch(const AttStep& st, const bf16* zk, const bf16* zv, int tid, u32x4 (&kreg)[4], u32x4 (&vreg)[4]) {
    const int it = (st.L & 7) * 64 + (st.L >> 3); const int kvh = (it >> 1) & 1, n = (it >> 2) & 15, b = it >> 6;
    const size_t krow0 = (size_t)b * SEQ + (size_t)(n - 1 + st.kc) * 128;
#pragma unroll
    for (int i = 0; i < 4; ++i) { const int piece = tid + i * 512; kreg[i] = *(const u32x4*)(zk + (krow0 + (piece >> 4)) * 256 + kvh * 128 + (piece & 15) * 8); }
#pragma unroll
    for (int i = 0; i < 4; ++i) { const int piece = tid + i * 512; vreg[i] = *(const u32x4*)(zv + (krow0 + (piece & 127)) * 256 + kvh * 128 + (piece >> 7) * 8); }
}
DI void attn_phase(const int wid_s, LAS unsigned char* lds, const bf16* zq, const bf16* zk, const bf16* zv, bf16* att, const float* sink, int c, int G) {
    const int tid = get_tid(wid_s); const int w = wid_s, lane = tid & 63, l32 = lane & 31, h = lane >> 5;
    LAS unsigned char* Ks = lds;
    LAS unsigned char* Vt = lds + 34816;
    u32x4 kreg[4], vreg[4];
    AttStep cur{c, -1}; cur = att_next(cur, G);
    if (cur.L < 512) att_fetch(cur, zk, zv, tid, kreg, vreg);
    for (int L = c; L < 512; L += G) {
        const int it = (L & 7) * 64 + (L >> 3);
        const int pair = it & 1, kvh = (it >> 1) & 1, n = (it >> 2) & 15, b = it >> 6;
        const int hq = kvh * 4 + pair * 2 + (w >> 2);
        const int qrl = (w & 3) * 32 + l32;
        const size_t qrow = (size_t)b * SEQ + n * 128 + qrl;
        float mrun = sink[hq] * LOG2E, lrun = 1.f;
        f32x16 o[4];
#pragma unroll
        for (int dd = 0; dd < 4; ++dd)
#pragma unroll
            for (int i = 0; i < 16; ++i) o[dd][i] = 0.f;
        for (int kc = 0; kc < 3; ++kc) {
            const int kb = n - 1 + kc; if (kb < 0 || kb > 15) continue;
            bf16x8 qf[8];
#pragma unroll
            for (int c8 = 0; c8 < 8; ++c8) qf[c8] = *(const bf16x8*)(zq + qrow * 1024 + hq * 128 + c8 * 16 + h * 8);
            __syncthreads();
#pragma unroll
            for (int i = 0; i < 4; ++i) { const int piece = tid + i * 512; *(LAS u32x4*)(Ks + (piece >> 4) * 272 + (piece & 15) * 16) = kreg[i]; }
#pragma unroll
            for (int i = 0; i < 4; ++i) { const int piece = tid + i * 512; const int r = piece & 127, cc = piece >> 7;
#pragma unroll
                for (int e = 0; e < 8; ++e) { const unsigned wv = vreg[i][e >> 1]; *(LAS unsigned short*)(Vt + (cc * 8 + e) * 264 + r * 2) = (unsigned short)((e & 1) ? (wv >> 16) : (wv & 0xffffu)); } }
            cur = att_next(cur, G);
            if (cur.L < 512) att_fetch(cur, zk, zv, tid, kreg, vreg);
            __syncthreads();
            f32x16 s[4];
#pragma unroll
            for (int j = 0; j < 4; ++j) {
#pragma unroll
                for (int i = 0; i < 16; ++i) s[j][i] = 0.f;
#pragma unroll
                for (int c8 = 0; c8 < 8; ++c8) { const bf16x8 kf = *(const LAS bf16x8*)(Ks + (j * 32 + l32) * 272 + c8 * 32 + h * 16);
                    s[j] = __builtin_amdgcn_mfma_f32_32x32x16_bf16(kf, qf[c8], s[j], 0, 0, 0); }
            }
            if (kc != 1) {
                int hb = (kc == 0) ? (4 * h - qrl) : (qrl - 4 * h); asm volatile("" : "+v"(hb));
#pragma unroll
                for (int j = 0; j < 4; ++j)
#pragma unroll
                    for (int i = 0; i < 16; ++i) { const int ko = j * 32 + (i & 3) + 8 * (i >> 2); const int dlt = (kc == 0) ? (hb + ko) : (hb - ko); const unsigned t = (unsigned)(dlt >> 31);
                        s[j][i] = __uint_as_float((__float_as_uint(s[j][i]) & ~t) | (0xF149F2CAu & t)); }
            }
            float mx = -3e38f;
#pragma unroll
            for (int j = 0; j < 4; ++j)
#pragma unroll
                for (int i = 0; i < 16; ++i) mx = fmaxf(mx, s[j][i]);
            mx = fmaxf(mx, shx(mx, 32, lane));
            const float mnew = fmaxf(mrun, mx); const float alpha = __builtin_amdgcn_exp2f(mrun - mnew); mrun = mnew;
            float psum = 0.f;
#pragma unroll
            for (int j = 0; j < 4; ++j)
#pragma unroll
                for (int i = 0; i < 16; ++i) { const float p = __builtin_amdgcn_exp2f(s[j][i] - mnew); s[j][i] = p; psum += p; }
            psum += shx(psum, 32, lane);
            lrun = lrun * alpha + psum;
#pragma unroll
            for (int dd = 0; dd < 4; ++dd)
#pragma unroll
                for (int i = 0; i < 16; ++i) o[dd][i] *= alpha;
#pragma unroll
            for (int j = 0; j < 4; ++j)
#pragma unroll
                for (int s2 = 0; s2 < 2; ++s2) {
                    u32x4 pw; pw.x = pk2(s[j][8 * s2 + 0], s[j][8 * s2 + 1]); pw.y = pk2(s[j][8 * s2 + 2], s[j][8 * s2 + 3]); pw.z = pk2(s[j][8 * s2 + 4], s[j][8 * s2 + 5]); pw.w = pk2(s[j][8 * s2 + 6], s[j][8 * s2 + 7]);
                    const bf16x8 pf = __builtin_bit_cast(bf16x8, pw);
#pragma unroll
                    for (int dd = 0; dd < 4; ++dd) { const LAS unsigned char* vp = Vt + (dd * 32 + l32) * 264 + (j * 32 + 16 * s2 + 4 * h) * 2;
                        const u32x2 lo = *(const LAS u32x2*)vp, hi = *(const LAS u32x2*)(vp + 16);
                        const u32x4 vw = {lo.x, lo.y, hi.x, hi.y};
                        o[dd] = __builtin_amdgcn_mfma_f32_32x32x16_bf16(__builtin_bit_cast(bf16x8, vw), pf, o[dd], 0, 0, 0); }
                }
        }
        const float inv = __builtin_amdgcn_rcpf(lrun);
        bf16* op = att + qrow * 1024 + hq * 128;
#pragma unroll
        for (int dd = 0; dd < 4; ++dd)
#pragma unroll
            for (int i4 = 0; i4 < 4; ++i4) { const int d0 = dd * 32 + 8 * i4 + 4 * h;
                *(u32x2*)(op + d0) = (u32x2){pk2(o[dd][4 * i4] * inv, o[dd][4 * i4 + 1] * inv), pk2(o[dd][4 * i4 + 2] * inv, o[dd][4 * i4 + 3] * inv)}; }
    }
}
DI void scan_step8(const u32x4 lw, const u32x4 uw, const bool start, float (&H)[8], float (&P)[8]) {
    float la[8], ux[8]; unpack8(lw, la); unpack8(uw, ux);
#pragma unroll
    for (int e = 0; e < 8; ++e) { const float a = __builtin_amdgcn_exp2f(la[e]); const float mlt = start ? 1.f : __builtin_amdgcn_sqrtf(fmaxf(1.f - a * a, 0.f)); H[e] = a * H[e] + ux[e] * mlt; P[e] *= a; }
}
DI void scan_phase(const int wid_s, LAS unsigned char* lds, const bf16* LA, const bf16* U, const bf16* yr, bf16* HG, int c, int G) {
    const int tid = get_tid(wid_s); const int q = tid & 3, seg = tid >> 2;
    LAS float* sP = (LAS float*)lds;
    LAS float* sH = sP + 2 * 128 * 32;
    LAS float* sC = sH + 2 * 128 * 32;
    LAS float* gP = sC + 2 * 128 * 32;
    LAS float* gH = gP + 8 * 64;
    for (int L = c; L < 256; L += G) {
        const int it = (L & 7) * 32 + (L >> 3);
        const int b = it >> 5, ch = (it & 31) * 32 + q * 8;
        const size_t r0 = (size_t)b * SEQ + seg * 16;
        const bf16* laf = LA + r0 * 1024 + ch; const bf16* uxf = U + r0 * 1024 + ch;
        const bf16* lab = laf + (size_t)M * 1024; const bf16* uxb = uxf + (size_t)M * 1024;
        const bf16* yp = yr + r0 * 1024 + ch; bf16* hp = HG + r0 * 1024 + ch;
        float Hf[8], Pf[8], Hb[8], Pb[8];
#pragma unroll
        for (int e = 0; e < 8; ++e) { Hf[e] = 0.f; Pf[e] = 1.f; Hb[e] = 0.f; Pb[e] = 1.f; }
        u32x4 lf[2][4], uf[2][4], lb[2][4], ub[2][4];
#define SC_LOAD1(bi, j0) _Pragma("unroll") for (int j = 0; j < 4; ++j) { lf[bi][j] = *(const u32x4*)(laf + (size_t)((j0) + j) * 1024); uf[bi][j] = *(const u32x4*)(uxf + (size_t)((j0) + j) * 1024); \
            lb[bi][j] = *(const u32x4*)(lab + (size_t)(15 - (j0) - j) * 1024); ub[bi][j] = *(const u32x4*)(uxb + (size_t)(15 - (j0) - j) * 1024); }
        SC_LOAD1(0, 0)
#pragma unroll
        for (int ck = 0; ck < 4; ++ck) {
            if (ck < 3) { SC_LOAD1((ck + 1) & 1, 4 * (ck + 1)) }
#pragma unroll
            for (int j = 0; j < 4; ++j) { scan_step8(lf[ck & 1][j], uf[ck & 1][j], (seg == 0) && (4 * ck + j == 0), Hf, Pf); scan_step8(lb[ck & 1][j], ub[ck & 1][j], (seg == 127) && (4 * ck + j == 0), Hb, Pb); }
            __builtin_amdgcn_sched_barrier(0);
        }
        u32x4 yv[2][2];
#define SC_LOADF(bi, j0) _Pragma("unroll") for (int j = 0; j < 2; ++j) { lf[bi][j] = *(const u32x4*)(laf + (size_t)((j0) + j) * 1024); uf[bi][j] = *(const u32x4*)(uxf + (size_t)((j0) + j) * 1024); }
#define SC_LOADB(bi, j0) _Pragma("unroll") for (int j = 0; j < 2; ++j) { lb[bi][j] = *(const u32x4*)(lab + (size_t)(15 - (j0) - j) * 1024); ub[bi][j] = *(const u32x4*)(uxb + (size_t)(15 - (j0) - j) * 1024); yv[bi][j] = *(const u32x4*)(yp + (size_t)(15 - (j0) - j) * 1024); }
        SC_LOADF(0, 0)
        __syncthreads();
#pragma unroll
        for (int e = 0; e < 8; ++e) { sP[(0 * 128 + seg) * 32 + q * 8 + e] = Pf[e]; sH[(0 * 128 + seg) * 32 + q * 8 + e] = Hf[e]; sP[(1 * 128 + seg) * 32 + q * 8 + e] = Pb[e]; sH[(1 * 128 + seg) * 32 + q * 8 + e] = Hb[e]; }
        __syncthreads();
        {
            const int cc = tid & 31, dir = (tid >> 5) & 1, grp = tid >> 6;
            float Cg = 0.f, Pg = 1.f;
            for (int s2 = 0; s2 < 16; ++s2) { const int so = grp * 16 + s2, sg = dir ? 127 - so : so; const float p = sP[(dir * 128 + sg) * 32 + cc], h = sH[(dir * 128 + sg) * 32 + cc]; Cg = p * Cg + h; Pg *= p; }
            gP[grp * 64 + (tid & 63)] = Pg; gH[grp * 64 + (tid & 63)] = Cg;
            __syncthreads();
            float C = 0.f;
            for (int g2 = 0; g2 < grp; ++g2) C = gP[g2 * 64 + (tid & 63)] * C + gH[g2 * 64 + (tid & 63)];
            for (int s2 = 0; s2 < 16; ++s2) { const int so = grp * 16 + s2, sg = dir ? 127 - so : so; sC[(dir * 128 + sg) * 32 + cc] = C; C = sP[(dir * 128 + sg) * 32 + cc] * C + sH[(dir * 128 + sg) * 32 + cc]; }
        }
        __syncthreads();
#pragma unroll
        for (int e = 0; e < 8; ++e) { Hf[e] = sC[(0 * 128 + seg) * 32 + q * 8 + e]; Hb[e] = sC[(1 * 128 + seg) * 32 + q * 8 + e]; }
        unsigned hfp[16][4];
#pragma unroll
        for (int ck = 0; ck < 8; ++ck) {
            if (ck < 7) { SC_LOADF((ck + 1) & 1, 2 * (ck + 1)) } else { SC_LOADB(0, 0) }
#pragma unroll
            for (int j = 0; j < 2; ++j) { scan_step8(lf[ck & 1][j], uf[ck & 1][j], (seg == 0) && (2 * ck + j == 0), Hf, Pf);
                hfp[2 * ck + j][0] = pk2(Hf[0], Hf[1]); hfp[2 * ck + j][1] = pk2(Hf[2], Hf[3]); hfp[2 * ck + j][2] = pk2(Hf[4], Hf[5]); hfp[2 * ck + j][3] = pk2(Hf[6], Hf[7]); }
            __builtin_amdgcn_sched_barrier(0);
        }
#pragma unroll
        for (int ck = 0; ck < 8; ++ck) {
            if (ck < 7) { SC_LOADB((ck + 1) & 1, 2 * (ck + 1)) }
#pragma unroll
            for (int j = 0; j < 2; ++j) { const int tt = 15 - 2 * ck - j; scan_step8(lb[ck & 1][j], ub[ck & 1][j], (seg == 127) && (2 * ck + j == 0), Hb, Pb);
                float y[8], o[8]; unpack8(yv[ck & 1][j], y);
                const float hf[8] = {bflo(hfp[tt][0]), bfhi(hfp[tt][0]), bflo(hfp[tt][1]), bfhi(hfp[tt][1]), bflo(hfp[tt][2]), bfhi(hfp[tt][2]), bflo(hfp[tt][3]), bfhi(hfp[tt][3])};
#pragma unroll
                for (int e = 0; e < 8; ++e) o[e] = (hf[e] + Hb[e]) * gelu_t(y[e]);
                *(u32x4*)(hp + (size_t)tt * 1024) = pack8(o); }
            __builtin_amdgcn_sched_barrier(0);
        }
#undef SC_LOAD1
#undef SC_LOADF
#undef SC_LOADB
    }
}
#define XB_TMO      128
#define XB_XCNT(j)  (256  + 64 * (j))
#define XB_XSUB(j)  (1280 + 64 * (j))
#define XB_XGEN(j)  (2304 + 64 * (j))
#define XB_TOP      3328
#define XB_TOPGEN   3392
#define XCD_BAR_WORDS 3456
#define XB_SPIN_CAP (1u << 18)

__device__ __forceinline__ unsigned xb_ld(unsigned* p)              { return __hip_atomic_load(p, __ATOMIC_RELAXED, __HIP_MEMORY_SCOPE_AGENT); }
__device__ __forceinline__ unsigned xb_add(unsigned* p, unsigned v) { return __hip_atomic_fetch_add(p, v, __ATOMIC_RELAXED, __HIP_MEMORY_SCOPE_AGENT); }
__device__ __forceinline__ unsigned xb_xcc_id() { return (unsigned)__builtin_amdgcn_s_getreg((3 << 11) | 20) & 0xFu; }
#define XB_SPIN(cond, bar) do { unsigned _sp = 0; while (cond) { __builtin_amdgcn_s_sleep(1); \
    if ((++_sp & 255u) == 0u) { if (xb_ld(&(bar)[XB_TMO])) break; if (_sp > XB_SPIN_CAP) { atomicAdd(&(bar)[XB_TMO], 1u); break; } } } } while (0)

struct XcdBarrier {
    unsigned* bar; unsigned x;
    volatile LAS unsigned* st;
};

__device__ __forceinline__ XcdBarrier xcd_barrier_post(unsigned* bar, volatile LAS unsigned* st, int tid) {
    XcdBarrier b; b.bar = bar; b.x = xb_xcc_id(); b.st = st;
    if (tid == 0) (void)xb_add(&bar[XB_XCNT(b.x)], 1u);
    return b;
}
__device__ __forceinline__ void xcd_barrier_complete(unsigned* bar, unsigned x, unsigned& nloc, unsigned& nx) {
    const unsigned G = gridDim.x * gridDim.y * gridDim.z;
    unsigned sum, cnt, mine, sp = 0u;
    for (;;) {
        sum = 0u; cnt = 0u; mine = 0u;
#pragma unroll
        for (unsigned j = 0; j < 16; ++j) { const unsigned c = xb_ld(&bar[XB_XCNT(j)]); sum += c; cnt += (c > 0u) ? 1u : 0u; mine = (j == x) ? c : mine; }
        if (sum == G) break;
        __builtin_amdgcn_s_sleep(1);
        if ((++sp & 255u) == 0u) { if (xb_ld(&bar[XB_TMO])) break; if (sp > XB_SPIN_CAP) { atomicAdd(&bar[XB_TMO], 1u); break; } }
    }
    nloc = mine > 0u ? mine : 1u; nx = cnt > 0u ? cnt : 1u;
}

__device__ __forceinline__ void xcd_barrier(const XcdBarrier& b, int tid) {
    asm volatile("s_waitcnt vmcnt(0)" ::: "memory");
    __syncthreads();
    if (tid == 0) {
        unsigned* bar = b.bar;
        __builtin_amdgcn_s_waitcnt(0);
        unsigned nloc = b.st[0], nx = b.st[1];
        if (nloc == 0u) { xcd_barrier_complete(bar, b.x, nloc, nx); b.st[0] = nloc; b.st[1] = nx; }
        const unsigned old = xb_add(&bar[XB_XSUB(b.x)], 1u);
        const unsigned gen = old / nloc;
        if (old + 1u == (gen + 1u) * nloc) {
            __builtin_amdgcn_fence(__ATOMIC_RELEASE, "agent");
            asm volatile("s_waitcnt vmcnt(0)" ::: "memory");
            const unsigned og = xb_add(&bar[XB_TOP], 1u);
            const unsigned tg = og / nx;
            if (og + 1u == (tg + 1u) * nx) xb_add(&bar[XB_TOPGEN], 1u);
            else XB_SPIN(xb_ld(&bar[XB_TOPGEN]) == tg, bar);
            __builtin_amdgcn_fence(__ATOMIC_ACQUIRE, "agent");
            xb_add(&bar[XB_XGEN(b.x)], 1u);
            asm volatile("s_waitcnt vmcnt(0)" ::: "memory");
        } else {
            XB_SPIN(xb_ld(&bar[XB_XGEN(b.x)]) == gen, bar);
            __builtin_amdgcn_fence(__ATOMIC_ACQUIRE, "agent");
            asm volatile("s_waitcnt vmcnt(0)" ::: "memory");
        }
    }
    __syncthreads();
}

struct Args { InPtrs I; float* out; unsigned char* ws; int ph_lo, ph_hi; };
#ifndef ONLY
#define ONLY -1
#endif
#define CASE_ON(n) if constexpr (ONLY < 0 || ONLY == (n))
#ifndef PROBE_K
#define PROBE_K -1
#endif
constexpr int PH_PER_LAYER = 9 + (PROBE_K >= 0 ? 1 : 0), N_PHASES = 1 + DEPTH * PH_PER_LAYER;

__global__ void __launch_bounds__(512, 2) fwd_kernel(Args args) {
    extern __shared__ __attribute__((aligned(16))) unsigned char lds_raw[];
    LAS unsigned char* lds = (LAS unsigned char*)lds_raw;
    cg::grid_group grid = cg::this_grid();
    const int wid_s = __builtin_amdgcn_readfirstlane((int)threadIdx.x >> 6);
    XcdBarrier bar;
    {
        const int tid0 = get_tid(wid_s);
        unsigned* barw = (unsigned*)(args.ws + WS_BAR);
        volatile LAS unsigned* st = (volatile LAS unsigned*)(lds + 131072 + 64);
        if (blockIdx.x == 0) { for (int i = tid0; i < XCD_BAR_WORDS; i += 512) __hip_atomic_store(barw + i, 0u, __ATOMIC_RELAXED, __HIP_MEMORY_SCOPE_AGENT);
            unsigned* cw = (unsigned*)(args.ws + WS_CNT); for (int i = tid0; i < CNT_WORDS; i += 512) __hip_atomic_store(cw + i, 0u, __ATOMIC_RELAXED, __HIP_MEMORY_SCOPE_AGENT); }
        if (tid0 < 2) st[tid0] = 0u;
        __syncthreads();
        grid.sync();
        bar = xcd_barrier_post(barw, st, tid0);
    }
    for (int ph = args.ph_lo; ph < args.ph_hi; ++ph) {
        kptr_t kp = (kptr_t)__builtin_amdgcn_kernarg_segment_ptr(); asm volatile("" : "+s"(kp));
        float* trunk = *(float* const __attribute__((address_space(4)))*)(kp + 208);
        unsigned char* ws = *(unsigned char* const __attribute__((address_space(4)))*)(kp + 216);
        const int wave = wid_s;
        int G = gridDim.x, c = blockIdx.x; asm volatile("" : "+s"(G), "+s"(c));
        const int gw = c * 8 + wave, NGW = G * 8;
        float* rope = (float*)(ws + WS_ROPE);
        bf16* Wb = (bf16*)(ws + WS_W); bf16* PB = (bf16*)(ws + WS_PB); bf16* HB = (bf16*)(ws + WS_HB); bf16* Z = (bf16*)(ws + WS_Z);
        bf16* ATT = (bf16*)(ws + WS_ATT); bf16* XFB = (bf16*)(ws + WS_XFB); bf16* UB = (bf16*)(ws + WS_EXTRA); bf16* T = (bf16*)(ws + WS_EXTRA);
        bf16* LAb = Z; bf16* HG = XFB; bf16* ACT = Z; float* SIDE = (float*)(ws + WS_ATT);
        if (ph > args.ph_lo) { xcd_barrier(bar, get_tid(wid_s));
#ifdef PROBE_SYNC2
            xcd_barrier(bar, get_tid(wid_s));
#endif
        }
        if (ph == 0) { CASE_ON(100) {
            const int tid = get_tid(wid_s), lane = tid & 63;
            convert_layer(kp, ws, 0, CJ_IN, lds, gw, NGW, wave, lane);
            ln_rows(INP(0), trunk, HB, INP(2), INP(3), gw, NGW, lane);
            rope_table(rope, c * 512 + tid, G * 512); }
            continue;
        }
        const int l = (ph - 1) / PH_PER_LAYER; int k = (ph - 1) % PH_PER_LAYER; if (PROBE_K >= 0 && k == 9) k = PROBE_K;
        switch (k) {
        case 0: CASE_ON(0) {
#ifndef PROBE_LITE
#define PROBE_LITE 0
#endif
            const bool rerun = (ph - 1) % PH_PER_LAYER == 9;
            if (c >= 128 && !rerun) convert_layer(kp, ws, l, CJ_ALL & ~CJ_IN, lds, (c - 128) * 8 + wave, 128 * 8, wave, get_tid(wid_s) & 63);
            __syncthreads();
            pg8::TileOrder S; S.init(M, DIN, G, c, HB, D, Wb + W_IN, D);
            EpiIn E{Z, rope, rerun ? PROBE_LITE : 0};
            pg8::gemm_phase(lds, wid_s, D, D, S, E);
        } break;
        case 1: CASE_ON(1) {
            attn_phase(wid_s, lds, Z + Z_Q, Z + Z_K, Z + Z_V, ATT, INP(5) + l * NH, c, G);
            conv_phase(wid_s, Z + Z_XR, XFB, INP(6) + (size_t)l * 2 * 4 * D, INP(7) + (size_t)l * 2 * D, c, G);
            __syncthreads();
            if (l + 1 < DEPTH) convert_layer(kp, ws, l + 1, CJ_IN, lds, gw, NGW, wave, get_tid(wid_s) & 63);
        } break;
        case 2: CASE_ON(2) {
            pg8::GateOrder S{G, c, (const char*)XFB, (const char*)(Wb + W_G)};
            EpiGate E{XFB, LAb, UB, INP(9) + (size_t)l * 2 * D, INP(11) + (size_t)l * 2 * D, INP(12) + (size_t)l * 2 * D};
            pg8::gemm_phase(lds, wid_s, 256, 1024, S, E);
        } break;
        case 3: CASE_ON(3) {
            scan_phase(wid_s, lds, LAb, UB, Z + Z_GY, HG, c, G);
        } break;
        case 4: CASE_ON(4) {
            { pg8::TileOrder S; S.init(M, D, G, c, ATT, D, Wb + W_PA, D); EpiX<EP_PA> E{T, nullptr, Z + Z_SA, nullptr}; pg8::gemm_phase(lds, wid_s, D, D, S, E); }
            { pg8::TileOrder S; S.init(M, D, G, c, HG, D, Wb + W_PR, D); EpiX<EP_PR> E{T, nullptr, Z + Z_SR, HB}; pg8::gemm_phase(lds, wid_s, D, D, S, E); }
        } break;
        case 5: CASE_ON(5) {
            pg8::TileOrder S; S.init(M, D, G, c, HB, D, Wb + W_O, D);
            EpiLn E{trunk, HB, INP(16) + (size_t)l * D, INP(17) + (size_t)l * D, (unsigned long long*)(ws + WS_ATT + 16 * MiB), (unsigned*)(ws + WS_CNT) + (2 * l) * 1024, DN_ALPHA};
            pg8::gemm_phase(lds, wid_s, D, D, S, E);
        } break;
        case 6: CASE_ON(6) {
            pg8::TileOrder S; S.init(M, 2 * DFF, G, c, HB, D, Wb + W_UP, D);
            EpiUpG E{ACT, SIDE, INP(19) + (size_t)l * 3 * DFF, INP(20) + (size_t)l * DFF, (LAS float*)(lds + 131072 + 1024)};
            pg8::gemm_phase(lds, wid_s, D, D, S, E);
        } break;
        case 7: CASE_ON(7) {
            geglu_fix(wid_s, ACT, SIDE, INP(19) + (size_t)l * 3 * DFF, INP(20) + (size_t)l * DFF, c, G);
            { pg8::TileOrder S; S.init(M, D, G, c, PB, DPLE, Wb + W_PLE, DPLE); EpiX<EP_PLE1> E{T, nullptr, nullptr, nullptr}; pg8::gemm_phase(lds, wid_s, DPLE, DPLE, S, E); }
            { pg8::TileOrder S; S.init(M, D, G, c, HB, D, Wb + W_PG, D); EpiX<EP_PLE2> E{T, trunk, nullptr, nullptr}; pg8::gemm_phase(lds, wid_s, D, D, S, E); }
        } break;
        case 8: CASE_ON(8) {
            pg8::TileOrder S; S.init(M, D, G, c, ACT, DFF, Wb + W_DN, DFF);
            EpiLn E{trunk, HB, INP(24) + (size_t)l * D, INP(25) + (size_t)l * D, (unsigned long long*)(ws + WS_ATT + 16 * MiB), (unsigned*)(ws + WS_CNT) + (2 * l + 1) * 1024, 1.f};
            pg8::gemm_phase(lds, wid_s, DFF, DFF, S, E);
        } break;
        }
    }
}

extern "C" void kernel_launch(void* const* d_in, const int* in_sizes, int n_in, void* d_out, int out_size, void* d_ws, size_t ws_size, hipStream_t stream) {
    static int grid = 0;
    if (grid == 0) {
        if (n_in != 26 || out_size != M * D || ws_size < WS_END) { fprintf(stderr, "kernel_launch: unexpected sizes n_in %d out %d ws %zu\n", n_in, out_size, ws_size); grid = -1; return; }
        int dev = 0, cus = 0, per_cu = 0;
        hipGetDevice(&dev); hipDeviceGetAttribute(&cus, hipDeviceAttributeMultiprocessorCount, dev);
        if (hipFuncSetAttribute((const void*)fwd_kernel, hipFuncAttributeMaxDynamicSharedMemorySize, LDS_BYTES) != hipSuccess) { fprintf(stderr, "kernel_launch: hipFuncSetAttribute failed\n"); grid = -1; return; }
        hipOccupancyMaxActiveBlocksPerMultiprocessor(&per_cu, (const void*)fwd_kernel, 512, LDS_BYTES);
        (void)hipGetLastError();
        if (per_cu < 1) per_cu = 1;
        grid = cus * 1;
        if (grid > 256) grid = 256;
        if (grid != 256) { fprintf(stderr, "kernel_launch: needs a 256-CU device (one 256x256 unit per workgroup in the fused-LayerNorm phases)\n"); grid = -1; return; }
        fprintf(stderr, "kernel_launch: cus %d per_cu %d grid %d ws %zu\n", cus, per_cu, grid, ws_size);
    }
    if (grid < 0) return;
    Args a{};
    for (int i = 0; i < 26; ++i) a.I.in[i] = (const float*)d_in[i];
    a.out = (float*)d_out; a.ws = (unsigned char*)d_ws; a.ph_lo = 0; a.ph_hi = N_PHASES;
    void* kargs[] = {&a};
    hipError_t e = hipLaunchCooperativeKernel((const void*)fwd_kernel, dim3(grid), dim3(512), kargs, LDS_BYTES, stream);
    if (e != hipSuccess) fprintf(stderr, "kernel_launch: cooperative launch failed: %s\n", hipGetErrorString(e));
}
```
